# Optimizing an MI355X kernel written in HIP

```python
import math
import jax, jax.numpy as jnp
from jax import lax
import numpy as np

D_MODEL = 2048
BATCH = 4
SEQ = 2048
DEPTH = 4
DEC_BATCH = 8
DEC_SEQ = 1
PAST_LEN = 16384
PAGE_SIZE = 128

HEAD_DIM = 64
D_MIX = D_MODEL
D_ATTN = D_MIX // 2
D_CONV = D_MIX - D_ATTN
N_HEADS = D_ATTN // HEAD_DIM
CONV_GROUPS = D_CONV // HEAD_DIM
CONV_WIDTH = 3
D_FF = 4 * D_MODEL
DILATED_CONFIGS = ((128, 1), (512, 4), (2048, 16))
ATTN_WINDOW = max(w for w, _ in DILATED_CONFIGS)
N_BUCKETS = 32
MAX_DISTANCE = 2048
Q_BLOCK = 128
EPS = 1e-6
ATTN_SCALE = HEAD_DIM ** -0.5
D_IN = 3 * D_ATTN + 3 * D_CONV

kernel_name = "hymba_dilated_swa_shortconv_decoder_step"


def _rmsnorm(x, g):
    xf = x.astype(jnp.float32)
    y = xf * lax.rsqrt(jnp.mean(xf * xf, axis=-1, keepdims=True) + EPS)
    return (y * g.astype(jnp.float32)).astype(x.dtype)


def _t5_bucket(dist):
    n_exact = N_BUCKETS // 2
    large = n_exact + (np.log(np.maximum(dist, 1) / n_exact) / np.log(MAX_DISTANCE / n_exact)
                       * (N_BUCKETS - n_exact)).astype(np.int32)
    large = np.minimum(large, N_BUCKETS - 1)
    return np.where(dist < n_exact, dist, large).astype(np.int32)


def _branch_biases(rel_bias):
    return [rel_bias[_t5_bucket(np.arange(w // d + 1) * d)] for w, d in DILATED_CONFIGS]


def _dilated_branch_prompt(q, k, v, bias_k, dil):
    b, s, h, e = q.shape
    nw = bias_k.shape[0] - 1
    L = s // dil
    bq = math.gcd(L, Q_BLOCK)
    nblk = L // bq
    pad = ((0, 0), (nw, 0), (0, 0), (0, 0), (0, 0))
    qb = q.reshape(b, nblk, bq, dil, h, e)
    kp = jnp.pad(k.reshape(b, L, dil, h, e), pad)
    vp = jnp.pad(v.reshape(b, L, dil, h, e), pad)
    idx = np.arange(nblk)[:, None] * bq + np.arange(bq + nw)[None, :]
    kb = kp[:, idx]
    vb = vp[:, idx]
    logits = jnp.einsum('bnqrhe,bnkrhe->bnrhqk', qb, kb).astype(jnp.float32) * ATTN_SCALE
    rel = np.arange(bq)[:, None] - np.arange(bq + nw)[None, :] + nw
    valid = ((rel >= 0) & (rel <= nw))[None] & ((idx - nw) >= 0)[:, None, :]
    bias = bias_k[np.clip(rel, 0, nw)].transpose(2, 0, 1).astype(jnp.float32)
    logits = jnp.where(valid[None, :, None, None], logits + bias[None, None, None], -jnp.inf)
    m = jnp.max(logits, axis=-1)
    p = jnp.exp(logits - m[..., None])
    den = jnp.sum(p, axis=-1)
    o = jnp.einsum('bnrhqk,bnkrhe->bnqrhe', p, vb.astype(jnp.float32)).reshape(b, s, h, e)
    m = m.transpose(0, 1, 4, 2, 3).reshape(b, s, h)
    den = den.transpose(0, 1, 4, 2, 3).reshape(b, s, h)
    return o, m, den


def _dilated_branch_sample(q, kcat, vcat, bias_k, dil):
    b, t, h, e = q.shape
    wb = kcat.shape[1] - t
    nk = bias_k.shape[0]
    j = wb + np.arange(t)[:, None] - np.arange(nk)[None, :] * dil
    valid = j >= 0
    jc = np.maximum(j, 0)
    kg = kcat[:, jc]
    vg = vcat[:, jc]
    logits = jnp.einsum('bthe,btkhe->bhtk', q, kg).astype(jnp.float32) * ATTN_SCALE
    logits = logits + bias_k.T.astype(jnp.float32)[None, :, None, :]
    logits = jnp.where(valid[None, None], logits, -jnp.inf)
    m = jnp.max(logits, axis=-1)
    p = jnp.exp(logits - m[..., None])
    den = jnp.sum(p, axis=-1)
    o = jnp.einsum('bhtk,btkhe->bthe', p, vg.astype(jnp.float32))
    return o, m.transpose(0, 2, 1), den.transpose(0, 2, 1)


def _combine_branches(branches):
    ms = jnp.stack([br[1] for br in branches], axis=0)
    mmax = jnp.max(ms, axis=0)
    num = 0.0
    den = 0.0
    for o_c, m_c, d_c in branches:
        w = jnp.exp(m_c - mmax)
        num = num + w[..., None] * o_c
        den = den + w * d_c
    return num / den[..., None]


def _mixer_inputs(x, g_norm, w_in, q_g, k_g):
    b, s, _ = x.shape
    h = _rmsnorm(x, g_norm)
    proj = jnp.einsum('bsd,dc->bsc', h, w_in)
    cuts = [D_ATTN, 2 * D_ATTN, 3 * D_ATTN, 3 * D_ATTN + D_CONV, 3 * D_ATTN + 2 * D_CONV]
    q, k, v, vc, gate_b, gate_c = jnp.split(proj, cuts, axis=-1)
    q = _rmsnorm(q.reshape(b, s, N_HEADS, HEAD_DIM), q_g)
    k = _rmsnorm(k.reshape(b, s, N_HEADS, HEAD_DIM), k_g)
    v = v.reshape(b, s, N_HEADS, HEAD_DIM)
    u = gate_c * vc
    return q, k, v, u, gate_b


def _depthwise_conv(ucat, w, t):
    y = w[0] * ucat[:, 0:t]
    for i in range(1, CONV_WIDTH):
        y = y + w[i] * ucat[:, i:i + t]
    return y


def _mixer_output(o_attn, y_conv, gate_b, attn_g, conv_g, w_out):
    b, s = o_attn.shape[:2]
    oa = _rmsnorm(o_attn.reshape(b, s, D_ATTN).astype(y_conv.dtype), attn_g)
    oc = _rmsnorm(gate_b * y_conv, conv_g)
    return jnp.einsum('bsc,cd->bsd', jnp.concatenate([oa, oc], axis=-1), w_out)


def _mlp(x, g, w_up, w_down):
    h = _rmsnorm(x, g)
    a = jnp.square(jax.nn.relu(jnp.einsum('bsd,df->bsf', h, w_up)))
    return jnp.einsum('bsf,fd->bsd', a, w_down)


def setup_inputs(seed: int = 0) -> dict:
    key = jax.random.key(seed)
    ks = jax.random.split(key, 17)
    wb = min(ATTN_WINDOW, PAST_LEN)
    f32 = jnp.float32

    def nrm(k, shape, scale=1.0):
        return jax.random.normal(k, shape, f32) * scale

    return {
        "x_prompt": nrm(ks[0], (BATCH, SEQ, D_MODEL)),
        "x_sample": nrm(ks[1], (DEC_BATCH, DEC_SEQ, D_MODEL)),
        "state_attn_k": nrm(ks[2], (DEPTH, DEC_BATCH, wb, N_HEADS, HEAD_DIM)),
        "state_attn_v": nrm(ks[3], (DEPTH, DEC_BATCH, wb, N_HEADS, HEAD_DIM)),
        "state_conv": nrm(ks[4], (DEPTH, DEC_BATCH, CONV_WIDTH - 1, D_CONV)),
        "rel_bias": nrm(ks[5], (N_BUCKETS, N_HEADS), 0.5),
        "norm_mix": 1.0 + nrm(ks[6], (DEPTH, D_MODEL), 0.05),
        "w_in": nrm(ks[7], (DEPTH, D_MODEL, D_IN), D_MODEL ** -0.5),
        "q_norm": 1.0 + nrm(ks[8], (DEPTH, HEAD_DIM), 0.05),
        "k_norm": 1.0 + nrm(ks[9], (DEPTH, HEAD_DIM), 0.05),
        "conv_w": nrm(ks[10], (DEPTH, CONV_WIDTH, D_CONV), CONV_WIDTH ** -0.5),
        "attn_out_norm": 1.0 + nrm(ks[11], (DEPTH, D_ATTN), 0.05),
        "conv_out_norm": 1.0 + nrm(ks[12], (DEPTH, D_CONV), 0.05),
        "w_out": nrm(ks[13], (DEPTH, D_MIX, D_MODEL), D_MIX ** -0.5),
        "norm_mlp": 1.0 + nrm(ks[14], (DEPTH, D_MODEL), 0.05),
        "w_up": nrm(ks[15], (DEPTH, D_MODEL, D_FF), D_MODEL ** -0.5),
        "w_down": nrm(ks[16], (DEPTH, D_FF, D_MODEL), 0.8 * D_FF ** -0.5),
    }


def reference(x_prompt, x_sample, state_attn_k, state_attn_v, state_conv, rel_bias,
              norm_mix, w_in, q_norm, k_norm, conv_w, attn_out_norm, conv_out_norm,
              w_out, norm_mlp, w_up, w_down):
    biases = _branch_biases(rel_bias)
    s_p = x_prompt.shape[1]
    t_s = x_sample.shape[1]
    pw = min(ATTN_WINDOW, s_p)
    wb = state_attn_k.shape[2]
    xp, xs = x_prompt, x_sample
    kp_new, vp_new, cp_new, ks_new, vs_new, cs_new = [], [], [], [], [], []
    for l in range(DEPTH):
        q, k, v, u, gb = _mixer_inputs(xp, norm_mix[l], w_in[l], q_norm[l], k_norm[l])
        o = _combine_branches([_dilated_branch_prompt(q, k, v, bias_c, d)
                               for bias_c, (_, d) in zip(biases, DILATED_CONFIGS)])
        ucat = jnp.pad(u, ((0, 0), (CONV_WIDTH - 1, 0), (0, 0)))
        yc = _depthwise_conv(ucat, conv_w[l], s_p)
        xp = xp + _mixer_output(o, yc, gb, attn_out_norm[l], conv_out_norm[l], w_out[l])
        xp = xp + _mlp(xp, norm_mlp[l], w_up[l], w_down[l])
        kp_new.append(k[:, s_p - pw:])
        vp_new.append(v[:, s_p - pw:])
        cp_new.append(u[:, s_p - (CONV_WIDTH - 1):])

        q, k, v, u, gb = _mixer_inputs(xs, norm_mix[l], w_in[l], q_norm[l], k_norm[l])
        kcat = jnp.concatenate([state_attn_k[l].astype(k.dtype), k], axis=1)
        vcat = jnp.concatenate([state_attn_v[l].astype(v.dtype), v], axis=1)
        o = _combine_branches([_dilated_branch_sample(q, kcat, vcat, bias_c, d)
                               for bias_c, (_, d) in zip(biases, DILATED_CONFIGS)])
        ucat = jnp.concatenate([state_conv[l].astype(u.dtype), u], axis=1)
        yc = _depthwise_conv(ucat, conv_w[l], t_s)
        xs = xs + _mixer_output(o, yc, gb, attn_out_norm[l], conv_out_norm[l], w_out[l])
        xs = xs + _mlp(xs, norm_mlp[l], w_up[l], w_down[l])
        ks_new.append(kcat[:, t_s:t_s + wb])
        vs_new.append(vcat[:, t_s:t_s + wb])
        cs_new.append(ucat[:, t_s:])

    return (xp, xs, jnp.stack(kp_new), jnp.stack(vp_new), jnp.stack(cp_new),
            jnp.stack(ks_new), jnp.stack(vs_new), jnp.stack(cs_new))
```

```cpp
#include <hip/hip_runtime.h>
#include <cstdio>
#include <cstdint>
#ifndef KV_SIDE
#define KV_SIDE 1
#endif
namespace pg8 {
#define PG8_LAS __attribute__((address_space(3)))
typedef unsigned short bf16_t;
typedef short bf16x8 __attribute__((ext_vector_type(8)));
typedef float f32x4 __attribute__((ext_vector_type(4)));
typedef unsigned u32x4 __attribute__((ext_vector_type(4)));
constexpr int BM = 256, BK = 64, HALF = 128, HTB = HALF * BK * 2  , STAGE_BYTES = 8 * HTB, NXCD = 8, WGM = 4;

__host__ __device__ __forceinline__ int lds_byte(int r, int c) { const int st = (r >> 4) * 2 + (c >> 5), rr = r & 15, cc = c & 31, ob = rr * 64 + cc * 2; return st * 1024 + (ob ^ (((ob >> 9) & 1) << 5)); }
__host__ __device__ __forceinline__ void stage_rc(int b, int& R, int& C) { const int st = b / 1024, sb = b % 1024, swz = sb ^ (((sb >> 9) & 1) << 5); R = (st >> 1) * 16 + swz / 64; C = (st & 1) * 32 + (swz % 64) / 2; }
__host__ __device__ __forceinline__ int perm32(int rho) { const int n = rho >> 4, i = rho & 15; return 8 * (i >> 2) + 4 * n + (i & 3); }

struct Unit { int pm, pn; };
struct Gemm { const bf16_t* A; const bf16_t* Bt; int M, N, K, wave; };

struct StaticOrder {
    int nM, nN, nwg, G, c;
    __host__ __device__ void init(int M, int N, int G_, int c_) { nM = M / BM; nN = N / BM; nwg = nM * nN; G = G_; c = c_; }
    __host__ __device__ bool next(int i, Unit& u) const {
        const long L = (long)i * G + c; if (L >= nwg) return false;
        int wgid = (int)L; { const int q = nwg / NXCD, r = nwg % NXCD, xcd = wgid % NXCD, off = wgid / NXCD; wgid = (xcd < r ? xcd * (q + 1) : r * (q + 1) + (xcd - r) * q) + off; }
        const int nig = WGM * nN, gid = wgid / nig, fm = gid * WGM, gsz = (nM - fm) < WGM ? (nM - fm) : WGM;
        u.pm = fm + ((wgid % nig) % gsz); u.pn = (wgid % nig) / gsz; return true;
    }
    __device__ __forceinline__ void a_ready(const Unit&) const {}
    __device__ __forceinline__ void done(const Unit&) const {}
};

typedef float f32x2 __attribute__((ext_vector_type(2)));
typedef __bf16 bf16x2v __attribute__((ext_vector_type(2)));
__device__ __forceinline__ unsigned cvt_pk_bf16(float lo, float hi) { f32x2 v = {lo, hi}; bf16x2v b = __builtin_convertvector(v, bf16x2v); return __builtin_bit_cast(unsigned, b); }
__device__ __forceinline__ u32x4 pack8(const f32x4 a, const f32x4 b) { u32x4 w; w.x = cvt_pk_bf16(a[0], a[1]); w.y = cvt_pk_bf16(a[2], a[3]); w.z = cvt_pk_bf16(b[0], b[1]); w.w = cvt_pk_bf16(b[2], b[3]); return w; }
#ifndef RES_PREFETCH
#define RES_PREFETCH 0
#endif
#ifndef STORE_WT
#define STORE_WT 0
#endif
__device__ __forceinline__ void st16(bf16_t* p, const u32x4 v) {
#if STORE_WT
    asm volatile("global_store_dwordx4 %0, %1, off sc1\n\ts_nop 1" :: "v"(p), "v"(v) : "memory");
#else
    *(u32x4*)p = v;
#endif
}
__device__ __forceinline__ float row_rstd(const float* ssq, int row, float inv_n, float eps) {
    const f32x4 s0 = *(const f32x4*)(ssq + (size_t)row * 8), s1 = *(const f32x4*)(ssq + (size_t)row * 8 + 4);
    return __builtin_amdgcn_rsqf((((s0[0] + s0[1]) + (s0[2] + s0[3])) + ((s1[0] + s1[1]) + (s1[2] + s1[3]))) * inv_n + eps);
}

template <class Sched>
__device__ __forceinline__ void fill_rstd_table(PG8_LAS float* tab, const Sched& S, const float* ssq, float eps, int tid) {
    Unit u;
    for (int i = 0; S.next(i, u); ++i) if ((tid >> 8) == (i & 1)) tab[i * BM + (tid & 255)] = row_rstd(ssq, u.pm * BM + (tid & 255), 1.0f / 2048.0f, eps);
    asm volatile("s_waitcnt lgkmcnt(0)" ::: "memory"); __builtin_amdgcn_s_barrier(); asm volatile("" ::: "memory");
}

struct MixedOrderG1 : StaticOrder {
    __host__ __device__ bool next(int i, Unit& u) const { const bool ok = StaticOrder::next(i, u); if (ok) u.pn = (u.pn & 3) * 6 + (u.pn >> 2); return ok; }
};

struct EpiG1 {
    static constexpr bool AFTER_DRAIN = false;
    const PG8_LAS float* rs_tab; const float* qg; int g_stride;
    bf16_t* Q; size_t qkv_stride;
    bf16_t* PC;
    float* kout; size_t kv_out_stride;
    float qscale, eps;
    __device__ __forceinline__ void operator()(const f32x4 (&acc)[2][2][4][2], const Unit& u, int ui, int wr, int wc, int fr, int fq) const {
        const int region = u.pn >> 2, head = (u.pn & 3) * 4 + wc;
        f32x4 g[2][2];
#pragma unroll
        for (int bj = 0; bj < 2; ++bj)
#pragma unroll
            for (int n = 0; n < 2; ++n) g[bj][n] = (f32x4){1.f, 1.f, 1.f, 1.f};
        if (region < 2) { const float* gp = qg + region * g_stride; const float s = region == 0 ? qscale : 1.f;
#pragma unroll
            for (int bj = 0; bj < 2; ++bj)
#pragma unroll
                for (int n = 0; n < 2; ++n) g[bj][n] = *(const f32x4*)(gp + bj * 32 + fq * 8 + n * 4) * s; }
#pragma unroll
        for (int ai = 0; ai < 2; ++ai)
#pragma unroll
            for (int m = 0; m < 4; ++m) {
                const int row = u.pm * BM + ai * HALF + wr * 64 + m * 16 + fr;
                const float rs = rs_tab[ui * BM + ai * HALF + wr * 64 + m * 16 + fr];
                f32x4 v[2][2];
#pragma unroll
                for (int bj = 0; bj < 2; ++bj)
#pragma unroll
                    for (int n = 0; n < 2; ++n) v[bj][n] = acc[ai][bj][m][n] * rs;
                if (region < 2) {
                    float q = 0.f;
#pragma unroll
                    for (int bj = 0; bj < 2; ++bj)
#pragma unroll
                        for (int n = 0; n < 2; ++n) { const f32x4 x = v[bj][n]; q += (x[0] * x[0] + x[1] * x[1]) + (x[2] * x[2] + x[3] * x[3]); }
                    q += __shfl_xor(q, 16); q += __shfl_xor(q, 32);
                    const float rh = __builtin_amdgcn_rsqf(q * (1.0f / 64.0f) + eps);
#pragma unroll
                    for (int bj = 0; bj < 2; ++bj)
#pragma unroll
                        for (int n = 0; n < 2; ++n) v[bj][n] = v[bj][n] * rh * g[bj][n];
                }
                if (region < 3) {
                    const int b = row >> 11, t = row & 2047;
                    bf16_t* dst = Q + (size_t)region * qkv_stride + ((size_t)(b * 16 + head) * 2048 + t) * 64 + fq * 8;
#pragma unroll
                    for (int bj = 0; bj < 2; ++bj) *(u32x4*)(dst + bj * 32) = pack8(v[bj][0], v[bj][1]);
                    if (!KV_SIDE && region >= 1) { float* o = kout + (size_t)(region - 1) * kv_out_stride + (size_t)row * 1024 + head * 64 + fq * 8;
#pragma unroll
                        for (int bj = 0; bj < 2; ++bj) { __builtin_nontemporal_store(v[bj][0], (f32x4*)(o + bj * 32)); __builtin_nontemporal_store(v[bj][1], (f32x4*)(o + bj * 32 + 4)); } }
                } else if (u.pn < 20) {
                    bf16_t* dst = PC + (size_t)row * 2048 + (u.pn - 12) * 128 + wc * 32 + fq * 8;
                    *(u32x4*)dst = pack8(v[0][0] * v[1][0], v[0][1] * v[1][1]);
                } else {
                    bf16_t* dst = PC + (size_t)row * 2048 + 1024 + (u.pn - 20) * 256 + wc * 64 + fq * 8;
#pragma unroll
                    for (int bj = 0; bj < 2; ++bj) *(u32x4*)(dst + bj * 32) = pack8(v[bj][0], v[bj][1]);
                }
            }
    }
};

struct EpiG3 {
    static constexpr bool AFTER_DRAIN = false;
    const PG8_LAS float* rs_tab; bf16_t* Hb; int ldc;
    __device__ __forceinline__ void operator()(const f32x4 (&acc)[2][2][4][2], const Unit& u, int ui, int wr, int wc, int fr, int fq) const {
#pragma unroll
        for (int ai = 0; ai < 2; ++ai)
#pragma unroll
            for (int m = 0; m < 4; ++m) {
                const int row = u.pm * BM + ai * HALF + wr * 64 + m * 16 + fr;
                const float rs = rs_tab[ui * BM + ai * HALF + wr * 64 + m * 16 + fr];
                bf16_t* dst = Hb + (size_t)row * ldc + u.pn * BM + wc * 64 + fq * 8;
#pragma unroll
                for (int bj = 0; bj < 2; ++bj) {
                    f32x4 a = acc[ai][bj][m][0] * rs, b = acc[ai][bj][m][1] * rs;
#pragma unroll
                    for (int i = 0; i < 4; ++i) { const float x = fmaxf(a[i], 0.f), y = fmaxf(b[i], 0.f); a[i] = x * x; b[i] = y * y; }
                    st16(dst + bj * 32, pack8(a, b));
                }
            }
    }
};

struct EpiRes {
    static constexpr bool AFTER_DRAIN = true;
    bf16_t* xb; float* ssq_out; float* yout;
    __device__ __forceinline__ void prefetch(const Unit& u, int wr, int wc, int fr, int fq, u32x4 (&res)[2][4][2]) const {
#pragma unroll
        for (int ai = 0; ai < RES_PREFETCH; ++ai)
#pragma unroll
            for (int m = 0; m < 4; ++m) {
                const size_t off = (size_t)(u.pm * BM + ai * HALF + wr * 64 + m * 16 + fr) * 2048 + u.pn * BM + wc * 64 + fq * 8;
#pragma unroll
                for (int bj = 0; bj < 2; ++bj) res[ai][m][bj] = *(const u32x4*)(xb + off + bj * 32);
            }
    }
    __device__ __forceinline__ void fused(const f32x4 (&acc)[2][2][4][2], const u32x4 (&res)[2][4][2], const Unit& u, int wr, int wc, int fr, int fq, PG8_LAS unsigned char* lds, int wid, int lane) const {
        PG8_LAS float* P = (PG8_LAS float*)lds;
#pragma unroll
        for (int ai = 0; ai < 2; ++ai)
#pragma unroll
            for (int m = 0; m < 4; ++m) {
                const int rl = ai * HALF + wr * 64 + m * 16 + fr;
                const size_t off = (size_t)(u.pm * BM + rl) * 2048 + u.pn * BM + wc * 64 + fq * 8;
                float q = 0.f;
#pragma unroll
                for (int bj = 0; bj < 2; ++bj) {
                    const u32x4 xo = ai < RES_PREFETCH ? res[ai][m][bj] : *(const u32x4*)(xb + off + bj * 32);
                    f32x4 v0, v1;
                    v0[0] = __uint_as_float(xo[0] << 16); v0[1] = __uint_as_float(xo[0] & 0xffff0000u); v0[2] = __uint_as_float(xo[1] << 16); v0[3] = __uint_as_float(xo[1] & 0xffff0000u);
                    v1[0] = __uint_as_float(xo[2] << 16); v1[1] = __uint_as_float(xo[2] & 0xffff0000u); v1[2] = __uint_as_float(xo[3] << 16); v1[3] = __uint_as_float(xo[3] & 0xffff0000u);
                    v0 += acc[ai][bj][m][0]; v1 += acc[ai][bj][m][1];
                    if (yout) { *(f32x4*)(yout + off + bj * 32) = v0; *(f32x4*)(yout + off + bj * 32 + 4) = v1; }
                    st16(xb + off + bj * 32, pack8(v0, v1));
                    q += ((v0[0] * v0[0] + v0[1] * v0[1]) + (v0[2] * v0[2] + v0[3] * v0[3])) + ((v1[0] * v1[0] + v1[1] * v1[1]) + (v1[2] * v1[2] + v1[3] * v1[3]));
                }
                q += __shfl_xor(q, 16); q += __shfl_xor(q, 32);
                if (fq == 0) P[rl * 4 + wc] = q;
            }
        asm volatile("s_waitcnt lgkmcnt(0)" ::: "memory"); __builtin_amdgcn_s_barrier(); asm volatile("" ::: "memory");
        const int tid = wid * 64 + lane;
        if (tid < 256) { const f32x4 p = *(const PG8_LAS f32x4*)(P + tid * 4); ssq_out[(size_t)(u.pm * BM + tid) * 8 + u.pn] = (p[0] + p[1]) + (p[2] + p[3]); }
        asm volatile("s_waitcnt lgkmcnt(0)" ::: "memory"); __builtin_amdgcn_s_barrier(); asm volatile("" ::: "memory");
    }
};

struct EpiNull { static constexpr bool AFTER_DRAIN = true;
    __device__ __forceinline__ void prefetch(const Unit&, int, int, int, int, u32x4 (&)[2][4][2]) const {}
    __device__ __forceinline__ void fused(const f32x4 (&acc)[2][2][4][2], const u32x4 (&)[2][4][2], const Unit& u, int wr, int wc, int fr, int fq, PG8_LAS unsigned char* lds, int wid, int lane) const {
        float s = 0.f;
#pragma unroll
        for (int ai = 0; ai < 2; ++ai)
#pragma unroll
            for (int bj = 0; bj < 2; ++bj)
#pragma unroll
                for (int m = 0; m < 4; ++m)
#pragma unroll
                    for (int n = 0; n < 2; ++n) s += acc[ai][bj][m][n][0] + acc[ai][bj][m][n][1] + acc[ai][bj][m][n][2] + acc[ai][bj][m][n][3];
        if (s == 1.2345e-30f) *(PG8_LAS float*)lds = s;
    }
};

struct NoSide { static constexpr bool ON = false; __device__ __forceinline__ void prime() {} __device__ __forceinline__ void fetch() {} __device__ __forceinline__ void step(int) {} };
template <class Epi, class Sched, bool ALIGN_EPI = false, bool SP2 = false, class Side = NoSide>
__device__ __forceinline__ void gemm_phase(PG8_LAS unsigned char* lds, const Gemm g, const Sched& S, const Epi& E, Side side = Side()) {
    int tid_ = (int)__builtin_amdgcn_mbcnt_hi(~0u, __builtin_amdgcn_mbcnt_lo(~0u, 0u)) + 64 * g.wave; asm volatile("" : "+v"(tid_));
    const int tid = tid_, wid = __builtin_amdgcn_readfirstlane(tid >> 6), lane = tid & 63, wr = wid >> 2, wc = wid & 3, fr = lane & 15, fq = lane >> 4;
    const int K = g.K, nt = K / BK;
    unsigned voffA[2], voffB[2];
#pragma unroll
    for (int i = 0; i < 2; ++i) { int R, C; stage_rc(tid * 16 + i * 8192, R, C); const int Rb = 64 * (R >> 5) + perm32(R & 31);
        voffA[i] = (unsigned)(R * K + C) * 2u; voffB[i] = (unsigned)(Rb * K + C) * 2u; }
    const size_t kstep = (size_t)(BK * 2);
    const size_t hstep = (size_t)HALF * K * 2;
    const size_t hstepB = (size_t)32 * K * 2; const size_t tstep = 2 * hstep;
    const unsigned ldsw = (unsigned)wid * 1024u;
    const int aoff = lds_byte(wr * 64 + fr, fq * 8), boff = lds_byte(wc * 32 + fr, fq * 8);
#define PG8_SA(b, h) (((b) * 2 + (h)) * HTB)
#define PG8_SB(b, h) ((4 + (b) * 2 + (h)) * HTB)
#define PG8_STAGE(bufoff, gbase, voff) do { _Pragma("unroll") for (int _i = 0; _i < 2; ++_i) \
        __builtin_amdgcn_global_load_lds((const unsigned*)((const char*)(gbase) + (voff)[_i]), (PG8_LAS unsigned*)(lds + (bufoff) + ldsw + _i * 8192), 16, 0, 0); } while (0)
#define PG8_LDA(dst, b, h) do { _Pragma("unroll") for (int m = 0; m < 4; ++m) _Pragma("unroll") for (int k = 0; k < 2; ++k) dst[m][k] = *(const PG8_LAS bf16x8*)(lds + PG8_SA(b, h) + aoff + m * 2048 + k * 1024); } while (0)
#define PG8_LDB(dst, b, h) do { _Pragma("unroll") for (int n = 0; n < 2; ++n) _Pragma("unroll") for (int k = 0; k < 2; ++k) dst[n][k] = *(const PG8_LAS bf16x8*)(lds + PG8_SB(b, h) + boff + n * 2048 + k * 1024); } while (0)
#define PG8_MMA(ai, bj, At, Bt) do { __builtin_amdgcn_s_setprio(1); _Pragma("unroll") for (int m = 0; m < 4; ++m) _Pragma("unroll") for (int n = 0; n < 2; ++n) _Pragma("unroll") for (int k = 0; k < 2; ++k) \
        acc[ai][bj][m][n] = __builtin_amdgcn_mfma_f32_16x16x32_bf16(Bt[n][k], At[m][k], acc[ai][bj][m][n], 0, 0, 0); __builtin_amdgcn_s_setprio(0); } while (0)
#define PG8_WAIT_V(n) asm volatile("s_waitcnt vmcnt(" #n ")" ::: "memory")
#define PG8_WAIT_L(n) asm volatile("s_waitcnt lgkmcnt(" #n ")" ::: "memory")
#define PG8_BAR __builtin_amdgcn_s_barrier()
#define PG8_SCHED __builtin_amdgcn_sched_barrier(0)
    Unit cur, nxt; int ui = 0;
    if (!S.next(0, cur)) return;
    f32x4 acc[2][2][4][2];
#pragma unroll
    for (int a = 0; a < 2; ++a)
#pragma unroll
        for (int b = 0; b < 2; ++b)
#pragma unroll
            for (int m = 0; m < 4; ++m)
#pragma unroll
                for (int n = 0; n < 2; ++n) acc[a][b][m][n] = (f32x4){0.f, 0.f, 0.f, 0.f};
    bf16x8 At[4][2], B0[2][2], B1[2][2];
    const char* cA = (const char*)g.A + (size_t)cur.pm * tstep; const char* cB = (const char*)g.Bt + (size_t)cur.pn * tstep;
    S.a_ready(cur);
    if constexpr (SP2) {
        if constexpr (Side::ON) side.prime();
        PG8_STAGE(PG8_SB(0, 0), cB, voffB); PG8_STAGE(PG8_SB(0, 1), cB + hstepB, voffB); PG8_STAGE(PG8_SA(0, 0), cA, voffA); PG8_STAGE(PG8_SA(0, 1), cA + hstep, voffA);
        if (wr == 1) PG8_BAR;
        PG8_WAIT_V(2); PG8_BAR;
        PG8_STAGE(PG8_SB(1, 0), cB + kstep, voffB); PG8_STAGE(PG8_SA(1, 0), cA + kstep, voffA); PG8_STAGE(PG8_SB(1, 1), cB + hstepB + kstep, voffB);
        PG8_WAIT_V(6); PG8_BAR;
        if constexpr (Side::ON) side.fetch();
    } else {
        PG8_STAGE(PG8_SB(0, 0), cB, voffB); PG8_STAGE(PG8_SA(0, 0), cA, voffA); PG8_STAGE(PG8_SB(0, 1), cB + hstepB, voffB); PG8_STAGE(PG8_SA(0, 1), cA + hstep, voffA);
        if (wr == 1) PG8_BAR;
        PG8_WAIT_V(4); PG8_BAR;
        PG8_STAGE(PG8_SB(1, 0), cB + kstep, voffB); PG8_STAGE(PG8_SA(1, 0), cA + kstep, voffA); PG8_STAGE(PG8_SB(1, 1), cB + hstepB + kstep, voffB);
        PG8_WAIT_V(6); PG8_BAR;
    }
    for (;;) {
        const bool has_next = S.next(ui + 1, nxt);
        const char* nA = has_next ? (const char*)g.A + (size_t)nxt.pm * tstep : cA; const char* nB = has_next ? (const char*)g.Bt + (size_t)nxt.pn * tstep : cB;
        for (int t = 0; t < nt; t += 2) {
            const bool last = (t == nt - 2);
            const char* a1 = cA + (size_t)(t + 1) * kstep;
            const char* a2 = last ? nA : cA + (size_t)(t + 2) * kstep; const char* b2 = last ? nB : cB + (size_t)(t + 2) * kstep;
            const char* a3 = a2 + kstep; const char* b3 = b2 + kstep;
            if (last && has_next) S.a_ready(nxt);
            if constexpr (SP2) {
            PG8_LDB(B0, 0, 0); PG8_LDB(B1, 0, 1); PG8_SCHED; PG8_LDA(At, 0, 0); PG8_STAGE(PG8_SA(1, 1), a1 + hstep, voffA);
            if constexpr (Side::ON) { side.step(ui * (nt >> 1) + (t >> 1)); PG8_WAIT_V(9); } else PG8_WAIT_V(8);
            PG8_WAIT_L(0); PG8_BAR; PG8_MMA(0, 0, At, B0); PG8_MMA(0, 1, At, B1); PG8_BAR; PG8_SCHED;
            PG8_LDA(At, 0, 1); PG8_STAGE(PG8_SB(0, 0), b2, voffB); PG8_STAGE(PG8_SB(0, 1), b2 + hstepB, voffB); PG8_STAGE(PG8_SA(0, 0), a2, voffA);
            if constexpr (Side::ON) PG8_WAIT_V(9); else PG8_WAIT_V(8);
            PG8_WAIT_L(0); PG8_BAR; PG8_MMA(1, 0, At, B0); PG8_MMA(1, 1, At, B1); PG8_BAR; PG8_SCHED;
            PG8_LDB(B0, 1, 0); PG8_LDB(B1, 1, 1); PG8_SCHED; PG8_LDA(At, 1, 0); PG8_STAGE(PG8_SA(0, 1), a2 + hstep, voffA);
            PG8_WAIT_V(8); PG8_WAIT_L(0); PG8_BAR; PG8_MMA(0, 0, At, B0); PG8_MMA(0, 1, At, B1); PG8_BAR; PG8_SCHED;
            PG8_LDA(At, 1, 1); if constexpr (Side::ON) side.fetch();
            PG8_STAGE(PG8_SB(1, 0), b3, voffB); PG8_STAGE(PG8_SB(1, 1), b3 + hstepB, voffB); PG8_STAGE(PG8_SA(1, 0), a3, voffA);
            PG8_WAIT_V(8); PG8_WAIT_L(0); PG8_BAR; PG8_MMA(1, 0, At, B0); PG8_MMA(1, 1, At, B1); PG8_BAR; PG8_SCHED;
            } else {
            PG8_LDB(B0, 0, 0); PG8_SCHED; PG8_LDA(At, 0, 0); PG8_STAGE(PG8_SA(1, 1), a1 + hstep, voffA);
            PG8_WAIT_L(8); PG8_BAR; PG8_WAIT_L(0); PG8_MMA(0, 0, At, B0); PG8_BAR; PG8_SCHED;
            PG8_LDB(B1, 0, 1); PG8_STAGE(PG8_SB(0, 0), b2, voffB);
            PG8_BAR; PG8_WAIT_L(0); PG8_MMA(0, 1, At, B1); PG8_BAR;
            PG8_LDA(At, 0, 1); PG8_STAGE(PG8_SA(0, 0), a2, voffA);
            PG8_BAR; PG8_WAIT_L(0); PG8_MMA(1, 0, At, B0); PG8_BAR; PG8_SCHED;
            PG8_STAGE(PG8_SB(0, 1), b2 + hstepB, voffB);
            PG8_WAIT_V(6); PG8_BAR; PG8_MMA(1, 1, At, B1); PG8_BAR;
            PG8_LDB(B0, 1, 0); PG8_SCHED; PG8_LDA(At, 1, 0); PG8_STAGE(PG8_SA(0, 1), a2 + hstep, voffA);
            PG8_WAIT_L(8); PG8_BAR; PG8_WAIT_L(0); PG8_MMA(0, 0, At, B0); PG8_BAR; PG8_SCHED;
            PG8_LDB(B1, 1, 1); PG8_STAGE(PG8_SB(1, 0), b3, voffB);
            PG8_BAR; PG8_WAIT_L(0); PG8_MMA(0, 1, At, B1); PG8_BAR;
            PG8_LDA(At, 1, 1); PG8_STAGE(PG8_SA(1, 0), a3, voffA);
            PG8_BAR; PG8_WAIT_L(0); PG8_MMA(1, 0, At, B0); PG8_BAR; PG8_SCHED;
            PG8_STAGE(PG8_SB(1, 1), b3 + hstepB, voffB);
            PG8_WAIT_V(6); PG8_BAR; PG8_MMA(1, 1, At, B1); PG8_BAR;
            }
        }
        if constexpr (ALIGN_EPI) { if (wr == 0) PG8_BAR; }
        if constexpr (!Epi::AFTER_DRAIN) { E(acc, cur, ui, wr, wc, fr, fq); S.done(cur); }
        if (!has_next) break;
#pragma unroll
        for (int a = 0; a < 2; ++a)
#pragma unroll
            for (int b = 0; b < 2; ++b)
#pragma unroll
                for (int m = 0; m < 4; ++m)
#pragma unroll
                    for (int n = 0; n < 2; ++n) acc[a][b][m][n] = (f32x4){0.f, 0.f, 0.f, 0.f};
        cur = nxt; cA = nA; cB = nB; ++ui;
        if constexpr (ALIGN_EPI) { if (wr == 1) PG8_BAR; }
    }
    u32x4 res[2][4][2];
    if constexpr (Epi::AFTER_DRAIN) E.prefetch(cur, wr, wc, fr, fq, res);
    PG8_WAIT_V(0);
    if constexpr (!ALIGN_EPI) { if (wr == 0) PG8_BAR; }
    PG8_BAR;
    if constexpr (Epi::AFTER_DRAIN) { E.fused(acc, res, cur, wr, wc, fr, fq, lds, wid, lane); S.done(cur); }
#undef PG8_SA
#undef PG8_SB
#undef PG8_STAGE
#undef PG8_LDA
#undef PG8_LDB
#undef PG8_MMA
#undef PG8_WAIT_V
#undef PG8_WAIT_L
#undef PG8_BAR
#undef PG8_SCHED
}
}

constexpr int NWAVES = 8;
#ifndef MK_ONE_LAUNCH
#define MK_ONE_LAUNCH 1
#endif
#ifndef COPY_IN_P0
#define COPY_IN_P0 0
#endif
#ifndef ATT_NMOVE
#define ATT_NMOVE (COPY_IN_P0 ? 0 : 3)
#endif
#ifndef ATT_V4
#define ATT_V4 1
#endif
#ifndef ATT4_MOVERS
#define ATT4_MOVERS 4
#endif
#ifndef GEMM_ALIGN
#define GEMM_ALIGN true
#endif
#ifndef GEMM_SP2
#define GEMM_SP2 true
#endif
#ifndef STAGGER
#define STAGGER 1
#endif
#ifndef STAGGER_MODE
#define STAGGER_MODE 0
#endif
#define STAGGER_PRED(v) (STAGGER_MODE == 0 ? ((v) & 1) : STAGGER_MODE == 1 ? (((v) & 3) == 0) : STAGGER_MODE == 2 ? (((v) >> 1) & 1) : (((v) % 3) == 0))
#ifndef CONV_ORDER
#define CONV_ORDER 0
#endif
#ifndef CONV_IN_P0
#define CONV_IN_P0 0
#endif
constexpr int NB = 4, S = 2048, D = 2048, DEPTH = 4, SB = 8, WBUF = 2048, H = 16, HD = 64, DA = 1024, DC = 1024, DIN = 6144, DFF = 8192;
constexpr int M = NB * S;
constexpr float EPS = 1e-6f;
constexpr float QSCALE = 0.125f * 1.4426950408889634f;
constexpr float LOG2E = 1.4426950408889634f;
constexpr int NPH = 1 + 6 * DEPTH;

constexpr size_t O_Y = 0, O_YS = 16777216, O_KP = 16793600, O_VP = 50348032, O_CP = 83902464, O_KS = 83935232, O_VS = 151044096, O_CS = 218152960, O_END = 218218496;

constexpr size_t MiB = 1u << 20;
constexpr size_t WS_CTL = 0, CTL_ZERO_BYTES = 64 * 1024;
constexpr size_t WS_WIN = 1 * MiB;
constexpr size_t WS_WOUT = WS_WIN + 96 * MiB;
constexpr size_t WS_WUP = WS_WOUT + 32 * MiB;
constexpr size_t WS_WDN = WS_WUP + 128 * MiB;
constexpr size_t WS_XB = WS_WDN + 128 * MiB;
constexpr size_t WS_Q = WS_XB + 32 * MiB, WS_K = WS_Q + 16 * MiB, WS_V = WS_K + 16 * MiB;
constexpr size_t WS_PC = WS_V + 16 * MiB;
constexpr size_t WS_OP = WS_PC + 48 * MiB;
constexpr size_t WS_ML = WS_OP + 96 * MiB;
constexpr size_t WS_MIX = WS_ML + 3 * MiB;
constexpr size_t WS_HB = WS_MIX + 32 * MiB;
constexpr size_t WS_SSQA = WS_HB + 128 * MiB;
constexpr size_t WS_SSQB = WS_SSQA + 256 * 1024;
constexpr size_t WS_SMALL = WS_SSQB + 256 * 1024 + 512 * 1024;
constexpr size_t WS_XS = WS_SMALL;
constexpr size_t WS_PS = WS_XS + 64 * 1024;
constexpr size_t WS_OS = WS_PS + 192 * 1024;
constexpr size_t WS_MIXS = WS_OS + 32 * 1024;
constexpr size_t WS_AS = WS_MIXS + 64 * 1024;
constexpr size_t WS_BT = WS_AS + 256 * 1024;
constexpr size_t WS_GN = WS_BT + 32 * 1024;
constexpr size_t WS_CW = WS_GN + 4 * 1024;
constexpr size_t WS_SC = WS_CW + 64 * 1024;
constexpr size_t WS_SINK = WS_SMALL + 1 * MiB;
constexpr size_t WS_END = WS_SINK + 8 * MiB;
static_assert(WS_SC + 256 * 1024 <= WS_END, "small buffers");
constexpr int CW_BAR = 4096;

#ifndef EARLY_WBL2
#define EARLY_WBL2 0
#endif
#if EARLY_WBL2
#define EARLY_WB() asm volatile("buffer_wbl2 sc1" ::: "memory")
#else
#define EARLY_WB() do {} while (0)
#endif
#ifndef CONV_SKEW
#define CONV_SKEW 3
#endif
#ifndef COPY_IN_G4
#define COPY_IN_G4 0
#endif
#ifndef COPY_BOTH
#define COPY_BOTH 0
#endif
#ifndef CONV_RING
#define CONV_RING 0
#endif
#ifndef CONV_DP
#define CONV_DP 5
#endif
constexpr int LDS_BYTES = 147456;
constexpr int LDSCTL_OFF = LDS_BYTES - 512;
constexpr int MISC_OFF = LDSCTL_OFF;
constexpr int RS_TAB_OFF = 131072;
static_assert(RS_TAB_OFF + 4 * 256 * 4 <= LDSCTL_OFF, "LDS map");

#define GAS __attribute__((address_space(1)))
#define LAS __attribute__((address_space(3)))
typedef unsigned short bf16;
typedef unsigned v4u __attribute__((ext_vector_type(4)));
typedef unsigned v2u __attribute__((ext_vector_type(2)));
typedef float f32x4 __attribute__((ext_vector_type(4)));
typedef float f32x2 __attribute__((ext_vector_type(2)));
typedef float f32x16 __attribute__((ext_vector_type(16)));
typedef short bf16x8 __attribute__((ext_vector_type(8)));
typedef short s16x4 __attribute__((ext_vector_type(4)));
typedef GAS unsigned gu32;
#define RLX_AGENT __ATOMIC_RELAXED, __HIP_MEMORY_SCOPE_AGENT
using pg8::cvt_pk_bf16;
using pg8::pack8;

#define XB_TMO      128
#define XB_XCNT(j)  (256  + 64 * (j))
#define XB_XSUB(j)  (1280 + 64 * (j))
#define XB_XGEN(j)  (2304 + 64 * (j))
#define XB_TOP      3328
#define XB_TOPGEN   3392
#define XCD_BAR_WORDS 3456
#define XB_SPIN_CAP (1u << 18)

__device__ __forceinline__ unsigned xb_ld(unsigned* p)              { return __hip_atomic_load(p, __ATOMIC_RELAXED, __HIP_MEMORY_SCOPE_AGENT); }
__device__ __forceinline__ unsigned xb_add(unsigned* p, unsigned v) { return __hip_atomic_fetch_add(p, v, __ATOMIC_RELAXED, __HIP_MEMORY_SCOPE_AGENT); }
__device__ __forceinline__ unsigned xb_xcc_id() { return (unsigned)__builtin_amdgcn_s_getreg((3 << 11) | 20) & 0xFu; }
#define XB_SPIN(cond, bar) do { unsigned _sp = 0; while (cond) { __builtin_amdgcn_s_sleep(1); \
    if ((++_sp & 255u) == 0u) { if (xb_ld(&(bar)[XB_TMO])) break; if (_sp > XB_SPIN_CAP) { atomicAdd(&(bar)[XB_TMO], 1u); break; } } } } while (0)

__device__ __forceinline__ bool xb_lane0() { return __builtin_amdgcn_mbcnt_hi(~0u, __builtin_amdgcn_mbcnt_lo(~0u, 0u)) == 0u; }
struct XcdBarrier {
    int wave;
    unsigned* bar; unsigned x;
    volatile LAS unsigned* st;
};

__device__ __forceinline__ XcdBarrier xcd_barrier_post(unsigned* bar, volatile LAS unsigned* st, int wave) {
    XcdBarrier b; b.wave = wave; b.bar = bar; b.x = xb_xcc_id(); b.st = st;
    if (wave == 0 && xb_lane0()) (void)xb_add(&bar[XB_XCNT(b.x)], 1u);
    return b;
}
__device__ __forceinline__ void xcd_barrier_complete(unsigned* bar, unsigned x, unsigned& nloc, unsigned& nx) {
    const unsigned G = gridDim.x * gridDim.y * gridDim.z;
    unsigned sum, cnt, mine, sp = 0u;
    for (;;) {
        sum = 0u; cnt = 0u; mine = 0u;
#pragma unroll
        for (unsigned j = 0; j < 16; ++j) { const unsigned c = xb_ld(&bar[XB_XCNT(j)]); sum += c; cnt += (c > 0u) ? 1u : 0u; mine = (j == x) ? c : mine; }
        if (sum == G) break;
        __builtin_amdgcn_s_sleep(1);
        if ((++sp & 255u) == 0u) { if (xb_ld(&bar[XB_TMO])) break; if (sp > XB_SPIN_CAP) { atomicAdd(&bar[XB_TMO], 1u); break; } }
    }
    nloc = mine > 0u ? mine : 1u; nx = cnt > 0u ? cnt : 1u;
}

__device__ __forceinline__ void xcd_barrier(const XcdBarrier& b) {
    asm volatile("s_waitcnt vmcnt(0)" ::: "memory");
    __syncthreads();
    if (b.wave == 0 && xb_lane0()) {
        unsigned* bar = b.bar;
        __builtin_amdgcn_s_waitcnt(0);
        unsigned nloc = b.st[0], nx = b.st[1];
        if (nloc == 0u) { xcd_barrier_complete(bar, b.x, nloc, nx); b.st[0] = nloc; b.st[1] = nx; }
        const unsigned old = xb_add(&bar[XB_XSUB(b.x)], 1u);
        const unsigned gen = old / nloc;
        if (old + 1u == (gen + 1u) * nloc) {
            __builtin_amdgcn_fence(__ATOMIC_RELEASE, "agent");
            asm volatile("s_waitcnt vmcnt(0)" ::: "memory");
            const unsigned og = xb_add(&bar[XB_TOP], 1u);
            const unsigned tg = og / nx;
            if (og + 1u == (tg + 1u) * nx) xb_add(&bar[XB_TOPGEN], 1u);
            else XB_SPIN(xb_ld(&bar[XB_TOPGEN]) == tg, bar);
            __builtin_amdgcn_fence(__ATOMIC_ACQUIRE, "agent");
            xb_add(&bar[XB_XGEN(b.x)], 1u);
            asm volatile("s_waitcnt vmcnt(0)" ::: "memory");
        } else {
            XB_SPIN(xb_ld(&bar[XB_XGEN(b.x)]) == gen, bar);
            __builtin_amdgcn_fence(__ATOMIC_ACQUIRE, "agent");
            asm volatile("s_waitcnt vmcnt(0)" ::: "memory");
        }
    }
    __syncthreads();
}


struct Frame {
    LAS unsigned char* lds;
    int tid, lane, wave, vcu, G;
    unsigned char* ws; float* out;
    const float *x_prompt, *state_k, *state_v;
};
template <class T> __device__ __forceinline__ T* opq(T* p) { GAS T* g = (GAS T*)p; asm volatile("" : "+s"(g)); return (T*)g; }
__device__ __forceinline__ int opqv(int x) { asm volatile("" : "+v"(x)); return x; }
__device__ __forceinline__ int fresh_tid(int wave) { int l = (int)__builtin_amdgcn_mbcnt_hi(~0u, __builtin_amdgcn_mbcnt_lo(~0u, 0u)); asm volatile("" : "+v"(l)); return 64 * wave + l; }
#define W_WIN(w) ((bf16*)((w) + WS_WIN))
#define W_WOUT(w) ((bf16*)((w) + WS_WOUT))
#define W_WUP(w) ((bf16*)((w) + WS_WUP))
#define W_WDN(w) ((bf16*)((w) + WS_WDN))
#define W_XB(w) ((bf16*)((w) + WS_XB))
#define W_Q(w) ((bf16*)((w) + WS_Q))
#define W_K(w) ((bf16*)((w) + WS_K))
#define W_V(w) ((bf16*)((w) + WS_V))
#define W_PC(w) ((bf16*)((w) + WS_PC))
#define W_MIX(w) ((bf16*)((w) + WS_MIX))
#define W_HB(w) ((bf16*)((w) + WS_HB))
#define W_OPB(w) ((bf16*)((w) + WS_OP))
#define W_ML(w) ((float*)((w) + WS_ML))
#define W_SSQA(w) ((float*)((w) + WS_SSQA))
#define W_SSQB(w) ((float*)((w) + WS_SSQB))
#define W_XS(w) ((float*)((w) + WS_XS))
#define W_PS(w) ((float*)((w) + WS_PS))
#define W_OS(w) ((float*)((w) + WS_OS))
#define W_MIXS(w) ((float*)((w) + WS_MIXS))
#define W_AS(w) ((float*)((w) + WS_AS))
#define W_BT(w) ((float*)((w) + WS_BT))
#define W_GN(w) ((float*)((w) + WS_GN))
#define W_CW(w) ((float*)((w) + WS_CW))
#define W_SC(w) ((float*)((w) + WS_SC))

__device__ __forceinline__ float wave_sum(float v) {
#pragma unroll
    for (int o = 1; o < 64; o <<= 1) v += __shfl_xor(v, o);
    return v;
}
__device__ __forceinline__ float wave_max(float v) {
#pragma unroll
    for (int o = 1; o < 64; o <<= 1) v = fmaxf(v, __shfl_xor(v, o));
    return v;
}
__device__ __forceinline__ float max3f(float a, float b, float c) { float r; asm("v_max3_f32 %0, %1, %2, %3" : "=v"(r) : "v"(a), "v"(b), "v"(c)); return r; }
#define LDS_WAIT() asm volatile("s_waitcnt lgkmcnt(0)" ::: "memory")
#define WG_BAR() do { asm volatile("s_waitcnt vmcnt(0) lgkmcnt(0)" ::: "memory"); __builtin_amdgcn_s_barrier(); asm volatile("" ::: "memory"); } while (0)

struct Args { const float* in[17]; float* out; unsigned char* ws; int ph_lo, ph_hi; };
struct P0Item { const float* W; const float* g; bf16* WT; int K, N, k0, n0, perm; };
__device__ __forceinline__ int win_row(int col) {
    if (col < 3072) return col;
    if (col < 4096) { const int c = col - 3072; return 3072 + 256 * (c >> 7) + 64 * ((c >> 5) & 3) + (c & 31); }
    if (col < 5120) return 5120 + (col - 4096);
    const int c = col - 5120; return 3072 + 256 * (c >> 7) + 64 * ((c >> 5) & 3) + 32 + (c & 31);
}
__device__ __forceinline__ void p0_item_load(const P0Item& d, int lane, f32x4 (&v)[8], float& gk) {
#pragma unroll
    for (int i = 0; i < 8; ++i) v[i] = __builtin_nontemporal_load((const f32x4*)(d.W + (size_t)(d.k0 + 8 * i + (lane >> 3)) * d.N + d.n0 + (lane & 7) * 4));
    gk = d.g ? d.g[d.k0 + lane] : 1.f;
}
__device__ __forceinline__ void p0_item_store(const P0Item& d, int lane, const f32x4 (&v)[8], float gk, LAS float* scr) {
#pragma unroll
    for (int i = 0; i < 8; ++i) { const int kk = 8 * i + (lane >> 3); const float gg = __shfl(gk, kk);
        LAS float* s = scr + kk * 33 + (lane & 7) * 4; s[0] = v[i][0] * gg; s[1] = v[i][1] * gg; s[2] = v[i][2] * gg; s[3] = v[i][3] * gg; }
    LDS_WAIT(); asm volatile("" ::: "memory");
    const int c = lane & 7;
#pragma unroll
    for (int j = 0; j < 4; ++j) { const int n = (lane >> 3) + 8 * j; const LAS float* s = scr + (8 * c) * 33 + n;
        v4u o; o.x = cvt_pk_bf16(s[0 * 33], s[1 * 33]); o.y = cvt_pk_bf16(s[2 * 33], s[3 * 33]); o.z = cvt_pk_bf16(s[4 * 33], s[5 * 33]); o.w = cvt_pk_bf16(s[6 * 33], s[7 * 33]);
        *(GAS v4u*)(d.WT + (size_t)(d.perm ? win_row(d.n0 + n) : d.n0 + n) * d.K + d.k0 + 8 * c) = o; }
    LDS_WAIT(); asm volatile("" ::: "memory");
}
__device__ __forceinline__ int t5_bucket(int dist) {
    if (dist < 16) return dist;
    int b = 16;
    b += dist >= 22; b += dist >= 30; b += dist >= 40; b += dist >= 54; b += dist >= 73; b += dist >= 99; b += dist >= 134; b += dist >= 182;
    b += dist >= 246; b += dist >= 332; b += dist >= 450; b += dist >= 609; b += dist >= 825; b += dist >= 1117; b += dist >= 1513;
    return b;
}
constexpr int I_IN = (D / 64) * (DIN / 32), I_OUT = (D / 64) * (D / 32), I_UP = (D / 64) * (DFF / 32), I_DN = (DFF / 64) * (D / 32);
__device__ __forceinline__ int conv_count(int stage) { return stage == 0 ? I_IN : stage < 16 ? I_OUT + I_UP : stage < 32 ? I_DN : (stage - 32 < DEPTH - 1 ? I_IN : 0); }
__device__ __forceinline__ void p0_item_desc(const Args& A, unsigned char* w, int stage, int it, P0Item& d) {
    int l = 0, r = it, mat = 0;
    if (stage == 0) { l = 0; mat = 0; }
    else if (stage < 16) { l = stage - 1; if (r < I_OUT) mat = 1; else { r -= I_OUT; mat = 2; } }
    else if (stage < 32) { l = stage - 16; mat = 3; }
    else { l = stage - 32 + 1; mat = 0; }
    d.perm = mat == 0;
    if (mat == 0) { d.W = A.in[7] + (size_t)l * D * DIN; d.K = D; d.N = DIN; d.g = A.in[6] + l * D; d.WT = W_WIN(w) + (size_t)l * DIN * D; }
    else if (mat == 1) { d.W = A.in[13] + (size_t)l * D * D; d.K = D; d.N = D; d.g = nullptr; d.WT = W_WOUT(w) + (size_t)l * D * D; }
    else if (mat == 2) { d.W = A.in[15] + (size_t)l * D * DFF; d.K = D; d.N = DFF; d.g = A.in[14] + l * D; d.WT = W_WUP(w) + (size_t)l * DFF * D; }
    else { d.W = A.in[16] + (size_t)l * DFF * D; d.K = DFF; d.N = D; d.g = nullptr; d.WT = W_WDN(w) + (size_t)l * D * DFF; }
    const int nblk = d.N / 32, kb = r / nblk; d.k0 = 64 * kb; d.n0 = 32 * (r - kb * nblk);
    if (mat == 1) d.g = (d.k0 < DA ? A.in[11] + l * DA : A.in[12] + l * DC - DA);
}
__device__ __forceinline__ void conv_run(const Args& A, unsigned char* w, int stage, int it0, int stride, int lane, LAS float* scr) {
    const int n = conv_count(stage);
    P0Item dc, dn; f32x4 vc[8], vn[8]; float gc = 1.f, gn = 1.f;
    int it = it0;
    if (it < n) { p0_item_desc(A, w, stage, it, dc); p0_item_load(dc, lane, vc, gc); }
    for (; it < n; it += stride) {
        const bool more = it + stride < n;
        if (more) { p0_item_desc(A, w, stage, it + stride, dn); p0_item_load(dn, lane, vn, gn); }
        p0_item_store(dc, lane, vc, gc, scr);
        if (more) { dc = dn; gc = gn;
#pragma unroll
            for (int i = 0; i < 8; ++i) vc[i] = vn[i]; }
    }
}
struct CDesc { const float* W; bf16* WT; int N, K, goff; };
__device__ __forceinline__ void cdesc(const Args& A, unsigned char* w, int stage, int it, int sinkoff, CDesc& d) {
    if (it < 0) { d.W = A.in[7]; d.N = 0; d.WT = (bf16*)(w + WS_SINK) + sinkoff; d.K = 64; d.goff = 3 * 2048; return; }
    int l = stage == 0 ? 0 : stage - 1, r = it, mat = 0;
    if (stage != 0) { if (r < I_OUT) mat = 1; else if ((r -= I_OUT) < I_UP) mat = 2; else if ((r -= I_UP) < I_DN) mat = 3; else { r -= I_DN; mat = 0; l += 1; } }
    const float* Wb; bf16* WTb; int K, N;
    if (mat == 0) { Wb = A.in[7] + (size_t)l * D * DIN; K = D; N = DIN; WTb = W_WIN(w) + (size_t)l * DIN * D; }
    else if (mat == 1) { Wb = A.in[13] + (size_t)l * D * D; K = D; N = D; WTb = W_WOUT(w) + (size_t)l * D * D; }
    else if (mat == 2) { Wb = A.in[15] + (size_t)l * D * DFF; K = D; N = DFF; WTb = W_WUP(w) + (size_t)l * DFF * D; }
    else { Wb = A.in[16] + (size_t)l * DFF * D; K = DFF; N = D; WTb = W_WDN(w) + (size_t)l * D * DFF; }
    const int nblk = N / 32, kb = r / nblk, k0 = 64 * kb, n0 = 32 * (r - kb * nblk);
    d.W = Wb + (size_t)k0 * N + n0; d.N = N; d.K = K;
    d.WT = WTb + (size_t)(mat == 0 ? win_row(n0) : n0) * K + k0;
    d.goff = mat == 3 ? 3 * 2048 : mat * 2048 + k0;
}
__device__ __forceinline__ void conv_fill_gains(const Args& A, int stage, LAS float* gtab, int tid) {
    const int l = stage == 0 ? 0 : stage - 1, lin = stage == 0 ? 0 : (stage < DEPTH ? stage : DEPTH - 1);
    for (int e = tid; e < 4 * 2048; e += NWAVES * 64) { const int t = e >> 11, k = e & 2047;
        gtab[e] = t == 0 ? A.in[6][lin * D + k] : t == 1 ? (k < DA ? A.in[11][l * DA + k] : A.in[12][l * DC + k - DA]) : t == 2 ? A.in[14][l * D + k] : 1.f; }
}
__device__ __forceinline__ int conv_ticket(LAS unsigned* q, int lane);
template <int DP>
__device__ __forceinline__ void conv_ring(const Args& A, unsigned char* w, int stage, int vcu, int G, int lane, const LAS float* gtab, LAS unsigned* q, int gwave) {
    const int nk = conv_count(stage) / G;
    const int lq = lane & 7, lc = lane >> 3, bp = 4 * ((lane >> 3) + 8 * (lane & 7)), sinkoff = gwave * 2048;
    f32x4 v[DP][8]; int kt[DP];
#define CR_LOAD(s_) do { CDesc d_; cdesc(A, w, stage, kt[s_] < nk ? vcu * nk + kt[s_] : -1, sinkoff, d_); const float* wp_ = d_.W + (size_t)(8 * lc) * d_.N + 4 * lq; \
        _Pragma("unroll") for (int i = 0; i < 8; ++i) v[s_][i] = __builtin_nontemporal_load((const f32x4*)(wp_ + (size_t)i * d_.N)); } while (0)
#define CR_STORE(s_) do { CDesc d_; cdesc(A, w, stage, kt[s_] < nk ? vcu * nk + kt[s_] : -1, sinkoff, d_); \
        const LAS f32x4* gp_ = (const LAS f32x4*)(gtab + d_.goff + 8 * lc); const f32x4 g0_ = gp_[0], g1_ = gp_[1]; \
        bf16* op_ = d_.WT + (size_t)(4 * lc) * d_.K + 8 * lq;              \
        _Pragma("unroll") for (int e = 0; e < 4; ++e) { v4u o_; \
            o_.x = (unsigned)__builtin_amdgcn_ds_bpermute(bp, (int)cvt_pk_bf16(v[s_][0][e] * g0_[0], v[s_][1][e] * g0_[1])); \
            o_.y = (unsigned)__builtin_amdgcn_ds_bpermute(bp, (int)cvt_pk_bf16(v[s_][2][e] * g0_[2], v[s_][3][e] * g0_[3])); \
            o_.z = (unsigned)__builtin_amdgcn_ds_bpermute(bp, (int)cvt_pk_bf16(v[s_][4][e] * g1_[0], v[s_][5][e] * g1_[1])); \
            o_.w = (unsigned)__builtin_amdgcn_ds_bpermute(bp, (int)cvt_pk_bf16(v[s_][6][e] * g1_[2], v[s_][7][e] * g1_[3])); \
            *(GAS v4u*)(op_ + (size_t)e * d_.K) = o_; } } while (0)
#pragma unroll
    for (int s = 0; s < DP; ++s) {
        kt[s] = conv_ticket(q, lane);
        { bf16* sk = (bf16*)(w + WS_SINK) + sinkoff + (4 * lc) * 64 + 8 * lq;
#pragma unroll
          for (int e = 0; e < 4; ++e) *(GAS v4u*)(sk + e * 64) = (v4u){0u, 0u, 0u, 0u}; }
        CR_LOAD(s);
    }
    while (kt[0] < nk) {
#pragma unroll
        for (int s = 0; s < DP; ++s) { CR_STORE(s); kt[s] = conv_ticket(q, lane); CR_LOAD(s); }
    }
#undef CR_LOAD
#undef CR_STORE
}
__device__ __forceinline__ void p0_prologue(Frame& F, const Args& A) {
    unsigned char* w = F.ws;
    const int gw = F.vcu * NWAVES + F.wave, NGW = F.G * NWAVES;
#if CONV_RING
    { LAS float* gtab = (LAS float*)(F.lds + 1024); LAS unsigned* tq = (LAS unsigned*)F.lds;
      conv_fill_gains(A, 0, gtab, F.tid); if (F.tid == 0) tq[0] = 0u;
      WG_BAR();
      conv_ring<CONV_DP>(A, w, 0, F.vcu, F.G, F.lane, gtab, tq, gw); }
#else
    conv_run(A, w, 0, gw, NGW, F.lane, (LAS float*)(F.lds + F.wave * 8448));
#endif
    for (int m = gw; m < M; m += NGW) {
        const GAS f32x4* xr = (const GAS f32x4*)(A.in[0] + (size_t)m * D) + F.lane; GAS v2u* o8 = (GAS v2u*)(W_XB(w) + (size_t)m * D) + F.lane;
        float s = 0.f;
#pragma unroll
        for (int j = 0; j < 8; ++j) { const f32x4 v = xr[64 * j]; s += (v[0] * v[0] + v[1] * v[1]) + (v[2] * v[2] + v[3] * v[3]); v2u pw; pw.x = cvt_pk_bf16(v[0], v[1]); pw.y = cvt_pk_bf16(v[2], v[3]); o8[64 * j] = pw; }
        s = wave_sum(s);
        if (F.lane < 8) W_SSQA(w)[(size_t)m * 8 + F.lane] = F.lane == 0 ? s : 0.f;
    }
    const int gt = F.vcu * (NWAVES * 64) + F.tid, NGT = F.G * NWAVES * 64;
    for (int i = gt; i < SB * D; i += NGT) W_XS(w)[i] = A.in[1][i];
    for (int i = gt; i < DEPTH * 128; i += NGT) { const int l = i >> 7, r = i & 127; W_GN(w)[i] = r < 64 ? A.in[8][l * 64 + r] : A.in[9][l * 64 + r - 64]; }
    for (int i = gt; i < DEPTH * 3 * DC; i += NGT) W_CW(w)[i] = A.in[10][i];
    for (int i = gt; i < DEPTH * SB * 2 * DC; i += NGT) W_SC(w)[i] = A.in[4][i];
    for (int i = gt; i < 3 * 16 * 129; i += NGT) { const int c = i / (16 * 129), r = i - c * (16 * 129), h = r / 129, j = r - h * 129; W_BT(w)[i] = A.in[5][t5_bucket(j << (2 * c)) * 16 + h] * LOG2E; }
#if COPY_IN_P0
    { constexpr int ROWV = 1024 / 4, PER = (WBUF - 1) * ROWV, TOT = DEPTH * SB * PER;
      for (int i0 = gt; i0 < 2 * TOT; i0 += 8 * NGT) { f32x4 v[8];
#pragma unroll
          for (int u = 0; u < 8; ++u) { const int i = i0 + u * NGT; if (i < 2 * TOT) { const int kv = i >= TOT, r = i - kv * TOT, lb = r / PER, e = r - lb * PER;
              v[u] = __builtin_nontemporal_load((const f32x4*)(kv ? A.in[3] : A.in[2]) + (size_t)lb * (WBUF * ROWV) + ROWV + e); } }
#pragma unroll
          for (int u = 0; u < 8; ++u) { const int i = i0 + u * NGT; if (i < 2 * TOT) { const int kv = i >= TOT, r = i - kv * TOT, lb = r / PER, e = r - lb * PER;
              __builtin_nontemporal_store(v[u], (f32x4*)(F.out + (kv ? O_VS : O_KS)) + (size_t)lb * (WBUF * ROWV) + e); } } } }
#endif
}

template <int MODE, int K, int N>
__device__ __forceinline__ void sgemv(Frame& F, const float* A, const bf16* Wt, float* out, float* yout) {
    constexpr int NPW = N / 256, NG = (NPW + 15) / 16, KW = K / 8, STEPS = KW / 32;
    LAS float* red = (LAS float*)F.lds;
    LAS float* sq = (LAS float*)(F.lds + 8 * NG * 1024);
    const int lane = F.lane, wv = F.wave, fr = lane & 15, fq = lane >> 4;
    const int n0 = (F.vcu & 255) * NPW;
    {
        f32x4 acc[NG];
#pragma unroll
        for (int g = 0; g < NG; ++g) acc[g] = (f32x4){0.f, 0.f, 0.f, 0.f};
        float ssq = 0.f;
        const float* ap = A + (size_t)(fr & 7) * K + wv * KW + fq * 8;
        const bf16* wp[NG];
#pragma unroll
        for (int g = 0; g < NG; ++g) { const int nl = 16 * g + fr; wp[g] = Wt + (size_t)(n0 + (nl < NPW ? nl : NPW - 1)) * K + wv * KW + fq * 8; }
#pragma unroll 16
        for (int s = 0; s < STEPS; ++s) {
            v4u yw = {0u, 0u, 0u, 0u};
            if (fr < 8) { const f32x4 a0 = *(const f32x4*)(ap + 32 * s), a1 = *(const f32x4*)(ap + 32 * s + 4); yw = pack8(a0, a1);
                ssq += ((a0[0] * a0[0] + a0[1] * a0[1]) + (a0[2] * a0[2] + a0[3] * a0[3])) + ((a1[0] * a1[0] + a1[1] * a1[1]) + (a1[2] * a1[2] + a1[3] * a1[3])); }
#pragma unroll
            for (int g = 0; g < NG; ++g) { const bf16x8 X = *(const bf16x8*)(wp[g] + 32 * s); acc[g] = __builtin_amdgcn_mfma_f32_16x16x32_bf16(X, __builtin_bit_cast(bf16x8, yw), acc[g], 0, 0, 0); }
        }
#pragma unroll
        for (int g = 0; g < NG; ++g) *(LAS f32x4*)(red + (wv * NG + g) * 256 + lane * 4) = acc[g];
        if (MODE == 0 || MODE == 2) { ssq += __shfl_xor(ssq, 16); ssq += __shfl_xor(ssq, 32); if (lane < 8) sq[wv * 8 + lane] = ssq; }
    }
    float prev = 0.f;
    if ((MODE == 1 || MODE == 3) && F.tid < 8 * NPW) prev = out[(size_t)(F.tid & 7) * N + n0 + (F.tid >> 3)];
    WG_BAR();
    if (F.tid < 8 * NPW) {
        const int nl = F.tid >> 3, tok = F.tid & 7, g = nl >> 4, lp = ((nl & 15) >> 2) * 16 + tok, i = nl & 3;
        float v = 0.f;
#pragma unroll
        for (int ww = 0; ww < 8; ++ww) v += red[(ww * NG + g) * 256 + lp * 4 + i];
        float rs = 1.f;
        if (MODE == 0 || MODE == 2) { float q = 0.f;
#pragma unroll
            for (int ww = 0; ww < 8; ++ww) q += sq[ww * 8 + tok];
            rs = __builtin_amdgcn_rsqf(q * (1.0f / (float)K) + EPS); }
        float* op = out + (size_t)tok * N + n0 + nl;
        if (MODE == 0) *op = v * rs;
        else if (MODE == 2) { const float z = fmaxf(v * rs, 0.f); *op = z * z; }
        else { const float z = prev + v; *op = z; if (yout) yout[(size_t)tok * N + n0 + nl] = z; }
    }
}

constexpr int ATT_BT_BYTES = 48 * 192 * 4, ATT_V_BYTES = 32 * 192;
constexpr int NCP = 32;
__device__ __forceinline__ void attn_phase_prompt(Frame& F, unsigned char* w, float* out, int l, int mode = 3) {
    const int lane = F.lane, r = lane & 31, hh = lane >> 5;
    LAS float* btall = (LAS float*)F.lds;
    for (int e = F.tid; e < 48 * 192; e += NWAVES * 64) { const int t = e / 192, j = 160 - (e - t * 192); btall[e] = (j >= 0 && j <= 128) ? W_BT(w)[t * 129 + (j < 0 ? 0 : (j > 128 ? 128 : j))] : -1.0e30f; }
    WG_BAR();
    LAS unsigned char* vl = F.lds + ATT_BT_BYTES + F.wave * ATT_V_BYTES;
    const int trq = (lane & 15) >> 2, trp = lane & 3, g16 = (lane >> 4) & 1;
    LAS unsigned char* vtr0 = vl + (4 * hh + trq) * 192 + g16 * 32 + trp * 8;
    constexpr int NMOVE = ATT_NMOVE, NWORK = NWAVES - NMOVE;
    if (NMOVE > 0 && F.wave >= NWORK) {
        if (!(mode & 2)) return;
        const int mv = F.wave - NWORK;
        constexpr int CP_PER = (WBUF - 1) * 256, CP_HALF = SB * CP_PER, CP_TOT = 2 * CP_HALF, CP_ROWS = (CP_TOT + 63) / 64;
        for (int k0 = mv * NCP; k0 * F.G < CP_ROWS; k0 += (NMOVE > 0 ? NMOVE : 1) * NCP) {
            f32x4 cpv[NCP];
#pragma unroll
            for (int u = 0; u < NCP; ++u) { int ci = ((k0 + u) * F.G + F.vcu) * 64 + lane; ci = ci < CP_TOT ? ci : CP_TOT - 1;
                const int kv = ci >= CP_HALF, rr = ci - kv * CP_HALF, bb = rr / CP_PER, ee = rr - bb * CP_PER;
                cpv[u] = __builtin_nontemporal_load((const f32x4*)(kv ? F.state_v : F.state_k) + ((size_t)(l * SB + bb) * WBUF + 1) * 256 + ee); }
#pragma unroll
            for (int u = 0; u < NCP; ++u) { const int ci = ((k0 + u) * F.G + F.vcu) * 64 + lane;
                if (ci < CP_TOT) { const int kv = ci >= CP_HALF, rr = ci - kv * CP_HALF, bb = rr / CP_PER, ee = rr - bb * CP_PER;
                    __builtin_nontemporal_store(cpv[u], (f32x4*)(out + (kv ? O_VS : O_KS)) + ((size_t)(l * SB + bb) * WBUF) * 256 + ee); } }
        }
        return;
    }
    if (!(mode & 1)) return;
    const int ntile = (3 * (NB * H * 8) / F.G * 8 - F.wave + NWORK - 1) / NWORK;
#define TILE_SETUP(j_, C_, DSH_, RHO_, I0_, KB0_, HB_, BH_) do { const int t_ = F.wave + NWORK * (j_), i_ = t_ >> 3, c_ = i_ % 3, idx_ = (i_ / 3) * F.G + F.vcu; C_ = c_; DSH_ = 2 * c_; BH_ = idx_ >> 3; \
        const int f0_ = 256 * (idx_ & 7) + 32 * (t_ & 7); RHO_ = f0_ >> (11 - DSH_); I0_ = f0_ & ((2048 >> DSH_) - 1); KB0_ = I0_ >= 128 ? 0 : ((128 - I0_) >> 5); HB_ = (size_t)BH_ * 2048 * 64; } while (0)
#define LOAD_Q(QF, HB_, DSH_, RHO_, I0_) do { const char* qt_ = (const char*)(W_Q(w) + HB_ + (RHO_) * 64) + ((size_t)((I0_) << (DSH_))) * 128; const unsigned ql_ = ((unsigned)(r << (DSH_))) * 128u + 64u * hh; \
        _Pragma("unroll") for (int s = 0; s < 4; ++s) QF[s] = *(const bf16x8*)(qt_ + ql_ + 16 * s); } while (0)
#define LOAD_KV(KF, VV, kb_, HB_, DSH_, RHO_, I0_, KB0_) do { const int kbe_ = (kb_) < (KB0_) ? (KB0_) : (kb_); const size_t bo_ = ((size_t)(((I0_) - 128 + 32 * kbe_) << (DSH_))) * 128; \
        const char* kt_ = (const char*)(W_K(w) + HB_ + (RHO_) * 64) + bo_; const char* vt_ = (const char*)(W_V(w) + HB_ + (RHO_) * 64) + bo_; \
        const unsigned kl_ = ((unsigned)(r << (DSH_))) * 128u + 64u * hh, vl_ = ((unsigned)((lane >> 3) << (DSH_))) * 128u + 16u * (lane & 7), vs_ = (8u << (DSH_)) * 128u; \
        _Pragma("unroll") for (int s = 0; s < 4; ++s) KF[s] = *(const bf16x8*)(kt_ + kl_ + 16 * s); \
        _Pragma("unroll") for (int c4 = 0; c4 < 4; ++c4) VV[c4] = *(const v4u*)(vt_ + vl_ + c4 * vs_); } while (0)
#define VTR(p) __builtin_bit_cast(s16x4, __builtin_amdgcn_ds_read_tr16_b64_v4i16((LAS s16x4*)(p)))
#define VFRAG(db, s) ({ const s16x4 lo_ = VTR(vtr0 + (16 * (s)) * 192 + (db) * 64), hi_ = VTR(vtr0 + (16 * (s) + 8) * 192 + (db) * 64); (bf16x8){lo_[0], lo_[1], lo_[2], lo_[3], hi_[0], hi_[1], hi_[2], hi_[3]}; })
#define ATT_COMPUTE(KF, VV, kb_) do { \
        _Pragma("unroll") for (int c4 = 0; c4 < 4; ++c4) *(LAS v4u*)(vl + ((lane >> 3) + 8 * c4) * 192 + (lane & 7) * 16) = VV[c4]; \
        const int bidx = 32 - r + 4 * hh + 32 * (kb_);            \
        f32x16 sT; _Pragma("unroll") for (int k = 0; k < 16; ++k) sT[k] = bt[bidx + (k & 3) + 8 * (k >> 2)];        \
        _Pragma("unroll") for (int s = 0; s < 4; ++s) sT = __builtin_amdgcn_mfma_f32_32x32x16_bf16(KF[s], qf[s], sT, 0, 0, 0); \
        asm volatile("s_nop 15\n\ts_nop 7" : "+v"(sT));            \
        float mx = max3f(max3f(sT[0], sT[1], sT[2]), max3f(sT[3], sT[4], sT[5]), max3f(sT[6], sT[7], sT[8])); \
        mx = max3f(mx, max3f(sT[9], sT[10], sT[11]), max3f(sT[12], sT[13], max3f(sT[14], sT[15], sT[15]))); \
        mx = max3f(mx, __shfl_xor(mx, 32), mx); \
        if (__any(mx > m_run + 8.0f)) {                            \
            const float m_new = max3f(m_run, mx, mx), alpha = __builtin_amdgcn_exp2f(m_run - m_new); m_run = m_new; l_run *= alpha; \
            _Pragma("unroll") for (int k = 0; k < 16; ++k) { o0[k] *= alpha; o1[k] *= alpha; } } \
        _Pragma("unroll") for (int k = 0; k < 16; ++k) sT[k] = __builtin_amdgcn_exp2f(sT[k] - m_run); \
        l_run += (((sT[0] + sT[1]) + (sT[2] + sT[3])) + ((sT[4] + sT[5]) + (sT[6] + sT[7]))) + (((sT[8] + sT[9]) + (sT[10] + sT[11])) + ((sT[12] + sT[13]) + (sT[14] + sT[15]))); \
        v4u pw0, pw1; \
        pw0.x = cvt_pk_bf16(sT[0], sT[1]); pw0.y = cvt_pk_bf16(sT[2], sT[3]); pw0.z = cvt_pk_bf16(sT[4], sT[5]); pw0.w = cvt_pk_bf16(sT[6], sT[7]); \
        pw1.x = cvt_pk_bf16(sT[8], sT[9]); pw1.y = cvt_pk_bf16(sT[10], sT[11]); pw1.z = cvt_pk_bf16(sT[12], sT[13]); pw1.w = cvt_pk_bf16(sT[14], sT[15]); \
        const bf16x8 pk0 = __builtin_bit_cast(bf16x8, pw0), pk1 = __builtin_bit_cast(bf16x8, pw1); \
        const bf16x8 v00 = VFRAG(0, 0), v01 = VFRAG(0, 1), v10 = VFRAG(1, 0), v11 = VFRAG(1, 1); \
        o0 = __builtin_amdgcn_mfma_f32_32x32x16_bf16(v00, pk0, o0, 0, 0, 0); o0 = __builtin_amdgcn_mfma_f32_32x32x16_bf16(v01, pk1, o0, 0, 0, 0); \
        o1 = __builtin_amdgcn_mfma_f32_32x32x16_bf16(v10, pk0, o1, 0, 0, 0); o1 = __builtin_amdgcn_mfma_f32_32x32x16_bf16(v11, pk1, o1, 0, 0, 0); } while (0)
    int c, dsh, rho, i0, kb0, bh; size_t hb;
    TILE_SETUP(0, c, dsh, rho, i0, kb0, hb, bh);
    bf16x8 qf[4], kA[4], kB[4]; v4u vA[4];
    LOAD_Q(qf, hb, dsh, rho, i0);
    { v4u vdummy[4]; LOAD_KV(kA, vA, 0, hb, dsh, rho, i0, kb0); LOAD_KV(kB, vdummy, 1, hb, dsh, rho, i0, kb0); (void)vdummy; }
    for (int i = 0; i < ntile; ++i) {
        int c2 = 0, dsh2 = 0, rho2 = 0, i02 = 0, kb02 = 0, bh2 = 0; size_t hb2 = 0; const bool has_next = i + 1 < ntile;
        if (has_next) TILE_SETUP(i + 1, c2, dsh2, rho2, i02, kb02, hb2, bh2);
        const LAS float* bt = btall + (c * 16 + (bh & 15)) * 192;
        float m_run = -1.0e30f, l_run = 0.f;
        f32x16 o0, o1;
#pragma unroll
        for (int k = 0; k < 16; ++k) { o0[k] = 0.f; o1[k] = 0.f; }
        bf16x8 kC[4], kD[4], kE[4]; v4u vB[4], vC[4], vD[4], vE[4];
#define SB0() __builtin_amdgcn_sched_barrier(0)
#define LOAD_K(KF, kb_, HB_, DSH_, RHO_, I0_, KB0_) do { const int kbe_ = (kb_) < (KB0_) ? (KB0_) : (kb_); const char* kt_ = (const char*)(W_K(w) + HB_ + (RHO_) * 64) + ((size_t)(((I0_) - 128 + 32 * kbe_) << (DSH_))) * 128; \
        const unsigned kl_ = ((unsigned)(r << (DSH_))) * 128u + 64u * hh; if (!(mode & 8)) { _Pragma("unroll") for (int s = 0; s < 4; ++s) KF[s] = *(const bf16x8*)(kt_ + kl_ + 16 * s); } } while (0)
#define LOAD_V(VV, kb_, HB_, DSH_, RHO_, I0_, KB0_) do { const int kbe_ = (kb_) < (KB0_) ? (KB0_) : (kb_); const char* vt_ = (const char*)(W_V(w) + HB_ + (RHO_) * 64) + ((size_t)(((I0_) - 128 + 32 * kbe_) << (DSH_))) * 128; \
        const unsigned vl_ = ((unsigned)((lane >> 3) << (DSH_))) * 128u + 16u * (lane & 7), vs_ = (8u << (DSH_)) * 128u; if (!(mode & 8)) { _Pragma("unroll") for (int c4 = 0; c4 < 4; ++c4) VV[c4] = *(const v4u*)(vt_ + vl_ + c4 * vs_); } } while (0)
        SB0(); LOAD_K(kC, 2, hb, dsh, rho, i0, kb0); LOAD_V(vB, 1, hb, dsh, rho, i0, kb0); SB0();
        if (kb0 <= 0) ATT_COMPUTE(kA, vA, 0);
        SB0(); LOAD_K(kD, 3, hb, dsh, rho, i0, kb0); LOAD_V(vC, 2, hb, dsh, rho, i0, kb0); SB0();
        if (kb0 <= 1) ATT_COMPUTE(kB, vB, 1);
        SB0(); LOAD_K(kE, 4, hb, dsh, rho, i0, kb0); LOAD_V(vD, 3, hb, dsh, rho, i0, kb0); SB0();
        if (kb0 <= 2) ATT_COMPUTE(kC, vC, 2);
        SB0(); if (has_next) LOAD_K(kA, 0, hb2, dsh2, rho2, i02, kb02); LOAD_V(vE, 4, hb, dsh, rho, i0, kb0); SB0();
        if (kb0 <= 3) ATT_COMPUTE(kD, vD, 3);
        SB0(); if (has_next) { LOAD_K(kB, 1, hb2, dsh2, rho2, i02, kb02); LOAD_V(vA, 0, hb2, dsh2, rho2, i02, kb02); } SB0();
        ATT_COMPUTE(kE, vE, 4);
        SB0(); if (has_next) LOAD_Q(qf, hb2, dsh2, rho2, i02); SB0();
#undef SB0
#undef LOAD_K
#undef LOAD_V
        const float l_tot = l_run + __shfl_xor(l_run, 32);
        const int grow = (bh >> 4) * 2048 + (((i0 + r) << dsh) + rho);
#pragma unroll
        for (int g4 = 0; g4 < 4; ++g4) {
            v2u a, b2; a.x = cvt_pk_bf16(o0[4 * g4], o0[4 * g4 + 1]); a.y = cvt_pk_bf16(o0[4 * g4 + 2], o0[4 * g4 + 3]); b2.x = cvt_pk_bf16(o1[4 * g4], o1[4 * g4 + 1]); b2.y = cvt_pk_bf16(o1[4 * g4 + 2], o1[4 * g4 + 3]);
            *(LAS v2u*)(vl + r * 144 + (8 * g4 + 4 * hh) * 2) = a; *(LAS v2u*)(vl + r * 144 + (32 + 8 * g4 + 4 * hh) * 2) = b2;
        }
#pragma unroll
        for (int q4 = 0; q4 < 4; ++q4) { const int rq = q4 * 8 + (lane >> 3), ch = lane & 7;
            const v4u v = *(const LAS v4u*)(vl + rq * 144 + ch * 16);
            const int grow_q = (bh >> 4) * 2048 + (((i0 + rq) << dsh) + rho);
            if (!(mode & 16)) *(v4u*)(W_OPB(w) + ((size_t)c * M + grow_q) * 1024 + (bh & 15) * 64 + ch * 8) = v; }
        if (hh == 0 && !(mode & 16)) *(f32x2*)(W_ML(w) + (((size_t)c * M + grow) * 16 + (bh & 15)) * 2) = (f32x2){m_run, l_tot};
        c = c2; dsh = dsh2; rho = rho2; i0 = i02; kb0 = kb02; hb = hb2; bh = bh2;
    }
#undef ATT_COMPUTE
#undef VFRAG
#undef VTR
#undef TILE_SETUP
#undef LOAD_Q
#undef LOAD_KV
}

__device__ __forceinline__ int conv_ticket(LAS unsigned* q, int lane) {
    unsigned v = 0u;
    if (lane == 0) v = __hip_atomic_fetch_add(q, 1u, __ATOMIC_RELAXED, __HIP_MEMORY_SCOPE_WORKGROUP);
    return (int)__builtin_amdgcn_readfirstlane(v);
}
__device__ __forceinline__ void conv_run_dyn(const Args& A, unsigned char* w, int stage, int vcu, int G, int lane, LAS float* scr, LAS unsigned* q) {
    const int nk0 = conv_count(stage) / G, hasS = (2 * SB * H == G && stage >= 1 && stage < 16) ? (vcu < SB * H) : -1;
    const int nk = hasS < 0 ? nk0 : (hasS ? nk0 - CONV_SKEW : nk0 + CONV_SKEW), base = hasS < 0 ? vcu * nk0 : (hasS ? vcu * (nk0 - CONV_SKEW) : SB * H * (nk0 - CONV_SKEW) + (vcu - SB * H) * (nk0 + CONV_SKEW));
    P0Item dc, dn; f32x4 vc[8], vn[8]; float gc = 1.f, gn = 1.f;
    int k = conv_ticket(q, lane);
    if (k < nk) { p0_item_desc(A, w, stage, base + k, dc); p0_item_load(dc, lane, vc, gc); }
    while (k < nk) {
        const int k2 = conv_ticket(q, lane);
        if (k2 < nk) { p0_item_desc(A, w, stage, base + k2, dn); p0_item_load(dn, lane, vn, gn); }
        p0_item_store(dc, lane, vc, gc, scr);
        if (k2 < nk) { dc = dn; gc = gn;
#pragma unroll
            for (int i = 0; i < 8; ++i) vc[i] = vn[i]; }
        k = k2;
    }
}

__device__ __forceinline__ void att4_wait(volatile LAS unsigned* p, unsigned target);
__device__ __forceinline__ void team_bar(LAS unsigned* cnt, unsigned& epoch, int lane) {
    asm volatile("s_waitcnt vmcnt(0) lgkmcnt(0)" ::: "memory");
    if (lane == 0) (void)__hip_atomic_fetch_add(cnt, 1u, __ATOMIC_RELAXED, __HIP_MEMORY_SCOPE_WORKGROUP);
    ++epoch;
    att4_wait((volatile LAS unsigned*)cnt, 4u * epoch);
}
__device__ __forceinline__ void attn_sample_team(Frame& F, unsigned char* w, float* out, int l, int b, int h, int wv, LAS unsigned* tcnt) {
    LAS float* sm = (LAS float*)F.lds;
    const int lane = F.lane, t = wv * 64 + lane;
    unsigned epoch = 0u;
    const float* ps = W_PS(w) + (size_t)b * DIN;
    const size_t sbase = ((size_t)(l * SB + b) * WBUF) * 1024 + h * 64;
    const int e0 = t, c0 = e0 / 129, j0 = e0 - c0 * 129;
    f32x4 kreg[16];
    { const f32x4* kr = (const f32x4*)(F.state_k + sbase + (size_t)(j0 == 0 ? WBUF - 1 : WBUF - (j0 << (2 * c0))) * 1024);
#pragma unroll
      for (int d4 = 0; d4 < 16; ++d4) kreg[d4] = kr[d4]; }
    if (wv == 0) {
        const float qr = ps[h * 64 + lane], kr = ps[1024 + h * 64 + lane], vr = ps[2048 + h * 64 + lane];
        const float sq = wave_sum(qr * qr), sk = wave_sum(kr * kr);
        const float* gn = W_GN(w) + l * 128;
        const float qn = qr * __builtin_amdgcn_rsqf(sq * (1.0f / 64.0f) + EPS) * gn[lane] * QSCALE;
        const float kn = kr * __builtin_amdgcn_rsqf(sk * (1.0f / 64.0f) + EPS) * gn[64 + lane];
        sm[lane] = qn; sm[64 + lane] = kn; sm[128 + lane] = vr;
        out[O_KS + sbase + (size_t)(WBUF - 1) * 1024 + lane] = kn;
        out[O_VS + sbase + (size_t)(WBUF - 1) * 1024 + lane] = vr;
    }
    team_bar(tcnt, epoch, lane);
    {   float a = 0.f;
#pragma unroll
        for (int d4 = 0; d4 < 16; ++d4) { const f32x4 q4 = *(const LAS f32x4*)(sm + 4 * d4); f32x4 kv = kreg[d4]; if (j0 == 0) kv = *(const LAS f32x4*)(sm + 64 + 4 * d4);
            a += (kv[0] * q4[0] + kv[1] * q4[1]) + (kv[2] * q4[2] + kv[3] * q4[3]); }
        sm[192 + e0] = a + W_BT(w)[(c0 * 16 + h) * 129 + j0];
    }
    if (t + 256 < 387) {
        const int e1 = t + 256, c1 = e1 / 129, j1 = e1 - c1 * 129;
        const f32x4* kr = (const f32x4*)(F.state_k + sbase + (size_t)(j1 == 0 ? WBUF - 1 : WBUF - (j1 << (2 * c1))) * 1024);
        float a = 0.f;
#pragma unroll
        for (int d4 = 0; d4 < 16; ++d4) { const f32x4 q4 = *(const LAS f32x4*)(sm + 4 * d4); f32x4 kv = kr[d4]; if (j1 == 0) kv = *(const LAS f32x4*)(sm + 64 + 4 * d4);
            a += (kv[0] * q4[0] + kv[1] * q4[1]) + (kv[2] * q4[2] + kv[3] * q4[3]); }
        sm[192 + e1] = a + W_BT(w)[(c1 * 16 + h) * 129 + j1];
    }
    const int kg = t >> 4, dq = t & 15;
    f32x4 vreg[13];
#pragma unroll
    for (int i = 0; i < 13; ++i) { int ee = kg + 16 * i; const int cc = ee / 129, jj = ee - cc * 129;
        vreg[i] = *(const f32x4*)(F.state_v + sbase + (size_t)(jj == 0 ? WBUF - 1 : WBUF - (jj << (2 * cc))) * 1024 + dq * 4); }
    team_bar(tcnt, epoch, lane);
    float mx = -1.0e30f;
    for (int x = lane; x < 387; x += 64) mx = fmaxf(mx, sm[192 + x]);
    mx = wave_max(mx);
    float sum = 0.f;
    for (int x = lane; x < 387; x += 64) sum += __builtin_amdgcn_exp2f(sm[192 + x] - mx);
    sum = wave_sum(sum);
    f32x4 o = {0.f, 0.f, 0.f, 0.f};
#pragma unroll
    for (int i = 0; i < 13; ++i) { const int ee = kg + 16 * i;
        const float p = __builtin_amdgcn_exp2f(sm[192 + ee] - mx); f32x4 vv = vreg[i]; if (ee == 0 || ee == 129 || ee == 258) vv = *(const LAS f32x4*)(sm + 128 + dq * 4); o += vv * p; }
#pragma unroll
    for (int i = 13; i < 25; ++i) { int ee = kg + 16 * i; if (ee < 387) { const int cc = ee / 129, jj = ee - cc * 129;
        f32x4 vv = *(const f32x4*)(F.state_v + sbase + (size_t)(jj == 0 ? WBUF - 1 : WBUF - (jj << (2 * cc))) * 1024 + dq * 4);
        if (jj == 0) vv = *(const LAS f32x4*)(sm + 128 + dq * 4);
        o += vv * __builtin_amdgcn_exp2f(sm[192 + ee] - mx); } }
    *(LAS f32x4*)(sm + 1024 + kg * 64 + dq * 4) = o;
    team_bar(tcnt, epoch, lane);
    if (t < 64) {
        float tt = 0.f;
#pragma unroll
        for (int g = 0; g < 16; ++g) tt += sm[1024 + g * 64 + t];
        W_OS(w)[(size_t)b * 1024 + h * 64 + t] = tt / sum;
    }
}

constexpr int ATT4_BT = 6 * 192 * 4, ATT4_IMG = ATT4_BT, ATT4_STG = ATT4_IMG + 8 * 8192, ATT4_SYNC = ATT4_STG + 4 * 4608, ATT4_CONV = ATT4_SYNC + 256;
static_assert(ATT4_CONV + 4 * 8448 <= LDSCTL_OFF, "LDS map (attention v4)");
__device__ __forceinline__ void att4_wait(volatile LAS unsigned* p, unsigned target) {
    for (unsigned sp = 0; *p < target && sp < (1u << 22); ++sp) __builtin_amdgcn_s_sleep(1);
    asm volatile("" ::: "memory");
}
__device__ __forceinline__ void att4_signal(LAS unsigned* p, int lane) {
    asm volatile("s_waitcnt lgkmcnt(0)" ::: "memory");
    if (lane == 0) (void)__hip_atomic_fetch_add(p, 1u, __ATOMIC_RELAXED, __HIP_MEMORY_SCOPE_WORKGROUP);
    asm volatile("" ::: "memory");
}
__device__ __forceinline__ void attn_phase_prompt4(Frame& F, const Args& A, unsigned char* w, float* out, int l) {
    const int lane = F.lane, r = lane & 31, hh = lane >> 5;
    LAS float* btall = (LAS float*)F.lds;
    for (int e = F.tid; e < 6 * 192; e += NWAVES * 64) { const int t = e / 192, j = 160 - (e - t * 192), hh_ = ((((t / 3) * F.G + F.vcu) >> 3) & 15);
        btall[e] = (j >= 0 && j <= 128) ? W_BT(w)[((t % 3) * 16 + hh_) * 129 + (j < 0 ? 0 : (j > 128 ? 128 : j))] : -1.0e30f; }
    LAS unsigned* sync = (LAS unsigned*)(F.lds + ATT4_SYNC);
    if (F.tid == 0) { sync[0] = 0u; sync[16] = 0u; sync[32] = 0u; sync[48] = 0u; }
#if CONV_RING
    conv_fill_gains(A, 1 + l, (LAS float*)(F.lds + ATT4_CONV), F.tid);
#endif
    WG_BAR();
    constexpr int NWORK = 4, NMOVE = ATT4_MOVERS;
    if (F.wave >= NWORK) {
        const int mv = F.wave - NWORK;
        constexpr int CP_PER = (WBUF - 1) * 256, CP_HALF = SB * CP_PER, CP_TOT = 2 * CP_HALF, CP_ROWS = (CP_TOT + 63) / 64;
        for (int bt_ = F.vcu * NMOVE + mv; (!COPY_IN_G4 || COPY_BOTH) && bt_ * NCP < CP_ROWS; bt_ += F.G * NMOVE) {
            const int k0 = bt_ * NCP;
            f32x4 cpv[NCP];
#pragma unroll
            for (int u = 0; u < NCP; ++u) { int ci = (k0 + u) * 64 + lane; ci = ci < CP_TOT ? ci : CP_TOT - 1;
                const int kv = ci >= CP_HALF, rr = ci - kv * CP_HALF, bb = rr / CP_PER, ee = rr - bb * CP_PER;
                cpv[u] = __builtin_nontemporal_load((const f32x4*)(kv ? F.state_v : F.state_k) + ((size_t)(l * SB + bb) * WBUF + 1) * 256 + ee); }
#pragma unroll
            for (int u = 0; u < NCP; ++u) { const int ci = (k0 + u) * 64 + lane;
                if (ci < CP_TOT) { const int kv = ci >= CP_HALF, rr = ci - kv * CP_HALF, bb = rr / CP_PER, ee = rr - bb * CP_PER;
                    __builtin_nontemporal_store(cpv[u], (f32x4*)(out + (kv ? O_VS : O_KS)) + ((size_t)(l * SB + bb) * WBUF) * 256 + ee); } }
        }
#if CONV_RING
        conv_ring<CONV_DP>(A, w, 1 + l, F.vcu, F.G, lane, (const LAS float*)(F.lds + ATT4_CONV), sync + 48, F.vcu * NWAVES + F.wave);
#else
        conv_run_dyn(A, w, 1 + l, F.vcu, F.G, lane, (LAS float*)(F.lds + ATT4_CONV + mv * 8448), sync + 48);
#endif
        return;
    }
    const int wv = F.wave;
    LAS unsigned char* img = F.lds + ATT4_IMG;
    LAS unsigned char* stg = F.lds + ATT4_STG + wv * 4608;
    const int trq = (lane & 15) >> 2, trp = lane & 3, g16 = (lane >> 4) & 1, rsw = 4 * hh + trq;
    const int vt0 = rsw * 128 + (((2 * g16 + (trp >> 1)) ^ rsw) * 16) + 8 * (trp & 1), vt1 = rsw * 128 + (((4 + 2 * g16 + (trp >> 1)) ^ rsw) * 16) + 8 * (trp & 1);
    int koff[4];
#pragma unroll
    for (int s = 0; s < 4; ++s) koff[s] = r * 128 + (((4 * hh + s) ^ (r & 7)) * 16);
    const int rib = 8 * wv + (lane >> 3), woff = rib * 128 + (((lane & 7) ^ (rib & 7)) * 16);
#define UNIT_SETUP(mu_, C_, DSH_, RHO_, RB_, JV_, HB_, BH_, PAIR_) do { const int u_ = (mu_) < 5 ? (mu_) : (mu_) + 1; PAIR_ = ((mu_) == 4 || (mu_) == 9); \
        const int i_ = u_ >> 1, c_ = i_ % 3, idx_ = (i_ / 3) * F.G + F.vcu; C_ = c_; DSH_ = 2 * c_; BH_ = idx_ >> 3; \
        const int f0_ = 256 * (idx_ & 7) + 128 * (u_ & 1); RHO_ = f0_ >> (11 - DSH_); RB_ = f0_ & ((2048 >> DSH_) - 1); JV_ = RB_ == 0 ? 4 : 0; HB_ = (size_t)BH_ * 2048 * 64; } while (0)
#define UNIT_LOAD(KP, VP, QF, QFB, DSH_, RHO_, RB_, JV_, HB_, PAIR_) do { \
        _Pragma("unroll") for (int n = 0; n < 8; ++n) { \
            if (n >= (JV_)) { const size_t eo_ = HB_ + (size_t)((((RB_) - 128 + 32 * n + rib) << (DSH_)) + (RHO_)) * 64 + (lane & 7) * 8; KP[n] = *(const v4u*)(W_K(w) + eo_); VP[n] = *(const v4u*)(W_V(w) + eo_); } \
            else if (PAIR_) { const size_t eo_ = HB_ + (size_t)(((32 * n + rib) << (DSH_)) + (RHO_) + 1) * 64 + (lane & 7) * 8; KP[n] = *(const v4u*)(W_K(w) + eo_); VP[n] = *(const v4u*)(W_V(w) + eo_); } } \
        { const bf16* qp_ = W_Q(w) + HB_ + (size_t)((((RB_) + 32 * wv + r) << (DSH_)) + (RHO_)) * 64 + 32 * hh; _Pragma("unroll") for (int s = 0; s < 4; ++s) QF[s] = *(const bf16x8*)(qp_ + 8 * s); } \
        if (PAIR_) { const bf16* qp_ = W_Q(w) + HB_ + (size_t)(((32 * (3 - wv) + r) << (DSH_)) + (RHO_) + 1) * 64 + 32 * hh; _Pragma("unroll") for (int s = 0; s < 4; ++s) QFB[s] = *(const bf16x8*)(qp_ + 8 * s); } } while (0)
    int c, dsh, rho, rb, jv, bh, pair; size_t hb;
    UNIT_SETUP(0, c, dsh, rho, rb, jv, hb, bh, pair);
    int lo = jv, so = 0;
    v4u kp[8], vp[8]; bf16x8 qf[4], qfb[4];
#pragma unroll
    for (int n = 0; n < 8; ++n) { kp[n] = (v4u){0u, 0u, 0u, 0u}; vp[n] = (v4u){0u, 0u, 0u, 0u}; }
#pragma unroll
    for (int s = 0; s < 4; ++s) qfb[s] = (bf16x8){0, 0, 0, 0, 0, 0, 0, 0};
    UNIT_LOAD(kp, vp, qf, qfb, dsh, rho, rb, lo, hb, pair);
    constexpr unsigned NUNIT = 10;
    int pc = 0, pdsh = 0, prho = 0, pbh = 0, pi0 = 0; float pm = 0.f, pl = 0.f;
#define UNIT_FLUSH() do { \
        _Pragma("unroll") for (int q4 = 0; q4 < 4; ++q4) { const int rq = q4 * 8 + (lane >> 3), ch = lane & 7; \
            const v4u v = *(const LAS v4u*)(stg + rq * 144 + ch * 16); \
            const int grow_q = (pbh >> 4) * 2048 + (((pi0 + rq) << pdsh) + prho); \
            *(v4u*)(W_OPB(w) + ((size_t)pc * M + grow_q) * 1024 + (pbh & 15) * 64 + ch * 8) = v; } \
        if (hh == 0) *(f32x2*)(W_ML(w) + (((size_t)pc * M + (pbh >> 4) * 2048 + (((pi0 + r) << pdsh) + prho)) * 16 + (pbh & 15)) * 2) = (f32x2){pm, pl}; } while (0)
#define VTR(p) __builtin_bit_cast(s16x4, __builtin_amdgcn_ds_read_tr16_b64_v4i16((LAS s16x4*)(p)))
#define VFRAG4(VT_, s) ({ const s16x4 lo_ = VTR(vb_ + (16 * (s)) * 128 + (VT_)), hi_ = VTR(vb_ + (16 * (s) + 8) * 128 + (VT_)); (bf16x8){lo_[0], lo_[1], lo_[2], lo_[3], hi_[0], hi_[1], hi_[2], hi_[3]}; })
#define TILE_RUN(WQ_, SOFF_, JVV_, QC_, RHO_T_) do { \
        float m_run = -1.0e30f, l_run = 0.f; \
        f32x16 o0, o1; \
        _Pragma("unroll") for (int k = 0; k < 16; ++k) { o0[k] = 0.f; o1[k] = 0.f; } \
        _Pragma("unroll") for (int jj = 0; jj < 5; ++jj) { \
            const int j = (WQ_) + jj; \
            if (j >= (JVV_)) { \
                const LAS unsigned char* kb_ = img + ((j + (SOFF_) + so) & 7) * 8192; const LAS unsigned char* vb_ = kb_ + 4096; \
                bf16x8 kf[4]; \
                _Pragma("unroll") for (int s = 0; s < 4; ++s) kf[s] = *(const LAS bf16x8*)(kb_ + koff[s]); \
                const int bidx = 32 - r + 4 * hh + 32 * jj; \
                f32x16 sT; \
                _Pragma("unroll") for (int k = 0; k < 16; ++k) sT[k] = bt[bidx + (k & 3) + 8 * (k >> 2)]; \
                _Pragma("unroll") for (int s = 0; s < 4; ++s) sT = __builtin_amdgcn_mfma_f32_32x32x16_bf16(kf[s], QC_[s], sT, 0, 0, 0); \
                asm volatile("s_nop 15\n\ts_nop 7" : "+v"(sT)); \
                float mx = max3f(max3f(sT[0], sT[1], sT[2]), max3f(sT[3], sT[4], sT[5]), max3f(sT[6], sT[7], sT[8])); \
                mx = max3f(mx, max3f(sT[9], sT[10], sT[11]), max3f(sT[12], sT[13], max3f(sT[14], sT[15], sT[15]))); \
                asm volatile("s_nop 1" : "+v"(mx));        \
                { const unsigned mb_ = __builtin_bit_cast(unsigned, mx); const auto sw_ = __builtin_amdgcn_permlane32_swap(mb_, mb_, false, false);        \
                  const unsigned s0_ = sw_[0], s1_ = sw_[1];        \
                  mx = max3f(__builtin_bit_cast(float, s0_), __builtin_bit_cast(float, s1_), __builtin_bit_cast(float, s1_)); } \
                if (__any(mx > m_run + 8.0f)) { \
                    const float m_new = max3f(m_run, mx, mx), alpha = __builtin_amdgcn_exp2f(m_run - m_new); m_run = m_new; l_run *= alpha; \
                    _Pragma("unroll") for (int k = 0; k < 16; ++k) { o0[k] *= alpha; o1[k] *= alpha; } } \
                _Pragma("unroll") for (int k = 0; k < 16; ++k) sT[k] = __builtin_amdgcn_exp2f(sT[k] - m_run); \
                l_run += (((sT[0] + sT[1]) + (sT[2] + sT[3])) + ((sT[4] + sT[5]) + (sT[6] + sT[7]))) + (((sT[8] + sT[9]) + (sT[10] + sT[11])) + ((sT[12] + sT[13]) + (sT[14] + sT[15]))); \
                v4u pw0, pw1; \
                pw0.x = cvt_pk_bf16(sT[0], sT[1]); pw0.y = cvt_pk_bf16(sT[2], sT[3]); pw0.z = cvt_pk_bf16(sT[4], sT[5]); pw0.w = cvt_pk_bf16(sT[6], sT[7]); \
                pw1.x = cvt_pk_bf16(sT[8], sT[9]); pw1.y = cvt_pk_bf16(sT[10], sT[11]); pw1.z = cvt_pk_bf16(sT[12], sT[13]); pw1.w = cvt_pk_bf16(sT[14], sT[15]); \
                const bf16x8 pk0 = __builtin_bit_cast(bf16x8, pw0), pk1 = __builtin_bit_cast(bf16x8, pw1); \
                  \
                const bf16x8 v00 = VFRAG4(vt0, 0), v01 = VFRAG4(vt0, 1), v10 = VFRAG4(vt1, 0), v11 = VFRAG4(vt1, 1); \
                o0 = __builtin_amdgcn_mfma_f32_32x32x16_bf16(v00, pk0, o0, 0, 0, 0); o0 = __builtin_amdgcn_mfma_f32_32x32x16_bf16(v01, pk1, o0, 0, 0, 0); \
                o1 = __builtin_amdgcn_mfma_f32_32x32x16_bf16(v10, pk0, o1, 0, 0, 0); o1 = __builtin_amdgcn_mfma_f32_32x32x16_bf16(v11, pk1, o1, 0, 0, 0); \
            } \
        } \
          \
        _Pragma("unroll") for (int g4 = 0; g4 < 4; ++g4) { \
            v2u a, b2; a.x = cvt_pk_bf16(o0[4 * g4], o0[4 * g4 + 1]); a.y = cvt_pk_bf16(o0[4 * g4 + 2], o0[4 * g4 + 3]); b2.x = cvt_pk_bf16(o1[4 * g4], o1[4 * g4 + 1]); b2.y = cvt_pk_bf16(o1[4 * g4 + 2], o1[4 * g4 + 3]); \
            *(LAS v2u*)(stg + r * 144 + (8 * g4 + 4 * hh) * 2) = a; *(LAS v2u*)(stg + r * 144 + (32 + 8 * g4 + 4 * hh) * 2) = b2; } \
        pc = c; pdsh = dsh; prho = (RHO_T_); pbh = bh; pi0 = rb + 32 * (WQ_); pm = m_run; \
        { const unsigned lb_ = __builtin_bit_cast(unsigned, l_run); const auto sw_ = __builtin_amdgcn_permlane32_swap(lb_, lb_, false, false); const unsigned s0_ = sw_[0], s1_ = sw_[1]; \
          pl = __builtin_bit_cast(float, s0_) + __builtin_bit_cast(float, s1_); } } while (0)
    for (int u = 0; u < (int)NUNIT; ++u) {
        att4_wait((volatile LAS unsigned*)(sync + 16), 4u * (unsigned)u);
#pragma unroll
        for (int n = 0; n < 8; ++n) if (n >= lo || pair) { LAS unsigned char* sl_ = img + ((n + so) & 7) * 8192 + woff; *(LAS v4u*)sl_ = kp[n]; *(LAS v4u*)(sl_ + 4096) = vp[n]; }
        bf16x8 qc[4];
#pragma unroll
        for (int s = 0; s < 4; ++s) qc[s] = qf[s];
        att4_signal(sync, lane);
        if (u > 0) UNIT_FLUSH();
        att4_wait((volatile LAS unsigned*)sync, 4u * (unsigned)(u + 1));
        int c2 = 0, dsh2 = 0, rho2 = 0, rb2 = 0, jv2 = 0, bh2 = 0, pair2 = 0, lo2 = 0, so2 = 0; size_t hb2 = 0;
        if (u + 1 < (int)NUNIT) { UNIT_SETUP(u + 1, c2, dsh2, rho2, rb2, jv2, hb2, bh2, pair2);
            const int reuse2 = (u + 1 == 1 || u + 1 == 3 || u + 1 == 6 || u + 1 == 8); lo2 = reuse2 ? 4 : jv2; so2 = reuse2 ? 4 : 0;
            UNIT_LOAD(kp, vp, qf, qfb, dsh2, rho2, rb2, lo2, hb2, pair2); }
        const LAS float* bt = btall + ((u < 5 ? u : u + 1) >> 1) * 192;
        TILE_RUN(wv, 0, jv, qc, rho);
        if (pair) { UNIT_FLUSH(); TILE_RUN(3 - wv, -4, 4, qfb, rho + 1); }
        att4_signal(sync + 16, lane);
        c = c2; dsh = dsh2; rho = rho2; rb = rb2; jv = jv2; hb = hb2; bh = bh2; pair = pair2; lo = lo2; so = so2;
    }
#undef TILE_RUN
#undef VFRAG4
#undef VTR
#undef UNIT_SETUP
#undef UNIT_LOAD
    UNIT_FLUSH();
#undef UNIT_FLUSH
    att4_wait((volatile LAS unsigned*)(sync + 16), 4u * NUNIT);
    if (F.vcu < SB * H) attn_sample_team(F, w, out, l, F.vcu >> 4, F.vcu & 15, wv, sync + 32);
#if CONV_RING
    conv_ring<CONV_DP>(A, w, 1 + l, F.vcu, F.G, lane, (const LAS float*)(F.lds + ATT4_CONV), sync + 48, F.vcu * NWAVES + F.wave);
#else
    conv_run_dyn(A, w, 1 + l, F.vcu, F.G, lane, (LAS float*)(img + 16384 + wv * 8448), sync + 48);
#endif
}

__device__ __forceinline__ void attn_sample_unit(Frame& F, unsigned char* w, float* out, int l, int b, int h) {
    LAS float* sm = (LAS float*)F.lds;
    const int lane = F.lane, wave = F.wave, tid = F.tid;
    const float* ps = W_PS(w) + (size_t)b * DIN;
    const size_t sbase = ((size_t)(l * SB + b) * WBUF) * 1024 + h * 64;
    const int e = tid < 387 ? tid : 386, ec = e / 129, ej = e - ec * 129;
    f32x4 kreg[16];
    { const f32x4* kr = (const f32x4*)(F.state_k + sbase + (size_t)(ej == 0 ? WBUF - 1 : WBUF - (ej << (2 * ec))) * 1024);
#pragma unroll
      for (int d4 = 0; d4 < 16; ++d4) kreg[d4] = kr[d4]; }
    const int kg = tid >> 4, dq = tid & 15;
    f32x4 vreg[13];
#pragma unroll
    for (int i = 0; i < 13; ++i) { int ee = kg + 32 * i; ee = ee < 387 ? ee : 386; const int cc = ee / 129, jj = ee - cc * 129;
        vreg[i] = *(const f32x4*)(F.state_v + sbase + (size_t)(jj == 0 ? WBUF - 1 : WBUF - (jj << (2 * cc))) * 1024 + dq * 4); }
    if (wave == 0) {
        const float qr = ps[h * 64 + lane], kr = ps[1024 + h * 64 + lane], vr = ps[2048 + h * 64 + lane];
        const float sq = wave_sum(qr * qr), sk = wave_sum(kr * kr);
        const float* gn = W_GN(w) + l * 128;
        const float qn = qr * __builtin_amdgcn_rsqf(sq * (1.0f / 64.0f) + EPS) * gn[lane] * QSCALE;
        const float kn = kr * __builtin_amdgcn_rsqf(sk * (1.0f / 64.0f) + EPS) * gn[64 + lane];
        sm[lane] = qn; sm[64 + lane] = kn; sm[128 + lane] = vr;
        out[O_KS + sbase + (size_t)(WBUF - 1) * 1024 + lane] = kn;
        out[O_VS + sbase + (size_t)(WBUF - 1) * 1024 + lane] = vr;
    }
    WG_BAR();
    if (tid < 387) {
        float a = 0.f;
#pragma unroll
        for (int d4 = 0; d4 < 16; ++d4) { const f32x4 q4 = *(const LAS f32x4*)(sm + 4 * d4); f32x4 kv = kreg[d4]; if (ej == 0) kv = *(const LAS f32x4*)(sm + 64 + 4 * d4);
            a += (kv[0] * q4[0] + kv[1] * q4[1]) + (kv[2] * q4[2] + kv[3] * q4[3]); }
        sm[192 + tid] = a + W_BT(w)[(ec * 16 + h) * 129 + ej];
    }
    WG_BAR();
    float mx = -1.0e30f;
    for (int t = lane; t < 387; t += 64) mx = fmaxf(mx, sm[192 + t]);
    mx = wave_max(mx);
    float sum = 0.f;
    for (int t = lane; t < 387; t += 64) sum += __builtin_amdgcn_exp2f(sm[192 + t] - mx);
    sum = wave_sum(sum);
    f32x4 o = {0.f, 0.f, 0.f, 0.f};
#pragma unroll
    for (int i = 0; i < 13; ++i) { const int ee = kg + 32 * i;
        if (ee < 387) { const float p = __builtin_amdgcn_exp2f(sm[192 + ee] - mx); f32x4 vv = vreg[i]; if (ee == 0 || ee == 129 || ee == 258) vv = *(const LAS f32x4*)(sm + 128 + dq * 4); o += vv * p; } }
    *(LAS f32x4*)(sm + 1024 + kg * 64 + dq * 4) = o;
    WG_BAR();
    if (tid < 64) {
        float t = 0.f;
#pragma unroll
        for (int g = 0; g < 32; ++g) t += sm[1024 + g * 64 + tid];
        W_OS(w)[(size_t)b * 1024 + h * 64 + tid] = t / sum;
    }
    WG_BAR();
}

__device__ __forceinline__ void mix_row_prompt(unsigned char* w, float* out, int lane, int l, int row) {
    const int b = row >> 11, t = row & 2047;
    { const int head = lane >> 2, dq = (lane & 3) * 16;
      float mm[3], ll[3];
#pragma unroll
      for (int c = 0; c < 3; ++c) { const f32x2 v = *(const f32x2*)(W_ML(w) + (((size_t)c * M + row) * 16 + head) * 2); mm[c] = v[0]; ll[c] = v[1]; }
      const float mx = fmaxf(fmaxf(mm[0], mm[1]), mm[2]);
      float wgt[3], den = 0.f;
#pragma unroll
      for (int c = 0; c < 3; ++c) { wgt[c] = __builtin_amdgcn_exp2f(mm[c] - mx); den += wgt[c] * ll[c]; }
      const float inv = 1.0f / den;
      f32x4 o[4];
#pragma unroll
      for (int k = 0; k < 4; ++k) o[k] = (f32x4){0.f, 0.f, 0.f, 0.f};
#pragma unroll
      for (int c = 0; c < 3; ++c) { const v4u* p = (const v4u*)(W_OPB(w) + ((size_t)c * M + row) * 1024 + head * 64 + dq); const float wc_ = wgt[c] * inv; const v4u p0 = p[0], p1 = p[1];
#pragma unroll
          for (int e = 0; e < 4; ++e) { const int k = e >> 1, x = (e & 1) * 2;
              o[k][x] += __uint_as_float(p0[e] << 16) * wc_; o[k][x + 1] += __uint_as_float(p0[e] & 0xffff0000u) * wc_;
              o[2 + k][x] += __uint_as_float(p1[e] << 16) * wc_; o[2 + k][x + 1] += __uint_as_float(p1[e] & 0xffff0000u) * wc_; } }
      float q = 0.f;
#pragma unroll
      for (int k = 0; k < 4; ++k) q += (o[k][0] * o[k][0] + o[k][1] * o[k][1]) + (o[k][2] * o[k][2] + o[k][3] * o[k][3]);
      q = wave_sum(q);
      const float rs = __builtin_amdgcn_rsqf(q * (1.0f / 1024.0f) + EPS);
      bf16* dst = W_MIX(w) + (size_t)row * 2048 + head * 64 + dq;
      *(v4u*)dst = pack8(o[0] * rs, o[1] * rs); *(v4u*)(dst + 8) = pack8(o[2] * rs, o[3] * rs); }
    { const int c0 = lane * 16;
      float u[3][16];
#pragma unroll
      for (int k = 0; k < 3; ++k) { const int tt = t - 2 + k;
          if (tt >= 0) { const bf16* pr = W_PC(w) + (size_t)(row - 2 + k) * 2048;
              const v4u a0 = *(const v4u*)(pr + c0), a1 = *(const v4u*)(pr + c0 + 8);
#pragma unroll
              for (int e = 0; e < 4; ++e) { const unsigned va = a0[e], vb = a1[e];
                  u[k][2 * e] = __uint_as_float(va << 16); u[k][2 * e + 1] = __uint_as_float(va & 0xffff0000u);
                  u[k][8 + 2 * e] = __uint_as_float(vb << 16); u[k][8 + 2 * e + 1] = __uint_as_float(vb & 0xffff0000u); }
          } else {
#pragma unroll
              for (int e = 0; e < 16; ++e) u[k][e] = 0.f; } }
      const bf16* pr = W_PC(w) + (size_t)row * 2048 + 1024 + c0;
      const v4u b0 = *(const v4u*)pr, b1 = *(const v4u*)(pr + 8);
      float gb[16];
#pragma unroll
      for (int e = 0; e < 4; ++e) { gb[2 * e] = __uint_as_float(b0[e] << 16); gb[2 * e + 1] = __uint_as_float(b0[e] & 0xffff0000u); gb[8 + 2 * e] = __uint_as_float(b1[e] << 16); gb[8 + 2 * e + 1] = __uint_as_float(b1[e] & 0xffff0000u); }
      const float* cw = W_CW(w) + (size_t)l * 3 * DC + c0;
      float z[16]; float q = 0.f;
#pragma unroll
      for (int e4 = 0; e4 < 4; ++e4) { const f32x4 w0 = *(const f32x4*)(cw + 4 * e4), w1 = *(const f32x4*)(cw + DC + 4 * e4), w2 = *(const f32x4*)(cw + 2 * DC + 4 * e4);
#pragma unroll
          for (int e = 0; e < 4; ++e) { const int i = 4 * e4 + e; const float y = w0[e] * u[0][i] + w1[e] * u[1][i] + w2[e] * u[2][i]; z[i] = gb[i] * y; q += z[i] * z[i]; } }
      q = wave_sum(q);
      const float rs = __builtin_amdgcn_rsqf(q * (1.0f / 1024.0f) + EPS);
      bf16* dst = W_MIX(w) + (size_t)row * 2048 + 1024 + c0;
      v4u w0, w1;
#pragma unroll
      for (int e = 0; e < 4; ++e) { w0[e] = cvt_pk_bf16(z[2 * e] * rs, z[2 * e + 1] * rs); w1[e] = cvt_pk_bf16(z[8 + 2 * e] * rs, z[8 + 2 * e + 1] * rs); }
      *(v4u*)dst = w0; *(v4u*)(dst + 8) = w1;
      if (t >= S - 2) { float* cp = out + O_CP + ((size_t)(l * NB + b) * 2 + (t - (S - 2))) * DC + c0;
#pragma unroll
          for (int e4 = 0; e4 < 4; ++e4) *(f32x4*)(cp + 4 * e4) = (f32x4){u[2][4 * e4], u[2][4 * e4 + 1], u[2][4 * e4 + 2], u[2][4 * e4 + 3]}; } }
}
__device__ __forceinline__ void mix_row_sample(unsigned char* w, float* out, int lane, int l, int b) {
    { const f32x4* p = (const f32x4*)(W_OS(w) + (size_t)b * 1024 + lane * 16); f32x4 o[4]; float q = 0.f;
#pragma unroll
      for (int k = 0; k < 4; ++k) { o[k] = p[k]; q += (o[k][0] * o[k][0] + o[k][1] * o[k][1]) + (o[k][2] * o[k][2] + o[k][3] * o[k][3]); }
      q = wave_sum(q); const float rs = __builtin_amdgcn_rsqf(q * (1.0f / 1024.0f) + EPS);
      f32x4* dst = (f32x4*)(W_MIXS(w) + (size_t)b * 2048 + lane * 16);
#pragma unroll
      for (int k = 0; k < 4; ++k) dst[k] = o[k] * rs; }
    { const int c0 = lane * 16; const float* ps = W_PS(w) + (size_t)b * DIN;
      const float* st = W_SC(w) + (size_t)(l * SB + b) * 2 * DC; const float* cw = W_CW(w) + (size_t)l * 3 * DC;
      float* co = out + O_CS + (size_t)(l * SB + b) * 2 * DC;
      f32x4 z[4]; float q = 0.f;
#pragma unroll
      for (int k = 0; k < 4; ++k) { const int c = c0 + 4 * k;
          const int cv = 3072 + 256 * (c >> 7) + 64 * ((c >> 5) & 3) + (c & 31);
          const f32x4 vc = *(const f32x4*)(ps + cv), gb = *(const f32x4*)(ps + 5120 + c), gc = *(const f32x4*)(ps + cv + 32);
          const f32x4 s0 = *(const f32x4*)(st + c), s1 = *(const f32x4*)(st + DC + c);
          const f32x4 w0 = *(const f32x4*)(cw + c), w1 = *(const f32x4*)(cw + DC + c), w2 = *(const f32x4*)(cw + 2 * DC + c);
          const f32x4 un = gc * vc; const f32x4 y = w0 * s0 + w1 * s1 + w2 * un; z[k] = gb * y;
          q += (z[k][0] * z[k][0] + z[k][1] * z[k][1]) + (z[k][2] * z[k][2] + z[k][3] * z[k][3]);
          *(f32x4*)(co + c) = s1; *(f32x4*)(co + DC + c) = un; }
      q = wave_sum(q); const float rs = __builtin_amdgcn_rsqf(q * (1.0f / 1024.0f) + EPS);
      f32x4* dst = (f32x4*)(W_MIXS(w) + (size_t)b * 2048 + 1024 + c0);
#pragma unroll
      for (int k = 0; k < 4; ++k) dst[k] = z[k] * rs; }
}

#ifndef PHASE_MASK
#define PHASE_MASK 127
#endif
__device__ __forceinline__ void conv_phase_all(Frame& P, const Args& A, unsigned char* w, int stage) {
    LAS unsigned* tq = (LAS unsigned*)(P.lds + LDSCTL_OFF) + 64;
    if (P.tid == 0) *tq = 0u;
    WG_BAR();
    conv_run_dyn(A, w, stage, P.vcu, P.G, P.lane, (LAS float*)(P.lds + P.wave * 8448), tq);
    WG_BAR();
}
struct SideKV {
    static constexpr bool ON = true;
    const bf16* kb; const bf16* vb; float* ko; float* vo; int gw, ngw, lane;
    LAS unsigned char* slot; f32x2 d; f32x2* dst;
    __device__ __forceinline__ void issue(int j) {
        int o = j * ngw + gw; o = o < 131072 ? o : 131071;
        const int kv = o >> 16, rem = o & 65535, row = rem >> 3, part = rem & 7, head = 2 * part + (lane >> 5), dd = 2 * (lane & 31);
        const bf16* src = (kv ? vb : kb) + ((size_t)((row >> 11) * 16 + head) * 2048 + (row & 2047)) * 64 + dd;
        __builtin_amdgcn_global_load_lds((const unsigned*)src, (LAS unsigned*)slot, 4, 0, 0);
        dst = (f32x2*)((kv ? vo : ko) + (size_t)row * 1024 + part * 128 + 2 * lane);
    }
    __device__ __forceinline__ void prime() { issue(0); }
    __device__ __forceinline__ void fetch() { const unsigned x = *(const LAS unsigned*)(slot + lane * 4); d[0] = __uint_as_float(x << 16); d[1] = __uint_as_float(x & 0xffff0000u); }
    __device__ __forceinline__ void step(int j) { __builtin_nontemporal_store(d, dst); issue(j + 1); }
};
struct SideCopy {
    static constexpr bool ON = true;
    const float* sk; const float* sv; float* ok; float* ov; int gw, ngw, lane;
    LAS unsigned char* slot;
    f32x4 d; f32x4* dst;
    __device__ __forceinline__ void issue(int j) {
        constexpr int CP_PER = (WBUF - 1) * 256, CP_HALF = SB * CP_PER, CP_TOT = 2 * CP_HALF;
        int ci = (j * ngw + gw) * 64 + lane; ci = ci < CP_TOT ? ci : CP_TOT - 1;
        const int kv = ci >= CP_HALF, rr = ci - kv * CP_HALF, bb = rr / CP_PER, ee = rr - bb * CP_PER;
        __builtin_amdgcn_global_load_lds((const unsigned*)((const f32x4*)(kv ? sv : sk) + ((size_t)bb * WBUF + 1) * 256 + ee), (LAS unsigned*)slot, 16, 0, 0);
        dst = (f32x4*)(kv ? ov : ok) + (size_t)bb * WBUF * 256 + ee;
    }
    __device__ __forceinline__ void prime() { issue(0); }
    __device__ __forceinline__ void fetch() { d = *(const LAS f32x4*)(slot + lane * 16); }
    __device__ __forceinline__ void step(int j) { __builtin_nontemporal_store(d, dst); issue(j + 1); }
};
#define PH_ON(k) ((PHASE_MASK >> (k)) & 1)
#ifndef REPEAT_MASK
#define REPEAT_MASK 0
#endif
#define NREP(k) (((REPEAT_MASK >> (k)) & 1) ? 2 : 1)
__global__ void __launch_bounds__(NWAVES * 64, 2) mk_fwd(Args args) {
    extern __shared__ __attribute__((aligned(16))) unsigned char lds[];
    Frame F;
    F.lds = (LAS unsigned char*)lds;
    F.tid = threadIdx.x; F.lane = F.tid & 63; F.wave = __builtin_amdgcn_readfirstlane(F.tid >> 6);
    F.G = gridDim.x; { const int bx = blockIdx.x; F.vcu = (F.G % 8 == 0) ? (bx % 8) * (F.G / 8) + bx / 8 : bx; }
    F.ws = args.ws; F.out = args.out; F.x_prompt = args.in[0]; F.state_k = args.in[2]; F.state_v = args.in[3];
    for (int u = F.tid; u < (LDS_BYTES - LDSCTL_OFF) / 4; u += NWAVES * 64) ((LAS unsigned*)(F.lds + LDSCTL_OFF))[u] = 0u;
    __syncthreads();
    XcdBarrier bar; bar.wave = F.wave; bar.bar = (unsigned*)(F.ws + WS_CTL) + CW_BAR; bar.x = 0; bar.st = nullptr;
    if (MK_ONE_LAUNCH) bar = xcd_barrier_post((unsigned*)(F.ws + WS_CTL) + CW_BAR, (volatile LAS unsigned*)(F.lds + MISC_OFF) + 8, F.wave);
    const int lo = args.ph_lo, hi = args.ph_hi;
#define IN(k) (lo <= (k) && (k) < hi)
#define SEAM(k) do { if (IN(k) && IN((k) + 1)) xcd_barrier(bar); } while (0)

    if (PH_ON(0) && IN(0)) { for (int rep = 0; rep < NREP(0); ++rep) p0_prologue(F, args); SEAM(0); }

    for (int l = 0; l < DEPTH; ++l) {
        const int p0 = 1 + 6 * l;
        if (PH_ON(1) && IN(p0)) {
            unsigned char* w = opq(F.ws); float* out = opq(F.out); Frame P = F; P.tid = fresh_tid(F.wave); P.lane = P.tid & 63;
            const bool sfirst = STAGGER && (F.vcu & 1);
            if (sfirst) { sgemv<0, D, DIN>(P, W_XS(w), W_WIN(w) + (size_t)l * DIN * D, W_PS(w), nullptr); WG_BAR(); }
            for (int rep = 0; rep < NREP(1); ++rep) { pg8::Gemm g{W_XB(w), W_WIN(w) + (size_t)l * DIN * D, M, DIN, D, F.wave}; pg8::MixedOrderG1 So; So.init(M, DIN, F.G, (int)blockIdx.x);
              pg8::fill_rstd_table((LAS float*)(F.lds + RS_TAB_OFF), So, W_SSQA(w), EPS, P.tid);
              pg8::EpiG1 E{(const LAS float*)(F.lds + RS_TAB_OFF), W_GN(w) + l * 128, 64, W_Q(w), (size_t)(WS_K - WS_Q) / 2, W_PC(w), out + O_KP + (size_t)l * M * 1024, (size_t)(O_VP - O_KP), QSCALE, EPS};
              pg8::gemm_phase<pg8::EpiG1, pg8::MixedOrderG1, GEMM_ALIGN, GEMM_SP2>(F.lds, g, So, E); }
            if (!sfirst && F.wave == 0) EARLY_WB(); if (!sfirst) sgemv<0, D, DIN>(P, W_XS(w), W_WIN(w) + (size_t)l * DIN * D, W_PS(w), nullptr);
            SEAM(p0);
        }
        if (PH_ON(2) && IN(p0 + 1)) {
            unsigned char* w = opq(F.ws); float* out = opq(F.out); Frame P = F; P.tid = fresh_tid(F.wave); P.lane = P.tid & 63;
#ifdef ATT_PROBE_MODE
            attn_phase_prompt(P, w, out, l, ATT_PROBE_MODE); WG_BAR();
#endif
#if ATT_V4
            attn_phase_prompt4(P, args, w, out, l);
#else
            for (int rep = 0; rep < NREP(2); ++rep) attn_phase_prompt(P, w, out, l);
#endif
            WG_BAR();
#if !ATT_V4
            for (int rep = 0; rep < NREP(7); ++rep) if (F.vcu < SB * H) attn_sample_unit(P, w, out, l, F.vcu >> 4, F.vcu & 15);
#endif
            SEAM(p0 + 1);
        }
        if (PH_ON(3) && IN(p0 + 2)) {
            unsigned char* w = opq(F.ws); float* out = opq(F.out); Frame P = F; P.tid = fresh_tid(F.wave); P.lane = P.tid & 63;
            const int gw = F.vcu * NWAVES + F.wave, NGW = F.G * NWAVES;
            for (int rep = 0; rep < NREP(3); ++rep) for (int row = gw; row < M; row += NGW) mix_row_prompt(w, out, P.lane, l, row);
            if (F.vcu == F.G - 1) mix_row_sample(w, out, P.lane, l, P.wave);
            SEAM(p0 + 2);
        }
        if (PH_ON(4) && IN(p0 + 3)) {
            unsigned char* w = opq(F.ws); float* out = opq(F.out); Frame P = F; P.tid = fresh_tid(F.wave); P.lane = P.tid & 63;
            const bool sfirst = STAGGER && (F.vcu & 1);
            if (sfirst) { sgemv<1, D, D>(P, W_MIXS(w), W_WOUT(w) + (size_t)l * D * D, W_XS(w), nullptr); WG_BAR(); }
            if (NREP(4) > 1) { pg8::Gemm g{W_MIX(w), W_WOUT(w) + (size_t)l * D * D, M, D, D, F.wave}; pg8::StaticOrder So; So.init(M, D, F.G, (int)blockIdx.x); pg8::EpiNull E{}; pg8::gemm_phase<pg8::EpiNull, pg8::StaticOrder, false, true>(F.lds, g, So, E); }
            { pg8::Gemm g{W_MIX(w), W_WOUT(w) + (size_t)l * D * D, M, D, D, F.wave}; pg8::StaticOrder So; So.init(M, D, F.G, (int)blockIdx.x);
              pg8::EpiRes E{W_XB(w), W_SSQB(w), nullptr};
              pg8::gemm_phase<pg8::EpiRes, pg8::StaticOrder, false, GEMM_SP2>(F.lds, g, So, E); }
            if (!sfirst && F.wave == 0) EARLY_WB(); if (!sfirst) sgemv<1, D, D>(P, W_MIXS(w), W_WOUT(w) + (size_t)l * D * D, W_XS(w), nullptr);
            SEAM(p0 + 3);
        }
        if (PH_ON(5) && IN(p0 + 4)) {
            unsigned char* w = opq(F.ws); Frame P = F; P.tid = fresh_tid(F.wave); P.lane = P.tid & 63;
            const bool sfirst = STAGGER && (F.vcu & 1);
            if (sfirst) { sgemv<2, D, DFF>(P, W_XS(w), W_WUP(w) + (size_t)l * DFF * D, W_AS(w), nullptr); WG_BAR(); conv_phase_all(P, args, w, 16 + l); }
            for (int rep = 0; rep < NREP(5); ++rep) { pg8::Gemm g{W_XB(w), W_WUP(w) + (size_t)l * DFF * D, M, DFF, D, F.wave}; pg8::StaticOrder So; So.init(M, DFF, F.G, (int)blockIdx.x);
              pg8::fill_rstd_table((LAS float*)(F.lds + RS_TAB_OFF), So, W_SSQB(w), EPS, P.tid);
              pg8::EpiG3 E{(const LAS float*)(F.lds + RS_TAB_OFF), W_HB(w), DFF};
              pg8::gemm_phase<pg8::EpiG3, pg8::StaticOrder, GEMM_ALIGN, GEMM_SP2>(F.lds, g, So, E); }
            if (!sfirst) conv_phase_all(P, args, w, 16 + l);
            if (!sfirst) sgemv<2, D, DFF>(P, W_XS(w), W_WUP(w) + (size_t)l * DFF * D, W_AS(w), nullptr);
            SEAM(p0 + 4);
        }
        if (PH_ON(6) && IN(p0 + 5)) {
            unsigned char* w = opq(F.ws); float* out = opq(F.out); Frame P = F; P.tid = fresh_tid(F.wave); P.lane = P.tid & 63;
            const bool sfirst = STAGGER && (F.vcu & 1);
            if (sfirst) { sgemv<3, DFF, D>(P, W_AS(w), W_WDN(w) + (size_t)l * D * DFF, W_XS(w), l == DEPTH - 1 ? out + O_YS : nullptr); WG_BAR(); conv_phase_all(P, args, w, 32 + l); }
            if (NREP(6) > 1) { pg8::Gemm g{W_HB(w), W_WDN(w) + (size_t)l * D * DFF, M, D, DFF, F.wave}; pg8::StaticOrder So; So.init(M, D, F.G, (int)blockIdx.x); pg8::EpiNull E{}; pg8::gemm_phase<pg8::EpiNull, pg8::StaticOrder, false, true>(F.lds, g, So, E); }
            { pg8::Gemm g{W_HB(w), W_WDN(w) + (size_t)l * D * DFF, M, D, DFF, F.wave}; pg8::StaticOrder So; So.init(M, D, F.G, (int)blockIdx.x);
              pg8::EpiRes E{W_XB(w), W_SSQA(w), l == DEPTH - 1 ? out + O_Y : nullptr};
#if KV_SIDE
              SideKV sc{W_K(w), W_V(w), out + O_KP + (size_t)l * M * 1024, out + O_VP + (size_t)l * M * 1024, F.vcu * NWAVES + F.wave, F.G * NWAVES, P.lane, F.lds + RS_TAB_OFF + F.wave * 1024, (f32x2){0.f, 0.f}, nullptr};
              pg8::gemm_phase<pg8::EpiRes, pg8::StaticOrder, false, true, SideKV>(F.lds, g, So, E, sc); }
#elif COPY_IN_G4
              const size_t lo_ = (size_t)l * SB * WBUF * 1024;
              SideCopy sc{F.state_k + lo_, F.state_v + lo_, out + O_KS + lo_, out + O_VS + lo_, F.vcu * NWAVES + F.wave, F.G * NWAVES, P.lane, F.lds + RS_TAB_OFF + F.wave * 1024, (f32x4){0.f, 0.f, 0.f, 0.f}, nullptr};
              pg8::gemm_phase<pg8::EpiRes, pg8::StaticOrder, false, true, SideCopy>(F.lds, g, So, E, sc); }
#else
              pg8::gemm_phase<pg8::EpiRes, pg8::StaticOrder, false, GEMM_SP2>(F.lds, g, So, E); }
#endif
            if (!sfirst) conv_phase_all(P, args, w, 32 + l);
            if (!sfirst) sgemv<3, DFF, D>(P, W_AS(w), W_WDN(w) + (size_t)l * D * DFF, W_XS(w), l == DEPTH - 1 ? out + O_YS : nullptr);
            SEAM(p0 + 5);
        }
    }
#undef IN
#undef SEAM
}

extern "C" void kernel_launch(void* const* d_in, const int* in_sizes, int n_in, void* d_out, int out_size, void* d_ws, size_t ws_size, hipStream_t stream) {
    static int grid = 0;
    if (grid == 0) {
        if (n_in != 17 || (size_t)out_size != O_END || ws_size < WS_END) { fprintf(stderr, "kernel_launch: unexpected sizes (n_in %d out %d ws %zu)\n", n_in, out_size, ws_size); grid = -1; return; }
        int dev = 0, cus = 0, per_cu = 0;
        if (hipGetDevice(&dev) != hipSuccess || hipDeviceGetAttribute(&cus, hipDeviceAttributeMultiprocessorCount, dev) != hipSuccess) { grid = -1; return; }
        if (hipFuncSetAttribute((const void*)mk_fwd, hipFuncAttributeMaxDynamicSharedMemorySize, LDS_BYTES) != hipSuccess) { fprintf(stderr, "kernel_launch: hipFuncSetAttribute failed\n"); grid = -1; return; }
        if (hipOccupancyMaxActiveBlocksPerMultiprocessor(&per_cu, (const void*)mk_fwd, NWAVES * 64, LDS_BYTES) != hipSuccess || per_cu < 1) { fprintf(stderr, "kernel_launch: occupancy query says %d\n", per_cu); (void)hipGetLastError(); per_cu = 1; }
        grid = cus;
        if (grid != 256) fprintf(stderr, "kernel_launch: %d CUs (built for 256)\n", grid);
    }
    if (grid < 0) return;
    if (hipMemsetAsync((char*)d_ws + WS_CTL, 0, CTL_ZERO_BYTES, stream) != hipSuccess) return;
    Args a{};
    for (int i = 0; i < 17; ++i) a.in[i] = (const float*)d_in[i];
    a.out = (float*)d_out; a.ws = (unsigned char*)d_ws;
#if MK_ONE_LAUNCH
    a.ph_lo = 0; a.ph_hi = NPH;
    hipLaunchKernelGGL(mk_fwd, dim3(grid), dim3(NWAVES * 64), LDS_BYTES, stream, a);
#else
    for (int p = 0; p < NPH; ++p) { a.ph_lo = p; a.ph_hi = p + 1; hipLaunchKernelGGL(mk_fwd, dim3(grid), dim3(NWAVES * 64), LDS_BYTES, stream, a); }
#endif
}
```

```cpp
#include <hip/hip_runtime.h>
#include <cstdio>
#include <cstdint>
#ifndef KV_SIDE
#define KV_SIDE 1
#endif
namespace pg8 {
#define PG8_LAS __attribute__((address_space(3)))
typedef unsigned short bf16_t;
typedef short bf16x8 __attribute__((ext_vector_type(8)));
typedef float f32x4 __attribute__((ext_vector_type(4)));
typedef unsigned u32x4 __attribute__((ext_vector_type(4)));
constexpr int BM = 256, BK = 64, HALF = 128, HTB = HALF * BK * 2  , STAGE_BYTES = 8 * HTB, NXCD = 8, WGM = 4;

__host__ __device__ __forceinline__ int lds_byte(int r, int c) { const int st = (r >> 4) * 2 + (c >> 5), rr = r & 15, cc = c & 31, ob = rr * 64 + cc * 2; return st * 1024 + (ob ^ (((ob >> 9) & 1) << 5)); }
__host__ __device__ __forceinline__ void stage_rc(int b, int& R, int& C) { const int st = b / 1024, sb = b % 1024, swz = sb ^ (((sb >> 9) & 1) << 5); R = (st >> 1) * 16 + swz / 64; C = (st & 1) * 32 + (swz % 64) / 2; }
__host__ __device__ __forceinline__ int perm32(int rho) { const int n = rho >> 4, i = rho & 15; return 8 * (i >> 2) + 4 * n + (i & 3); }

struct Unit { int pm, pn; };
struct Gemm { const bf16_t* A; const bf16_t* Bt; int M, N, K, wave; };

struct StaticOrder {
    int nM, nN, nwg, G, c;
    __host__ __device__ void init(int M, int N, int G_, int c_) { nM = M / BM; nN = N / BM; nwg = nM * nN; G = G_; c = c_; }
    __host__ __device__ bool next(int i, Unit& u) const {
        const long L = (long)i * G + c; if (L >= nwg) return false;
        int wgid = (int)L; { const int q = nwg / NXCD, r = nwg % NXCD, xcd = wgid % NXCD, off = wgid / NXCD; wgid = (xcd < r ? xcd * (q + 1) : r * (q + 1) + (xcd - r) * q) + off; }
        const int nig = WGM * nN, gid = wgid / nig, fm = gid * WGM, gsz = (nM - fm) < WGM ? (nM - fm) : WGM;
        u.pm = fm + ((wgid % nig) % gsz); u.pn = (wgid % nig) / gsz; return true;
    }
    __device__ __forceinline__ void a_ready(const Unit&) const {}
    __device__ __forceinline__ void done(const Unit&) const {}
};

typedef float f32x2 __attribute__((ext_vector_type(2)));
typedef __bf16 bf16x2v __attribute__((ext_vector_type(2)));
__device__ __forceinline__ unsigned cvt_pk_bf16(float lo, float hi) { f32x2 v = {lo, hi}; bf16x2v b = __builtin_convertvector(v, bf16x2v); return __builtin_bit_cast(unsigned, b); }
__device__ __forceinline__ u32x4 pack8(const f32x4 a, const f32x4 b) { u32x4 w; w.x = cvt_pk_bf16(a[0], a[1]); w.y = cvt_pk_bf16(a[2], a[3]); w.z = cvt_pk_bf16(b[0], b[1]); w.w = cvt_pk_bf16(b[2], b[3]); return w; }
#ifndef RES_PREFETCH
#define RES_PREFETCH 0
#endif
#ifndef STORE_WT
#define STORE_WT 0
#endif
__device__ __forceinline__ void st16(bf16_t* p, const u32x4 v) {
#if STORE_WT
    asm volatile("global_store_dwordx4 %0, %1, off sc1\n\ts_nop 1" :: "v"(p), "v"(v) : "memory");
#else
    *(u32x4*)p = v;
#endif
}
__device__ __forceinline__ float row_rstd(const float* ssq, int row, float inv_n, float eps) {
    const f32x4 s0 = *(const f32x4*)(ssq + (size_t)row * 8), s1 = *(const f32x4*)(ssq + (size_t)row * 8 + 4);
    return __builtin_amdgcn_rsqf((((s0[0] + s0[1]) + (s0[2] + s0[3])) + ((s1[0] + s1[1]) + (s1[2] + s1[3]))) * inv_n + eps);
}

template <class Sched>
__device__ __forceinline__ void fill_rstd_table(PG8_LAS float* tab, const Sched& S, const float* ssq, float eps, int tid) {
    Unit u;
    for (int i = 0; S.next(i, u); ++i) if ((tid >> 8) == (i & 1)) tab[i * BM + (tid & 255)] = row_rstd(ssq, u.pm * BM + (tid & 255), 1.0f / 2048.0f, eps);
    asm volatile("s_waitcnt lgkmcnt(0)" ::: "memory"); __builtin_amdgcn_s_barrier(); asm volatile("" ::: "memory");
}

struct MixedOrderG1 : StaticOrder {
    __host__ __device__ bool next(int i, Unit& u) const { const bool ok = StaticOrder::next(i, u); if (ok) u.pn = (u.pn & 3) * 6 + (u.pn >> 2); return ok; }
};

struct EpiG1 {
    static constexpr bool AFTER_DRAIN = false;
    const PG8_LAS float* rs_tab; const float* qg; int g_stride;
    bf16_t* Q; size_t qkv_stride;
    bf16_t* PC;
    float* kout; size_t kv_out_stride;
    float qscale, eps;
    __device__ __forceinline__ void operator()(const f32x4 (&acc)[2][2][4][2], const Unit& u, int ui, int wr, int wc, int fr, int fq) const {
        const int region = u.pn >> 2, head = (u.pn & 3) * 4 + wc;
        f32x4 g[2][2];
#pragma unroll
        for (int bj = 0; bj < 2; ++bj)
#pragma unroll
            for (int n = 0; n < 2; ++n) g[bj][n] = (f32x4){1.f, 1.f, 1.f, 1.f};
        if (region < 2) { const float* gp = qg + region * g_stride; const float s = region == 0 ? qscale : 1.f;
#pragma unroll
            for (int bj = 0; bj < 2; ++bj)
#pragma unroll
                for (int n = 0; n < 2; ++n) g[bj][n] = *(const f32x4*)(gp + bj * 32 + fq * 8 + n * 4) * s; }
#pragma unroll
        for (int ai = 0; ai < 2; ++ai)
#pragma unroll
            for (int m = 0; m < 4; ++m) {
                const int row = u.pm * BM + ai * HALF + wr * 64 + m * 16 + fr;
                const float rs = rs_tab[ui * BM + ai * HALF + wr * 64 + m * 16 + fr];
                f32x4 v[2][2];
#pragma unroll
                for (int bj = 0; bj < 2; ++bj)
#pragma unroll
                    for (int n = 0; n < 2; ++n) v[bj][n] = acc[ai][bj][m][n] * rs;
                if (region < 2) {
                    float q = 0.f;
#pragma unroll
                    for (int bj = 0; bj < 2; ++bj)
#pragma unroll
                        for (int n = 0; n < 2; ++n) { const f32x4 x = v[bj][n]; q += (x[0] * x[0] + x[1] * x[1]) + (x[2] * x[2] + x[3] * x[3]); }
                    q += __shfl_xor(q, 16); q += __shfl_xor(q, 32);
                    const float rh = __builtin_amdgcn_rsqf(q * (1.0f / 64.0f) + eps);
#pragma unroll
                    for (int bj = 0; bj < 2; ++bj)
#pragma unroll
                        for (int n = 0; n < 2; ++n) v[bj][n] = v[bj][n] * rh * g[bj][n];
                }
                if (region < 3) {
                    const int b = row >> 11, t = row & 2047;
                    bf16_t* dst = Q + (size_t)region * qkv_stride + ((size_t)(b * 16 + head) * 2048 + t) * 64 + fq * 8;
#pragma unroll
                    for (int bj = 0; bj < 2; ++bj) *(u32x4*)(dst + bj * 32) = pack8(v[bj][0], v[bj][1]);
                    if (!KV_SIDE && region >= 1) { float* o = kout + (size_t)(region - 1) * kv_out_stride + (size_t)row * 1024 + head * 64 + fq * 8;
#pragma unroll
                        for (int bj = 0; bj < 2; ++bj) { __builtin_nontemporal_store(v[bj][0], (f32x4*)(o + bj * 32)); __builtin_nontemporal_store(v[bj][1], (f32x4*)(o + bj * 32 + 4)); } }
                } else if (u.pn < 20) {
                    bf16_t* dst = PC + (size_t)row * 2048 + (u.pn - 12) * 128 + wc * 32 + fq * 8;
                    *(u32x4*)dst = pack8(v[0][0] * v[1][0], v[0][1] * v[1][1]);
                } else {
                    bf16_t* dst = PC + (size_t)row * 2048 + 1024 + (u.pn - 20) * 256 + wc * 64 + fq * 8;
#pragma unroll
                    for (int bj = 0; bj < 2; ++bj) *(u32x4*)(dst + bj * 32) = pack8(v[bj][0], v[bj][1]);
                }
            }
    }
};

struct EpiG3 {
    static constexpr bool AFTER_DRAIN = false;
    const PG8_LAS float* rs_tab; bf16_t* Hb; int ldc;
    __device__ __forceinline__ void operator()(const f32x4 (&acc)[2][2][4][2], const Unit& u, int ui, int wr, int wc, int fr, int fq) const {
#pragma unroll
        for (int ai = 0; ai < 2; ++ai)
#pragma unroll
            for (int m = 0; m < 4; ++m) {
                const int row = u.pm * BM + ai * HALF + wr * 64 + m * 16 + fr;
                const float rs = rs_tab[ui * BM + ai * HALF + wr * 64 + m * 16 + fr];
                bf16_t* dst = Hb + (size_t)row * ldc + u.pn * BM + wc * 64 + fq * 8;
#pragma unroll
                for (int bj = 0; bj < 2; ++bj) {
                    f32x4 a = acc[ai][bj][m][0] * rs, b = acc[ai][bj][m][1] * rs;
#pragma unroll
                    for (int i = 0; i < 4; ++i) { const float x = fmaxf(a[i], 0.f), y = fmaxf(b[i], 0.f); a[i] = x * x; b[i] = y * y; }
                    st16(dst + bj * 32, pack8(a, b));
                }
            }
    }
};

struct EpiRes {
    static constexpr bool AFTER_DRAIN = true;
    bf16_t* xb; float* ssq_out; float* yout;
    __device__ __forceinline__ void prefetch(const Unit& u, int wr, int wc, int fr, int fq, u32x4 (&res)[2][4][2]) const {
#pragma unroll
        for (int ai = 0; ai < RES_PREFETCH; ++ai)
#pragma unroll
            for (int m = 0; m < 4; ++m) {
                const size_t off = (size_t)(u.pm * BM + ai * HALF + wr * 64 + m * 16 + fr) * 2048 + u.pn * BM + wc * 64 + fq * 8;
#pragma unroll
                for (int bj = 0; bj < 2; ++bj) res[ai][m][bj] = *(const u32x4*)(xb + off + bj * 32);
            }
    }
    __device__ __forceinline__ void fused(const f32x4 (&acc)[2][2][4][2], const u32x4 (&res)[2][4][2], const Unit& u, int wr, int wc, int fr, int fq, PG8_LAS unsigned char* lds, int wid, int lane) const {
        PG8_LAS float* P = (PG8_LAS float*)lds;
#pragma unroll
        for (int ai = 0; ai < 2; ++ai)
#pragma unroll
            for (int m = 0; m < 4; ++m) {
                const int rl = ai * HALF + wr * 64 + m * 16 + fr;
                const size_t off = (size_t)(u.pm * BM + rl) * 2048 + u.pn * BM + wc * 64 + fq * 8;
                float q = 0.f;
#pragma unroll
                for (int bj = 0; bj < 2; ++bj) {
                    const u32x4 xo = ai < RES_PREFETCH ? res[ai][m][bj] : *(const u32x4*)(xb + off + bj * 32);
                    f32x4 v0, v1;
                    v0[0] = __uint_as_float(xo[0] << 16); v0[1] = __uint_as_float(xo[0] & 0xffff0000u); v0[2] = __uint_as_float(xo[1] << 16); v0[3] = __uint_as_float(xo[1] & 0xffff0000u);
                    v1[0] = __uint_as_float(xo[2] << 16); v1[1] = __uint_as_float(xo[2] & 0xffff0000u); v1[2] = __uint_as_float(xo[3] << 16); v1[3] = __uint_as_float(xo[3] & 0xffff0000u);
                    v0 += acc[ai][bj][m][0]; v1 += acc[ai][bj][m][1];
                    if (yout) { *(f32x4*)(yout + off + bj * 32) = v0; *(f32x4*)(yout + off + bj * 32 + 4) = v1; continue; }
                    st16(xb + off + bj * 32, pack8(v0, v1));
                    q += ((v0[0] * v0[0] + v0[1] * v0[1]) + (v0[2] * v0[2] + v0[3] * v0[3])) + ((v1[0] * v1[0] + v1[1] * v1[1]) + (v1[2] * v1[2] + v1[3] * v1[3]));
                }
                if (yout) continue;
                q += __shfl_xor(q, 16); q += __shfl_xor(q, 32);
                if (fq == 0) P[rl * 4 + wc] = q;
            }
        if (yout) return;
        asm volatile("s_waitcnt lgkmcnt(0)" ::: "memory"); __builtin_amdgcn_s_barrier(); asm volatile("" ::: "memory");
        const int tid = wid * 64 + lane;
        if (tid < 256) { const f32x4 p = *(const PG8_LAS f32x4*)(P + tid * 4); ssq_out[(size_t)(u.pm * BM + tid) * 8 + u.pn] = (p[0] + p[1]) + (p[2] + p[3]); }
        asm volatile("s_waitcnt lgkmcnt(0)" ::: "memory"); __builtin_amdgcn_s_barrier(); asm volatile("" ::: "memory");
    }
};

struct EpiNull { static constexpr bool AFTER_DRAIN = true;
    __device__ __forceinline__ void prefetch(const Unit&, int, int, int, int, u32x4 (&)[2][4][2]) const {}
    __device__ __forceinline__ void fused(const f32x4 (&acc)[2][2][4][2], const u32x4 (&)[2][4][2], const Unit& u, int wr, int wc, int fr, int fq, PG8_LAS unsigned char* lds, int wid, int lane) const {
        float s = 0.f;
#pragma unroll
        for (int ai = 0; ai < 2; ++ai)
#pragma unroll
            for (int bj = 0; bj < 2; ++bj)
#pragma unroll
                for (int m = 0; m < 4; ++m)
#pragma unroll
                    for (int n = 0; n < 2; ++n) s += acc[ai][bj][m][n][0] + acc[ai][bj][m][n][1] + acc[ai][bj][m][n][2] + acc[ai][bj][m][n][3];
        if (s == 1.2345e-30f) *(PG8_LAS float*)lds = s;
    }
};

struct NoSide { static constexpr bool ON = false; __device__ __forceinline__ void prime() {} __device__ __forceinline__ void fetch() {} __device__ __forceinline__ void step(int) {} };
template <class Epi, class Sched, bool ALIGN_EPI = false, bool SP2 = false, class Side = NoSide>
__device__ __forceinline__ void gemm_phase(PG8_LAS unsigned char* lds, const Gemm g, const Sched& S, const Epi& E, Side side = Side()) {
    int tid_ = (int)__builtin_amdgcn_mbcnt_hi(~0u, __builtin_amdgcn_mbcnt_lo(~0u, 0u)) + 64 * g.wave; asm volatile("" : "+v"(tid_));
    const int tid = tid_, wid = __builtin_amdgcn_readfirstlane(tid >> 6), lane = tid & 63, wr = wid >> 2, wc = wid & 3, fr = lane & 15, fq = lane >> 4;
    const int K = g.K, nt = K / BK;
    unsigned voffA[2], voffB[2];
#pragma unroll
    for (int i = 0; i < 2; ++i) { int R, C; stage_rc(tid * 16 + i * 8192, R, C); const int Rb = 64 * (R >> 5) + perm32(R & 31);
        voffA[i] = (unsigned)(R * K + C) * 2u; voffB[i] = (unsigned)(Rb * K + C) * 2u; }
    const size_t kstep = (size_t)(BK * 2);
    const size_t hstep = (size_t)HALF * K * 2;
    const size_t hstepB = (size_t)32 * K * 2; const size_t tstep = 2 * hstep;
    const unsigned ldsw = (unsigned)wid * 1024u;
    const int aoff = lds_byte(wr * 64 + fr, fq * 8), boff = lds_byte(wc * 32 + fr, fq * 8);
#define PG8_SA(b, h) (((b) * 2 + (h)) * HTB)
#define PG8_SB(b, h) ((4 + (b) * 2 + (h)) * HTB)
#define PG8_STAGE(bufoff, gbase, voff) do { _Pragma("unroll") for (int _i = 0; _i < 2; ++_i) \
        __builtin_amdgcn_global_load_lds((const unsigned*)((const char*)(gbase) + (voff)[_i]), (PG8_LAS unsigned*)(lds + (bufoff) + ldsw + _i * 8192), 16, 0, 0); } while (0)
#define PG8_LDA(dst, b, h) do { _Pragma("unroll") for (int m = 0; m < 4; ++m) _Pragma("unroll") for (int k = 0; k < 2; ++k) dst[m][k] = *(const PG8_LAS bf16x8*)(lds + PG8_SA(b, h) + aoff + m * 2048 + k * 1024); } while (0)
#define PG8_LDB(dst, b, h) do { _Pragma("unroll") for (int n = 0; n < 2; ++n) _Pragma("unroll") for (int k = 0; k < 2; ++k) dst[n][k] = *(const PG8_LAS bf16x8*)(lds + PG8_SB(b, h) + boff + n * 2048 + k * 1024); } while (0)
#define PG8_MMA(ai, bj, At, Bt) do { __builtin_amdgcn_s_setprio(1); _Pragma("unroll") for (int m = 0; m < 4; ++m) _Pragma("unroll") for (int n = 0; n < 2; ++n) _Pragma("unroll") for (int k = 0; k < 2; ++k) \
        acc[ai][bj][m][n] = __builtin_amdgcn_mfma_f32_16x16x32_bf16(Bt[n][k], At[m][k], acc[ai][bj][m][n], 0, 0, 0); __builtin_amdgcn_s_setprio(0); } while (0)
#define PG8_WAIT_V(n) asm volatile("s_waitcnt vmcnt(" #n ")" ::: "memory")
#define PG8_WAIT_L(n) asm volatile("s_waitcnt lgkmcnt(" #n ")" ::: "memory")
#define PG8_BAR __builtin_amdgcn_s_barrier()
#define PG8_SCHED __builtin_amdgcn_sched_barrier(0)
    Unit cur, nxt; int ui = 0;
    if (!S.next(0, cur)) return;
    f32x4 acc[2][2][4][2];
#pragma unroll
    for (int a = 0; a < 2; ++a)
#pragma unroll
        for (int b = 0; b < 2; ++b)
#pragma unroll
            for (int m = 0; m < 4; ++m)
#pragma unroll
                for (int n = 0; n < 2; ++n) acc[a][b][m][n] = (f32x4){0.f, 0.f, 0.f, 0.f};
    bf16x8 At[4][2], B0[2][2], B1[2][2];
    const char* cA = (const char*)g.A + (size_t)cur.pm * tstep; const char* cB = (const char*)g.Bt + (size_t)cur.pn * tstep;
    S.a_ready(cur);
    if constexpr (SP2) {
        if constexpr (Side::ON) side.prime();
        PG8_STAGE(PG8_SB(0, 0), cB, voffB); PG8_STAGE(PG8_SB(0, 1), cB + hstepB, voffB); PG8_STAGE(PG8_SA(0, 0), cA, voffA); PG8_STAGE(PG8_SA(0, 1), cA + hstep, voffA);
        if (wr == 1) PG8_BAR;
        PG8_WAIT_V(2); PG8_BAR;
        PG8_STAGE(PG8_SB(1, 0), cB + kstep, voffB); PG8_STAGE(PG8_SA(1, 0), cA + kstep, voffA); PG8_STAGE(PG8_SB(1, 1), cB + hstepB + kstep, voffB);
        PG8_WAIT_V(6); PG8_BAR;
        if constexpr (Side::ON) side.fetch();
    } else {
        PG8_STAGE(PG8_SB(0, 0), cB, voffB); PG8_STAGE(PG8_SA(0, 0), cA, voffA); PG8_STAGE(PG8_SB(0, 1), cB + hstepB, voffB); PG8_STAGE(PG8_SA(0, 1), cA + hstep, voffA);
        if (wr == 1) PG8_BAR;
        PG8_WAIT_V(4); PG8_BAR;
        PG8_STAGE(PG8_SB(1, 0), cB + kstep, voffB); PG8_STAGE(PG8_SA(1, 0), cA + kstep, voffA); PG8_STAGE(PG8_SB(1, 1), cB + hstepB + kstep, voffB);
        PG8_WAIT_V(6); PG8_BAR;
    }
    for (;;) {
        const bool has_next = S.next(ui + 1, nxt);
        const char* nA = has_next ? (const char*)g.A + (size_t)nxt.pm * tstep : cA; const char* nB = has_next ? (const char*)g.Bt + (size_t)nxt.pn * tstep : cB;
        for (int t = 0; t < nt; t += 2) {
            const bool last = (t == nt - 2);
            const char* a1 = cA + (size_t)(t + 1) * kstep;
            const char* a2 = last ? nA : cA + (size_t)(t + 2) * kstep; const char* b2 = last ? nB : cB + (size_t)(t + 2) * kstep;
            const char* a3 = a2 + kstep; const char* b3 = b2 + kstep;
            if (last && has_next) S.a_ready(nxt);
            if constexpr (SP2) {
            PG8_LDB(B0, 0, 0); PG8_LDB(B1, 0, 1); PG8_SCHED; PG8_LDA(At, 0, 0); PG8_STAGE(PG8_SA(1, 1), a1 + hstep, voffA);
            if constexpr (Side::ON) { side.step(ui * (nt >> 1) + (t >> 1)); PG8_WAIT_V(9); } else PG8_WAIT_V(8);
            PG8_WAIT_L(0); PG8_BAR; PG8_MMA(0, 0, At, B0); PG8_MMA(0, 1, At, B1); PG8_BAR; PG8_SCHED;
            PG8_LDA(At, 0, 1); PG8_STAGE(PG8_SB(0, 0), b2, voffB); PG8_STAGE(PG8_SB(0, 1), b2 + hstepB, voffB); PG8_STAGE(PG8_SA(0, 0), a2, voffA);
            if constexpr (Side::ON) PG8_WAIT_V(9); else PG8_WAIT_V(8);
            PG8_WAIT_L(0); PG8_BAR; PG8_MMA(1, 0, At, B0); PG8_MMA(1, 1, At, B1); PG8_BAR; PG8_SCHED;
            PG8_LDB(B0, 1, 0); PG8_LDB(B1, 1, 1); PG8_SCHED; PG8_LDA(At, 1, 0); PG8_STAGE(PG8_SA(0, 1), a2 + hstep, voffA);
            PG8_WAIT_V(8); PG8_WAIT_L(0); PG8_BAR; PG8_MMA(0, 0, At, B0); PG8_MMA(0, 1, At, B1); PG8_BAR; PG8_SCHED;
            PG8_LDA(At, 1, 1); if constexpr (Side::ON) side.fetch();
            PG8_STAGE(PG8_SB(1, 0), b3, voffB); PG8_STAGE(PG8_SB(1, 1), b3 + hstepB, voffB); PG8_STAGE(PG8_SA(1, 0), a3, voffA);
            PG8_WAIT_V(8); PG8_WAIT_L(0); PG8_BAR; PG8_MMA(1, 0, At, B0); PG8_MMA(1, 1, At, B1); PG8_BAR; PG8_SCHED;
            } else {
            PG8_LDB(B0, 0, 0); PG8_SCHED; PG8_LDA(At, 0, 0); PG8_STAGE(PG8_SA(1, 1), a1 + hstep, voffA);
            PG8_WAIT_L(8); PG8_BAR; PG8_WAIT_L(0); PG8_MMA(0, 0, At, B0); PG8_BAR; PG8_SCHED;
            PG8_LDB(B1, 0, 1); PG8_STAGE(PG8_SB(0, 0), b2, voffB);
            PG8_BAR; PG8_WAIT_L(0); PG8_MMA(0, 1, At, B1); PG8_BAR;
            PG8_LDA(At, 0, 1); PG8_STAGE(PG8_SA(0, 0), a2, voffA);
            PG8_BAR; PG8_WAIT_L(0); PG8_MMA(1, 0, At, B0); PG8_BAR; PG8_SCHED;
            PG8_STAGE(PG8_SB(0, 1), b2 + hstepB, voffB);
            PG8_WAIT_V(6); PG8_BAR; PG8_MMA(1, 1, At, B1); PG8_BAR;
            PG8_LDB(B0, 1, 0); PG8_SCHED; PG8_LDA(At, 1, 0); PG8_STAGE(PG8_SA(0, 1), a2 + hstep, voffA);
            PG8_WAIT_L(8); PG8_BAR; PG8_WAIT_L(0); PG8_MMA(0, 0, At, B0); PG8_BAR; PG8_SCHED;
            PG8_LDB(B1, 1, 1); PG8_STAGE(PG8_SB(1, 0), b3, voffB);
            PG8_BAR; PG8_WAIT_L(0); PG8_MMA(0, 1, At, B1); PG8_BAR;
            PG8_LDA(At, 1, 1); PG8_STAGE(PG8_SA(1, 0), a3, voffA);
            PG8_BAR; PG8_WAIT_L(0); PG8_MMA(1, 0, At, B0); PG8_BAR; PG8_SCHED;
            PG8_STAGE(PG8_SB(1, 1), b3 + hstepB, voffB);
            PG8_WAIT_V(6); PG8_BAR; PG8_MMA(1, 1, At, B1); PG8_BAR;
            }
        }
        if constexpr (ALIGN_EPI) { if (wr == 0) PG8_BAR; }
        if constexpr (!Epi::AFTER_DRAIN) { E(acc, cur, ui, wr, wc, fr, fq); S.done(cur); }
        if (!has_next) break;
#pragma unroll
        for (int a = 0; a < 2; ++a)
#pragma unroll
            for (int b = 0; b < 2; ++b)
#pragma unroll
                for (int m = 0; m < 4; ++m)
#pragma unroll
                    for (int n = 0; n < 2; ++n) acc[a][b][m][n] = (f32x4){0.f, 0.f, 0.f, 0.f};
        cur = nxt; cA = nA; cB = nB; ++ui;
        if constexpr (ALIGN_EPI) { if (wr == 1) PG8_BAR; }
    }
    u32x4 res[2][4][2];
    if constexpr (Epi::AFTER_DRAIN) E.prefetch(cur, wr, wc, fr, fq, res);
    PG8_WAIT_V(0);
    if constexpr (!ALIGN_EPI) { if (wr == 0) PG8_BAR; }
    PG8_BAR;
    if constexpr (Epi::AFTER_DRAIN) { E.fused(acc, res, cur, wr, wc, fr, fq, lds, wid, lane); S.done(cur); }
#undef PG8_SA
#undef PG8_SB
#undef PG8_STAGE
#undef PG8_LDA
#undef PG8_LDB
#undef PG8_MMA
#undef PG8_WAIT_V
#undef PG8_WAIT_L
#undef PG8_BAR
#undef PG8_SCHED
}
}

constexpr int NWAVES = 8;
#ifndef MK_ONE_LAUNCH
#define MK_ONE_LAUNCH 1
#endif
#ifndef COPY_IN_P0
#define COPY_IN_P0 0
#endif
#ifndef ATT_NMOVE
#define ATT_NMOVE (COPY_IN_P0 ? 0 : 3)
#endif
#ifndef ATT_V4
#define ATT_V4 1
#endif
#ifndef ATT4_MOVERS
#define ATT4_MOVERS 4
#endif
#ifndef GEMM_ALIGN
#define GEMM_ALIGN true
#endif
#ifndef GEMM_SP2
#define GEMM_SP2 true
#endif
#ifndef STAGGER
#define STAGGER 1
#endif
#ifndef STAGGER_MODE
#define STAGGER_MODE 0
#endif
#define STAGGER_PRED(v) (STAGGER_MODE == 0 ? ((v) & 1) : STAGGER_MODE == 1 ? (((v) & 3) == 0) : STAGGER_MODE == 2 ? (((v) >> 1) & 1) : (((v) % 3) == 0))
#ifndef CONV_ORDER
#define CONV_ORDER 0
#endif
#ifndef CONV_IN_P0
#define CONV_IN_P0 0
#endif
constexpr int NB = 4, S = 2048, D = 2048, DEPTH = 4, SB = 8, WBUF = 2048, H = 16, HD = 64, DA = 1024, DC = 1024, DIN = 6144, DFF = 8192;
constexpr int M = NB * S;
constexpr float EPS = 1e-6f;
constexpr float QSCALE = 0.125f * 1.4426950408889634f;
constexpr float LOG2E = 1.4426950408889634f;
constexpr int NPH = 1 + 6 * DEPTH;

constexpr size_t O_Y = 0, O_YS = 16777216, O_KP = 16793600, O_VP = 50348032, O_CP = 83902464, O_KS = 83935232, O_VS = 151044096, O_CS = 218152960, O_END = 218218496;

constexpr size_t MiB = 1u << 20;
constexpr size_t WS_CTL = 0, CTL_ZERO_BYTES = 64 * 1024;
constexpr size_t WS_WIN = 1 * MiB;
constexpr size_t WS_WOUT = WS_WIN + 96 * MiB;
constexpr size_t WS_WUP = WS_WOUT + 32 * MiB;
constexpr size_t WS_WDN = WS_WUP + 128 * MiB;
constexpr size_t WS_XB = WS_WDN + 128 * MiB;
constexpr size_t WS_Q = WS_XB + 32 * MiB, WS_K = WS_Q + 16 * MiB, WS_V = WS_K + 16 * MiB;
constexpr size_t WS_PC = WS_V + 16 * MiB;
constexpr size_t WS_OP = WS_PC + 48 * MiB;
constexpr size_t WS_ML = WS_OP + 96 * MiB;
constexpr size_t WS_MIX = WS_ML + 3 * MiB;
constexpr size_t WS_HB = WS_MIX + 32 * MiB;
constexpr size_t WS_SSQA = WS_HB + 128 * MiB;
constexpr size_t WS_SSQB = WS_SSQA + 256 * 1024;
constexpr size_t WS_SMALL = WS_SSQB + 256 * 1024 + 512 * 1024;
constexpr size_t WS_XS = WS_SMALL;
constexpr size_t WS_PS = WS_XS + 64 * 1024;
constexpr size_t WS_OS = WS_PS + 192 * 1024;
constexpr size_t WS_MIXS = WS_OS + 32 * 1024;
constexpr size_t WS_AS = WS_MIXS + 64 * 1024;
constexpr size_t WS_BT = WS_AS + 256 * 1024;
constexpr size_t WS_GN = WS_BT + 32 * 1024;
constexpr size_t WS_CW = WS_GN + 4 * 1024;
constexpr size_t WS_SC = WS_CW + 64 * 1024;
constexpr size_t WS_SINK = WS_SMALL + 1 * MiB;
constexpr size_t WS_END = WS_SINK + 8 * MiB;
static_assert(WS_SC + 256 * 1024 <= WS_END, "small buffers");
constexpr int CW_BAR = 4096;

#ifndef EARLY_WBL2
#define EARLY_WBL2 0
#endif
#if EARLY_WBL2
#define EARLY_WB() asm volatile("buffer_wbl2 sc1" ::: "memory")
#else
#define EARLY_WB() do {} while (0)
#endif
#ifndef CONV_SKEW
#define CONV_SKEW 3
#endif
#ifndef COPY_IN_G4
#define COPY_IN_G4 0
#endif
#ifndef COPY_BOTH
#define COPY_BOTH 0
#endif
#ifndef CONV_RING
#define CONV_RING 0
#endif
#ifndef CONV_DP
#define CONV_DP 5
#endif
constexpr int LDS_BYTES = 147456;
constexpr int LDSCTL_OFF = LDS_BYTES - 512;
constexpr int MISC_OFF = LDSCTL_OFF;
constexpr int RS_TAB_OFF = 131072;
static_assert(RS_TAB_OFF + 4 * 256 * 4 <= LDSCTL_OFF, "LDS map");

#define GAS __attribute__((address_space(1)))
#define LAS __attribute__((address_space(3)))
typedef unsigned short bf16;
typedef unsigned v4u __attribute__((ext_vector_type(4)));
typedef unsigned v2u __attribute__((ext_vector_type(2)));
typedef float f32x4 __attribute__((ext_vector_type(4)));
typedef float f32x2 __attribute__((ext_vector_type(2)));
typedef float f32x16 __attribute__((ext_vector_type(16)));
typedef short bf16x8 __attribute__((ext_vector_type(8)));
typedef short s16x4 __attribute__((ext_vector_type(4)));
typedef GAS unsigned gu32;
#define RLX_AGENT __ATOMIC_RELAXED, __HIP_MEMORY_SCOPE_AGENT
using pg8::cvt_pk_bf16;
using pg8::pack8;

#define XB_TMO      128
#define XB_XCNT(j)  (256  + 64 * (j))
#define XB_XSUB(j)  (1280 + 64 * (j))
#define XB_XGEN(j)  (2304 + 64 * (j))
#define XB_TOP      3328
#define XB_TOPGEN   3392
#define XCD_BAR_WORDS 3456
#define XB_SPIN_CAP (1u << 18)

__device__ __forceinline__ unsigned xb_ld(unsigned* p)              { return __hip_atomic_load(p, __ATOMIC_RELAXED, __HIP_MEMORY_SCOPE_AGENT); }
__device__ __forceinline__ unsigned xb_add(unsigned* p, unsigned v) { return __hip_atomic_fetch_add(p, v, __ATOMIC_RELAXED, __HIP_MEMORY_SCOPE_AGENT); }
__device__ __forceinline__ unsigned xb_xcc_id() { return (unsigned)__builtin_amdgcn_s_getreg((3 << 11) | 20) & 0xFu; }
#define XB_SPIN(cond, bar) do { unsigned _sp = 0; while (cond) { __builtin_amdgcn_s_sleep(1); \
    if ((++_sp & 255u) == 0u) { if (xb_ld(&(bar)[XB_TMO])) break; if (_sp > XB_SPIN_CAP) { atomicAdd(&(bar)[XB_TMO], 1u); break; } } } } while (0)

__device__ __forceinline__ bool xb_lane0() { return __builtin_amdgcn_mbcnt_hi(~0u, __builtin_amdgcn_mbcnt_lo(~0u, 0u)) == 0u; }
struct XcdBarrier {
    int wave;
    unsigned* bar; unsigned x;
    volatile LAS unsigned* st;
};

__device__ __forceinline__ XcdBarrier xcd_barrier_post(unsigned* bar, volatile LAS unsigned* st, int wave) {
    XcdBarrier b; b.wave = wave; b.bar = bar; b.x = xb_xcc_id(); b.st = st;
    if (wave == 0 && xb_lane0()) (void)xb_add(&bar[XB_XCNT(b.x)], 1u);
    return b;
}
__device__ __forceinline__ void xcd_barrier_complete(unsigned* bar, unsigned x, unsigned& nloc, unsigned& nx) {
    const unsigned G = gridDim.x * gridDim.y * gridDim.z;
    unsigned sum, cnt, mine, sp = 0u;
    for (;;) {
        sum = 0u; cnt = 0u; mine = 0u;
#pragma unroll
        for (unsigned j = 0; j < 16; ++j) { const unsigned c = xb_ld(&bar[XB_XCNT(j)]); sum += c; cnt += (c > 0u) ? 1u : 0u; mine = (j == x) ? c : mine; }
        if (sum == G) break;
        __builtin_amdgcn_s_sleep(1);
        if ((++sp & 255u) == 0u) { if (xb_ld(&bar[XB_TMO])) break; if (sp > XB_SPIN_CAP) { atomicAdd(&bar[XB_TMO], 1u); break; } }
    }
    nloc = mine > 0u ? mine : 1u; nx = cnt > 0u ? cnt : 1u;
}

__device__ __forceinline__ void xcd_barrier(const XcdBarrier& b) {
    asm volatile("s_waitcnt vmcnt(0)" ::: "memory");
    __syncthreads();
    if (b.wave == 0 && xb_lane0()) {
        unsigned* bar = b.bar;
        __builtin_amdgcn_s_waitcnt(0);
        unsigned nloc = b.st[0], nx = b.st[1];
        if (nloc == 0u) { xcd_barrier_complete(bar, b.x, nloc, nx); b.st[0] = nloc; b.st[1] = nx; }
        const unsigned old = xb_add(&bar[XB_XSUB(b.x)], 1u);
        const unsigned gen = old / nloc;
        if (old + 1u == (gen + 1u) * nloc) {
            __builtin_amdgcn_fence(__ATOMIC_RELEASE, "agent");
            asm volatile("s_waitcnt vmcnt(0)" ::: "memory");
            const unsigned og = xb_add(&bar[XB_TOP], 1u);
            const unsigned tg = og / nx;
            if (og + 1u == (tg + 1u) * nx) xb_add(&bar[XB_TOPGEN], 1u);
            else XB_SPIN(xb_ld(&bar[XB_TOPGEN]) == tg, bar);
            __builtin_amdgcn_fence(__ATOMIC_ACQUIRE, "agent");
            xb_add(&bar[XB_XGEN(b.x)], 1u);
            asm volatile("s_waitcnt vmcnt(0)" ::: "memory");
        } else {
            XB_SPIN(xb_ld(&bar[XB_XGEN(b.x)]) == gen, bar);
            __builtin_amdgcn_fence(__ATOMIC_ACQUIRE, "agent");
            asm volatile("s_waitcnt vmcnt(0)" ::: "memory");
        }
    }
    __syncthreads();
}


struct Frame {
    LAS unsigned char* lds;
    int tid, lane, wave, vcu, G;
    unsigned char* ws; float* out;
    const float *x_prompt, *state_k, *state_v;
};
template <class T> __device__ __forceinline__ T* opq(T* p) { GAS T* g = (GAS T*)p; asm volatile("" : "+s"(g)); return (T*)g; }
__device__ __forceinline__ int opqv(int x) { asm volatile("" : "+v"(x)); return x; }
__device__ __forceinline__ int fresh_tid(int wave) { int l = (int)__builtin_amdgcn_mbcnt_hi(~0u, __builtin_amdgcn_mbcnt_lo(~0u, 0u)); asm volatile("" : "+v"(l)); return 64 * wave + l; }
#define W_WIN(w) ((bf16*)((w) + WS_WIN))
#define W_WOUT(w) ((bf16*)((w) + WS_WOUT))
#define W_WUP(w) ((bf16*)((w) + WS_WUP))
#define W_WDN(w) ((bf16*)((w) + WS_WDN))
#define W_XB(w) ((bf16*)((w) + WS_XB))
#define W_Q(w) ((bf16*)((w) + WS_Q))
#define W_K(w) ((bf16*)((w) + WS_K))
#define W_V(w) ((bf16*)((w) + WS_V))
#define W_PC(w) ((bf16*)((w) + WS_PC))
#define W_MIX(w) ((bf16*)((w) + WS_MIX))
#define W_HB(w) ((bf16*)((w) + WS_HB))
#define W_OPB(w) ((bf16*)((w) + WS_OP))
#define W_ML(w) ((float*)((w) + WS_ML))
#define W_SSQA(w) ((float*)((w) + WS_SSQA))
#define W_SSQB(w) ((float*)((w) + WS_SSQB))
#define W_XS(w) ((float*)((w) + WS_XS))
#define W_PS(w) ((float*)((w) + WS_PS))
#define W_OS(w) ((float*)((w) + WS_OS))
#define W_MIXS(w) ((float*)((w) + WS_MIXS))
#define W_AS(w) ((float*)((w) + WS_AS))
#define W_BT(w) ((float*)((w) + WS_BT))
#define W_GN(w) ((float*)((w) + WS_GN))
#define W_CW(w) ((float*)((w) + WS_CW))
#define W_SC(w) ((float*)((w) + WS_SC))

__device__ __forceinline__ float wave_sum(float v) {
#pragma unroll
    for (int o = 1; o < 64; o <<= 1) v += __shfl_xor(v, o);
    return v;
}
__device__ __forceinline__ float wave_max(float v) {
#pragma unroll
    for (int o = 1; o < 64; o <<= 1) v = fmaxf(v, __shfl_xor(v, o));
    return v;
}
__device__ __forceinline__ float max3f(float a, float b, float c) { float r; asm("v_max3_f32 %0, %1, %2, %3" : "=v"(r) : "v"(a), "v"(b), "v"(c)); return r; }
#define LDS_WAIT() asm volatile("s_waitcnt lgkmcnt(0)" ::: "memory")
#define WG_BAR() do { asm volatile("s_waitcnt vmcnt(0) lgkmcnt(0)" ::: "memory"); __builtin_amdgcn_s_barrier(); asm volatile("" ::: "memory"); } while (0)

struct Args { const float* in[17]; float* out; unsigned char* ws; int ph_lo, ph_hi; };
struct P0Item { const float* W; const float* g; bf16* WT; int K, N, k0, n0, perm; };
__device__ __forceinline__ int win_row(int col) {
    if (col < 3072) return col;
    if (col < 4096) { const int c = col - 3072; return 3072 + 256 * (c >> 7) + 64 * ((c >> 5) & 3) + (c & 31); }
    if (col < 5120) return 5120 + (col - 4096);
    const int c = col - 5120; return 3072 + 256 * (c >> 7) + 64 * ((c >> 5) & 3) + 32 + (c & 31);
}
__device__ __forceinline__ void p0_item_load(const P0Item& d, int lane, f32x4 (&v)[8], float& gk) {
#pragma unroll
    for (int i = 0; i < 8; ++i) v[i] = __builtin_nontemporal_load((const f32x4*)(d.W + (size_t)(d.k0 + 8 * i + (lane >> 3)) * d.N + d.n0 + (lane & 7) * 4));
    gk = d.g ? d.g[d.k0 + lane] : 1.f;
}
__device__ __forceinline__ void p0_item_store(const P0Item& d, int lane, const f32x4 (&v)[8], float gk, LAS float* scr) {
#pragma unroll
    for (int i = 0; i < 8; ++i) { const int kk = 8 * i + (lane >> 3); const float gg = __shfl(gk, kk);
        LAS float* s = scr + kk * 33 + (lane & 7) * 4; s[0] = v[i][0] * gg; s[1] = v[i][1] * gg; s[2] = v[i][2] * gg; s[3] = v[i][3] * gg; }
    LDS_WAIT(); asm volatile("" ::: "memory");
    const int c = lane & 7;
#pragma unroll
    for (int j = 0; j < 4; ++j) { const int n = (lane >> 3) + 8 * j; const LAS float* s = scr + (8 * c) * 33 + n;
        v4u o; o.x = cvt_pk_bf16(s[0 * 33], s[1 * 33]); o.y = cvt_pk_bf16(s[2 * 33], s[3 * 33]); o.z = cvt_pk_bf16(s[4 * 33], s[5 * 33]); o.w = cvt_pk_bf16(s[6 * 33], s[7 * 33]);
        *(GAS v4u*)(d.WT + (size_t)(d.perm ? win_row(d.n0 + n) : d.n0 + n) * d.K + d.k0 + 8 * c) = o; }
    LDS_WAIT(); asm volatile("" ::: "memory");
}
__device__ __forceinline__ int t5_bucket(int dist) {
    if (dist < 16) return dist;
    int b = 16;
    b += dist >= 22; b += dist >= 30; b += dist >= 40; b += dist >= 54; b += dist >= 73; b += dist >= 99; b += dist >= 134; b += dist >= 182;
    b += dist >= 246; b += dist >= 332; b += dist >= 450; b += dist >= 609; b += dist >= 825; b += dist >= 1117; b += dist >= 1513;
    return b;
}
constexpr int I_IN = (D / 64) * (DIN / 32), I_OUT = (D / 64) * (D / 32), I_UP = (D / 64) * (DFF / 32), I_DN = (DFF / 64) * (D / 32);
__device__ __forceinline__ int conv_count(int stage) { return stage == 0 ? I_IN : I_OUT + I_UP + I_DN + (stage < DEPTH ? I_IN : 0); }
__device__ __forceinline__ void p0_item_desc(const Args& A, unsigned char* w, int stage, int it, P0Item& d) {
    int l = stage == 0 ? 0 : stage - 1, r = it, mat = 0;
    if (stage != 0) { if (r < I_OUT) mat = 1; else if ((r -= I_OUT) < I_UP) mat = 2; else if ((r -= I_UP) < I_DN) mat = 3; else { r -= I_DN; mat = 0; l += 1; } }
    d.perm = mat == 0;
    if (mat == 0) { d.W = A.in[7] + (size_t)l * D * DIN; d.K = D; d.N = DIN; d.g = A.in[6] + l * D; d.WT = W_WIN(w) + (size_t)l * DIN * D; }
    else if (mat == 1) { d.W = A.in[13] + (size_t)l * D * D; d.K = D; d.N = D; d.g = nullptr; d.WT = W_WOUT(w) + (size_t)l * D * D; }
    else if (mat == 2) { d.W = A.in[15] + (size_t)l * D * DFF; d.K = D; d.N = DFF; d.g = A.in[14] + l * D; d.WT = W_WUP(w) + (size_t)l * DFF * D; }
    else { d.W = A.in[16] + (size_t)l * DFF * D; d.K = DFF; d.N = D; d.g = nullptr; d.WT = W_WDN(w) + (size_t)l * D * DFF; }
    const int nblk = d.N / 32, kb = r / nblk; d.k0 = 64 * kb; d.n0 = 32 * (r - kb * nblk);
    if (mat == 1) d.g = (d.k0 < DA ? A.in[11] + l * DA : A.in[12] + l * DC - DA);
}
__device__ __forceinline__ void conv_run(const Args& A, unsigned char* w, int stage, int it0, int stride, int lane, LAS float* scr) {
    const int n = conv_count(stage);
    P0Item dc, dn; f32x4 vc[8], vn[8]; float gc = 1.f, gn = 1.f;
    int it = it0;
    if (it < n) { p0_item_desc(A, w, stage, it, dc); p0_item_load(dc, lane, vc, gc); }
    for (; it < n; it += stride) {
        const bool more = it + stride < n;
        if (more) { p0_item_desc(A, w, stage, it + stride, dn); p0_item_load(dn, lane, vn, gn); }
        p0_item_store(dc, lane, vc, gc, scr);
        if (more) { dc = dn; gc = gn;
#pragma unroll
            for (int i = 0; i < 8; ++i) vc[i] = vn[i]; }
    }
}
struct CDesc { const float* W; bf16* WT; int N, K, goff; };
__device__ __forceinline__ void cdesc(const Args& A, unsigned char* w, int stage, int it, int sinkoff, CDesc& d) {
    if (it < 0) { d.W = A.in[7]; d.N = 0; d.WT = (bf16*)(w + WS_SINK) + sinkoff; d.K = 64; d.goff = 3 * 2048; return; }
    int l = stage == 0 ? 0 : stage - 1, r = it, mat = 0;
    if (stage != 0) { if (r < I_OUT) mat = 1; else if ((r -= I_OUT) < I_UP) mat = 2; else if ((r -= I_UP) < I_DN) mat = 3; else { r -= I_DN; mat = 0; l += 1; } }
    const float* Wb; bf16* WTb; int K, N;
    if (mat == 0) { Wb = A.in[7] + (size_t)l * D * DIN; K = D; N = DIN; WTb = W_WIN(w) + (size_t)l * DIN * D; }
    else if (mat == 1) { Wb = A.in[13] + (size_t)l * D * D; K = D; N = D; WTb = W_WOUT(w) + (size_t)l * D * D; }
    else if (mat == 2) { Wb = A.in[15] + (size_t)l * D * DFF; K = D; N = DFF; WTb = W_WUP(w) + (size_t)l * DFF * D; }
    else { Wb = A.in[16] + (size_t)l * DFF * D; K = DFF; N = D; WTb = W_WDN(w) + (size_t)l * D * DFF; }
    const int nblk = N / 32, kb = r / nblk, k0 = 64 * kb, n0 = 32 * (r - kb * nblk);
    d.W = Wb + (size_t)k0 * N + n0; d.N = N; d.K = K;
    d.WT = WTb + (size_t)(mat == 0 ? win_row(n0) : n0) * K + k0;
    d.goff = mat == 3 ? 3 * 2048 : mat * 2048 + k0;
}
__device__ __forceinline__ void conv_fill_gains(const Args& A, int stage, LAS float* gtab, int tid) {
    const int l = stage == 0 ? 0 : stage - 1, lin = stage == 0 ? 0 : (stage < DEPTH ? stage : DEPTH - 1);
    for (int e = tid; e < 4 * 2048; e += NWAVES * 64) { const int t = e >> 11, k = e & 2047;
        gtab[e] = t == 0 ? A.in[6][lin * D + k] : t == 1 ? (k < DA ? A.in[11][l * DA + k] : A.in[12][l * DC + k - DA]) : t == 2 ? A.in[14][l * D + k] : 1.f; }
}
__device__ __forceinline__ int conv_ticket(LAS unsigned* q, int lane);
template <int DP>
__device__ __forceinline__ void conv_ring(const Args& A, unsigned char* w, int stage, int vcu, int G, int lane, const LAS float* gtab, LAS unsigned* q, int gwave) {
    const int nk = conv_count(stage) / G;
    const int lq = lane & 7, lc = lane >> 3, bp = 4 * ((lane >> 3) + 8 * (lane & 7)), sinkoff = gwave * 2048;
    f32x4 v[DP][8]; int kt[DP];
#define CR_LOAD(s_) do { CDesc d_; cdesc(A, w, stage, kt[s_] < nk ? vcu * nk + kt[s_] : -1, sinkoff, d_); const float* wp_ = d_.W + (size_t)(8 * lc) * d_.N + 4 * lq; \
        _Pragma("unroll") for (int i = 0; i < 8; ++i) v[s_][i] = __builtin_nontemporal_load((const f32x4*)(wp_ + (size_t)i * d_.N)); } while (0)
#define CR_STORE(s_) do { CDesc d_; cdesc(A, w, stage, kt[s_] < nk ? vcu * nk + kt[s_] : -1, sinkoff, d_); \
        const LAS f32x4* gp_ = (const LAS f32x4*)(gtab + d_.goff + 8 * lc); const f32x4 g0_ = gp_[0], g1_ = gp_[1]; \
        bf16* op_ = d_.WT + (size_t)(4 * lc) * d_.K + 8 * lq;              \
        _Pragma("unroll") for (int e = 0; e < 4; ++e) { v4u o_; \
            o_.x = (unsigned)__builtin_amdgcn_ds_bpermute(bp, (int)cvt_pk_bf16(v[s_][0][e] * g0_[0], v[s_][1][e] * g0_[1])); \
            o_.y = (unsigned)__builtin_amdgcn_ds_bpermute(bp, (int)cvt_pk_bf16(v[s_][2][e] * g0_[2], v[s_][3][e] * g0_[3])); \
            o_.z = (unsigned)__builtin_amdgcn_ds_bpermute(bp, (int)cvt_pk_bf16(v[s_][4][e] * g1_[0], v[s_][5][e] * g1_[1])); \
            o_.w = (unsigned)__builtin_amdgcn_ds_bpermute(bp, (int)cvt_pk_bf16(v[s_][6][e] * g1_[2], v[s_][7][e] * g1_[3])); \
            *(GAS v4u*)(op_ + (size_t)e * d_.K) = o_; } } while (0)
#pragma unroll
    for (int s = 0; s < DP; ++s) {
        kt[s] = conv_ticket(q, lane);
        { bf16* sk = (bf16*)(w + WS_SINK) + sinkoff + (4 * lc) * 64 + 8 * lq;
#pragma unroll
          for (int e = 0; e < 4; ++e) *(GAS v4u*)(sk + e * 64) = (v4u){0u, 0u, 0u, 0u}; }
        CR_LOAD(s);
    }
    while (kt[0] < nk) {
#pragma unroll
        for (int s = 0; s < DP; ++s) { CR_STORE(s); kt[s] = conv_ticket(q, lane); CR_LOAD(s); }
    }
#undef CR_LOAD
#undef CR_STORE
}
__device__ __forceinline__ void p0_prologue(Frame& F, const Args& A) {
    unsigned char* w = F.ws;
    const int gw = F.vcu * NWAVES + F.wave, NGW = F.G * NWAVES;
#if CONV_RING
    { LAS float* gtab = (LAS float*)(F.lds + 1024); LAS unsigned* tq = (LAS unsigned*)F.lds;
      conv_fill_gains(A, 0, gtab, F.tid); if (F.tid == 0) tq[0] = 0u;
      WG_BAR();
      conv_ring<CONV_DP>(A, w, 0, F.vcu, F.G, F.lane, gtab, tq, gw); }
#else
    conv_run(A, w, 0, gw, NGW, F.lane, (LAS float*)(F.lds + F.wave * 8448));
#endif
    for (int m = gw; m < M; m += NGW) {
        const GAS f32x4* xr = (const GAS f32x4*)(A.in[0] + (size_t)m * D) + F.lane; GAS v2u* o8 = (GAS v2u*)(W_XB(w) + (size_t)m * D) + F.lane;
        float s = 0.f;
#pragma unroll
        for (int j = 0; j < 8; ++j) { const f32x4 v = xr[64 * j]; s += (v[0] * v[0] + v[1] * v[1]) + (v[2] * v[2] + v[3] * v[3]); v2u pw; pw.x = cvt_pk_bf16(v[0], v[1]); pw.y = cvt_pk_bf16(v[2], v[3]); o8[64 * j] = pw; }
        s = wave_sum(s);
        if (F.lane < 8) W_SSQA(w)[(size_t)m * 8 + F.lane] = F.lane == 0 ? s : 0.f;
    }
    const int gt = F.vcu * (NWAVES * 64) + F.tid, NGT = F.G * NWAVES * 64;
    for (int i = gt; i < SB * D; i += NGT) W_XS(w)[i] = A.in[1][i];
    for (int i = gt; i < DEPTH * 128; i += NGT) { const int l = i >> 7, r = i & 127; W_GN(w)[i] = r < 64 ? A.in[8][l * 64 + r] : A.in[9][l * 64 + r - 64]; }
    for (int i = gt; i < DEPTH * 3 * DC; i += NGT) W_CW(w)[i] = A.in[10][i];
    for (int i = gt; i < DEPTH * SB * 2 * DC; i += NGT) W_SC(w)[i] = A.in[4][i];
    for (int i = gt; i < 3 * 16 * 129; i += NGT) { const int c = i / (16 * 129), r = i - c * (16 * 129), h = r / 129, j = r - h * 129; W_BT(w)[i] = A.in[5][t5_bucket(j << (2 * c)) * 16 + h] * LOG2E; }
#if COPY_IN_P0
    { constexpr int ROWV = 1024 / 4, PER = (WBUF - 1) * ROWV, TOT = DEPTH * SB * PER;
      for (int i0 = gt; i0 < 2 * TOT; i0 += 8 * NGT) { f32x4 v[8];
#pragma unroll
          for (int u = 0; u < 8; ++u) { const int i = i0 + u * NGT; if (i < 2 * TOT) { const int kv = i >= TOT, r = i - kv * TOT, lb = r / PER, e = r - lb * PER;
              v[u] = __builtin_nontemporal_load((const f32x4*)(kv ? A.in[3] : A.in[2]) + (size_t)lb * (WBUF * ROWV) + ROWV + e); } }
#pragma unroll
          for (int u = 0; u < 8; ++u) { const int i = i0 + u * NGT; if (i < 2 * TOT) { const int kv = i >= TOT, r = i - kv * TOT, lb = r / PER, e = r - lb * PER;
              __builtin_nontemporal_store(v[u], (f32x4*)(F.out + (kv ? O_VS : O_KS)) + (size_t)lb * (WBUF * ROWV) + e); } } } }
#endif
}

template <int MODE, int K, int N>
__device__ __forceinline__ void sgemv(Frame& F, const float* A, const bf16* Wt, float* out, float* yout) {
    constexpr int NPW = N / 256, NG = (NPW + 15) / 16, KW = K / 8, STEPS = KW / 32;
    LAS float* red = (LAS float*)F.lds;
    LAS float* sq = (LAS float*)(F.lds + 8 * NG * 1024);
    const int lane = F.lane, wv = F.wave, fr = lane & 15, fq = lane >> 4;
    const int n0 = (F.vcu & 255) * NPW;
    {
        f32x4 acc[NG];
#pragma unroll
        for (int g = 0; g < NG; ++g) acc[g] = (f32x4){0.f, 0.f, 0.f, 0.f};
        float ssq = 0.f;
        const float* ap = A + (size_t)(fr & 7) * K + wv * KW + fq * 8;
        const bf16* wp[NG];
#pragma unroll
        for (int g = 0; g < NG; ++g) { const int nl = 16 * g + fr; wp[g] = Wt + (size_t)(n0 + (nl < NPW ? nl : NPW - 1)) * K + wv * KW + fq * 8; }
#pragma unroll 16
        for (int s = 0; s < STEPS; ++s) {
            v4u yw = {0u, 0u, 0u, 0u};
            if (fr < 8) { const f32x4 a0 = *(const f32x4*)(ap + 32 * s), a1 = *(const f32x4*)(ap + 32 * s + 4); yw = pack8(a0, a1);
                ssq += ((a0[0] * a0[0] + a0[1] * a0[1]) + (a0[2] * a0[2] + a0[3] * a0[3])) + ((a1[0] * a1[0] + a1[1] * a1[1]) + (a1[2] * a1[2] + a1[3] * a1[3])); }
#pragma unroll
            for (int g = 0; g < NG; ++g) { const bf16x8 X = *(const bf16x8*)(wp[g] + 32 * s); acc[g] = __builtin_amdgcn_mfma_f32_16x16x32_bf16(X, __builtin_bit_cast(bf16x8, yw), acc[g], 0, 0, 0); }
        }
#pragma unroll
        for (int g = 0; g < NG; ++g) *(LAS f32x4*)(red + (wv * NG + g) * 256 + lane * 4) = acc[g];
        if (MODE == 0 || MODE == 2) { ssq += __shfl_xor(ssq, 16); ssq += __shfl_xor(ssq, 32); if (lane < 8) sq[wv * 8 + lane] = ssq; }
    }
    float prev = 0.f;
    if ((MODE == 1 || MODE == 3) && F.tid < 8 * NPW) prev = out[(size_t)(F.tid & 7) * N + n0 + (F.tid >> 3)];
    WG_BAR();
    if (F.tid < 8 * NPW) {
        const int nl = F.tid >> 3, tok = F.tid & 7, g = nl >> 4, lp = ((nl & 15) >> 2) * 16 + tok, i = nl & 3;
        float v = 0.f;
#pragma unroll
        for (int ww = 0; ww < 8; ++ww) v += red[(ww * NG + g) * 256 + lp * 4 + i];
        float rs = 1.f;
        if (MODE == 0 || MODE == 2) { float q = 0.f;
#pragma unroll
            for (int ww = 0; ww < 8; ++ww) q += sq[ww * 8 + tok];
            rs = __builtin_amdgcn_rsqf(q * (1.0f / (float)K) + EPS); }
        float* op = out + (size_t)tok * N + n0 + nl;
        if (MODE == 0) *op = v * rs;
        else if (MODE == 2) { const float z = fmaxf(v * rs, 0.f); *op = z * z; }
        else { const float z = prev + v; *op = z; if (yout) yout[(size_t)tok * N + n0 + nl] = z; }
    }
}

constexpr int ATT_BT_BYTES = 48 * 192 * 4, ATT_V_BYTES = 32 * 192;
constexpr int NCP = 32;
__device__ __forceinline__ void attn_phase_prompt(Frame& F, unsigned char* w, float* out, int l, int mode = 3) {
    const int lane = F.lane, r = lane & 31, hh = lane >> 5;
    LAS float* btall = (LAS float*)F.lds;
    for (int e = F.tid; e < 48 * 192; e += NWAVES * 64) { const int t = e / 192, j = 160 - (e - t * 192); btall[e] = (j >= 0 && j <= 128) ? W_BT(w)[t * 129 + (j < 0 ? 0 : (j > 128 ? 128 : j))] : -1.0e30f; }
    WG_BAR();
    LAS unsigned char* vl = F.lds + ATT_BT_BYTES + F.wave * ATT_V_BYTES;
    const int trq = (lane & 15) >> 2, trp = lane & 3, g16 = (lane >> 4) & 1;
    LAS unsigned char* vtr0 = vl + (4 * hh + trq) * 192 + g16 * 32 + trp * 8;
    constexpr int NMOVE = ATT_NMOVE, NWORK = NWAVES - NMOVE;
    if (NMOVE > 0 && F.wave >= NWORK) {
        if (!(mode & 2)) return;
        const int mv = F.wave - NWORK;
        constexpr int CP_PER = (WBUF - 1) * 256, CP_HALF = SB * CP_PER, CP_TOT = 2 * CP_HALF, CP_ROWS = (CP_TOT + 63) / 64;
        for (int k0 = mv * NCP; k0 * F.G < CP_ROWS; k0 += (NMOVE > 0 ? NMOVE : 1) * NCP) {
            f32x4 cpv[NCP];
#pragma unroll
            for (int u = 0; u < NCP; ++u) { int ci = ((k0 + u) * F.G + F.vcu) * 64 + lane; ci = ci < CP_TOT ? ci : CP_TOT - 1;
                const int kv = ci >= CP_HALF, rr = ci - kv * CP_HALF, bb = rr / CP_PER, ee = rr - bb * CP_PER;
                cpv[u] = __builtin_nontemporal_load((const f32x4*)(kv ? F.state_v : F.state_k) + ((size_t)(l * SB + bb) * WBUF + 1) * 256 + ee); }
#pragma unroll
            for (int u = 0; u < NCP; ++u) { const int ci = ((k0 + u) * F.G + F.vcu) * 64 + lane;
                if (ci < CP_TOT) { const int kv = ci >= CP_HALF, rr = ci - kv * CP_HALF, bb = rr / CP_PER, ee = rr - bb * CP_PER;
                    __builtin_nontemporal_store(cpv[u], (f32x4*)(out + (kv ? O_VS : O_KS)) + ((size_t)(l * SB + bb) * WBUF) * 256 + ee); } }
        }
        return;
    }
    if (!(mode & 1)) return;
    const int ntile = (3 * (NB * H * 8) / F.G * 8 - F.wave + NWORK - 1) / NWORK;
#define TILE_SETUP(j_, C_, DSH_, RHO_, I0_, KB0_, HB_, BH_) do { const int t_ = F.wave + NWORK * (j_), i_ = t_ >> 3, c_ = i_ % 3, idx_ = (i_ / 3) * F.G + F.vcu; C_ = c_; DSH_ = 2 * c_; BH_ = idx_ >> 3; \
        const int f0_ = 256 * (idx_ & 7) + 32 * (t_ & 7); RHO_ = f0_ >> (11 - DSH_); I0_ = f0_ & ((2048 >> DSH_) - 1); KB0_ = I0_ >= 128 ? 0 : ((128 - I0_) >> 5); HB_ = (size_t)BH_ * 2048 * 64; } while (0)
#define LOAD_Q(QF, HB_, DSH_, RHO_, I0_) do { const char* qt_ = (const char*)(W_Q(w) + HB_ + (RHO_) * 64) + ((size_t)((I0_) << (DSH_))) * 128; const unsigned ql_ = ((unsigned)(r << (DSH_))) * 128u + 64u * hh; \
        _Pragma("unroll") for (int s = 0; s < 4; ++s) QF[s] = *(const bf16x8*)(qt_ + ql_ + 16 * s); } while (0)
#define LOAD_KV(KF, VV, kb_, HB_, DSH_, RHO_, I0_, KB0_) do { const int kbe_ = (kb_) < (KB0_) ? (KB0_) : (kb_); const size_t bo_ = ((size_t)(((I0_) - 128 + 32 * kbe_) << (DSH_))) * 128; \
        const char* kt_ = (const char*)(W_K(w) + HB_ + (RHO_) * 64) + bo_; const char* vt_ = (const char*)(W_V(w) + HB_ + (RHO_) * 64) + bo_; \
        const unsigned kl_ = ((unsigned)(r << (DSH_))) * 128u + 64u * hh, vl_ = ((unsigned)((lane >> 3) << (DSH_))) * 128u + 16u * (lane & 7), vs_ = (8u << (DSH_)) * 128u; \
        _Pragma("unroll") for (int s = 0; s < 4; ++s) KF[s] = *(const bf16x8*)(kt_ + kl_ + 16 * s); \
        _Pragma("unroll") for (int c4 = 0; c4 < 4; ++c4) VV[c4] = *(const v4u*)(vt_ + vl_ + c4 * vs_); } while (0)
#define VTR(p) __builtin_bit_cast(s16x4, __builtin_amdgcn_ds_read_tr16_b64_v4i16((LAS s16x4*)(p)))
#define VFRAG(db, s) ({ const s16x4 lo_ = VTR(vtr0 + (16 * (s)) * 192 + (db) * 64), hi_ = VTR(vtr0 + (16 * (s) + 8) * 192 + (db) * 64); (bf16x8){lo_[0], lo_[1], lo_[2], lo_[3], hi_[0], hi_[1], hi_[2], hi_[3]}; })
#define ATT_COMPUTE(KF, VV, kb_) do { \
        _Pragma("unroll") for (int c4 = 0; c4 < 4; ++c4) *(LAS v4u*)(vl + ((lane >> 3) + 8 * c4) * 192 + (lane & 7) * 16) = VV[c4]; \
        const int bidx = 32 - r + 4 * hh + 32 * (kb_);            \
        f32x16 sT; _Pragma("unroll") for (int k = 0; k < 16; ++k) sT[k] = bt[bidx + (k & 3) + 8 * (k >> 2)];        \
        _Pragma("unroll") for (int s = 0; s < 4; ++s) sT = __builtin_amdgcn_mfma_f32_32x32x16_bf16(KF[s], qf[s], sT, 0, 0, 0); \
        asm volatile("s_nop 15\n\ts_nop 7" : "+v"(sT));            \
        float mx = max3f(max3f(sT[0], sT[1], sT[2]), max3f(sT[3], sT[4], sT[5]), max3f(sT[6], sT[7], sT[8])); \
        mx = max3f(mx, max3f(sT[9], sT[10], sT[11]), max3f(sT[12], sT[13], max3f(sT[14], sT[15], sT[15]))); \
        mx = max3f(mx, __shfl_xor(mx, 32), mx); \
        if (__any(mx > m_run + 8.0f)) {                            \
            const float m_new = max3f(m_run, mx, mx), alpha = __builtin_amdgcn_exp2f(m_run - m_new); m_run = m_new; l_run *= alpha; \
            _Pragma("unroll") for (int k = 0; k < 16; ++k) { o0[k] *= alpha; o1[k] *= alpha; } } \
        _Pragma("unroll") for (int k = 0; k < 16; ++k) sT[k] = __builtin_amdgcn_exp2f(sT[k] - m_run); \
        l_run += (((sT[0] + sT[1]) + (sT[2] + sT[3])) + ((sT[4] + sT[5]) + (sT[6] + sT[7]))) + (((sT[8] + sT[9]) + (sT[10] + sT[11])) + ((sT[12] + sT[13]) + (sT[14] + sT[15]))); \
        v4u pw0, pw1; \
        pw0.x = cvt_pk_bf16(sT[0], sT[1]); pw0.y = cvt_pk_bf16(sT[2], sT[3]); pw0.z = cvt_pk_bf16(sT[4], sT[5]); pw0.w = cvt_pk_bf16(sT[6], sT[7]); \
        pw1.x = cvt_pk_bf16(sT[8], sT[9]); pw1.y = cvt_pk_bf16(sT[10], sT[11]); pw1.z = cvt_pk_bf16(sT[12], sT[13]); pw1.w = cvt_pk_bf16(sT[14], sT[15]); \
        const bf16x8 pk0 = __builtin_bit_cast(bf16x8, pw0), pk1 = __builtin_bit_cast(bf16x8, pw1); \
        const bf16x8 v00 = VFRAG(0, 0), v01 = VFRAG(0, 1), v10 = VFRAG(1, 0), v11 = VFRAG(1, 1); \
        o0 = __builtin_amdgcn_mfma_f32_32x32x16_bf16(v00, pk0, o0, 0, 0, 0); o0 = __builtin_amdgcn_mfma_f32_32x32x16_bf16(v01, pk1, o0, 0, 0, 0); \
        o1 = __builtin_amdgcn_mfma_f32_32x32x16_bf16(v10, pk0, o1, 0, 0, 0); o1 = __builtin_amdgcn_mfma_f32_32x32x16_bf16(v11, pk1, o1, 0, 0, 0); } while (0)
    int c, dsh, rho, i0, kb0, bh; size_t hb;
    TILE_SETUP(0, c, dsh, rho, i0, kb0, hb, bh);
    bf16x8 qf[4], kA[4], kB[4]; v4u vA[4];
    LOAD_Q(qf, hb, dsh, rho, i0);
    { v4u vdummy[4]; LOAD_KV(kA, vA, 0, hb, dsh, rho, i0, kb0); LOAD_KV(kB, vdummy, 1, hb, dsh, rho, i0, kb0); (void)vdummy; }
    for (int i = 0; i < ntile; ++i) {
        int c2 = 0, dsh2 = 0, rho2 = 0, i02 = 0, kb02 = 0, bh2 = 0; size_t hb2 = 0; const bool has_next = i + 1 < ntile;
        if (has_next) TILE_SETUP(i + 1, c2, dsh2, rho2, i02, kb02, hb2, bh2);
        const LAS float* bt = btall + (c * 16 + (bh & 15)) * 192;
        float m_run = -1.0e30f, l_run = 0.f;
        f32x16 o0, o1;
#pragma unroll
        for (int k = 0; k < 16; ++k) { o0[k] = 0.f; o1[k] = 0.f; }
        bf16x8 kC[4], kD[4], kE[4]; v4u vB[4], vC[4], vD[4], vE[4];
#define SB0() __builtin_amdgcn_sched_barrier(0)
#define LOAD_K(KF, kb_, HB_, DSH_, RHO_, I0_, KB0_) do { const int kbe_ = (kb_) < (KB0_) ? (KB0_) : (kb_); const char* kt_ = (const char*)(W_K(w) + HB_ + (RHO_) * 64) + ((size_t)(((I0_) - 128 + 32 * kbe_) << (DSH_))) * 128; \
        const unsigned kl_ = ((unsigned)(r << (DSH_))) * 128u + 64u * hh; if (!(mode & 8)) { _Pragma("unroll") for (int s = 0; s < 4; ++s) KF[s] = *(const bf16x8*)(kt_ + kl_ + 16 * s); } } while (0)
#define LOAD_V(VV, kb_, HB_, DSH_, RHO_, I0_, KB0_) do { const int kbe_ = (kb_) < (KB0_) ? (KB0_) : (kb_); const char* vt_ = (const char*)(W_V(w) + HB_ + (RHO_) * 64) + ((size_t)(((I0_) - 128 + 32 * kbe_) << (DSH_))) * 128; \
        const unsigned vl_ = ((unsigned)((lane >> 3) << (DSH_))) * 128u + 16u * (lane & 7), vs_ = (8u << (DSH_)) * 128u; if (!(mode & 8)) { _Pragma("unroll") for (int c4 = 0; c4 < 4; ++c4) VV[c4] = *(const v4u*)(vt_ + vl_ + c4 * vs_); } } while (0)
        SB0(); LOAD_K(kC, 2, hb, dsh, rho, i0, kb0); LOAD_V(vB, 1, hb, dsh, rho, i0, kb0); SB0();
        if (kb0 <= 0) ATT_COMPUTE(kA, vA, 0);
        SB0(); LOAD_K(kD, 3, hb, dsh, rho, i0, kb0); LOAD_V(vC, 2, hb, dsh, rho, i0, kb0); SB0();
        if (kb0 <= 1) ATT_COMPUTE(kB, vB, 1);
        SB0(); LOAD_K(kE, 4, hb, dsh, rho, i0, kb0); LOAD_V(vD, 3, hb, dsh, rho, i0, kb0); SB0();
        if (kb0 <= 2) ATT_COMPUTE(kC, vC, 2);
        SB0(); if (has_next) LOAD_K(kA, 0, hb2, dsh2, rho2, i02, kb02); LOAD_V(vE, 4, hb, dsh, rho, i0, kb0); SB0();
        if (kb0 <= 3) ATT_COMPUTE(kD, vD, 3);
        SB0(); if (has_next) { LOAD_K(kB, 1, hb2, dsh2, rho2, i02, kb02); LOAD_V(vA, 0, hb2, dsh2, rho2, i02, kb02); } SB0();
        ATT_COMPUTE(kE, vE, 4);
        SB0(); if (has_next) LOAD_Q(qf, hb2, dsh2, rho2, i02); SB0();
#undef SB0
#undef LOAD_K
#undef LOAD_V
        const float l_tot = l_run + __shfl_xor(l_run, 32);
        const int grow = (bh >> 4) * 2048 + (((i0 + r) << dsh) + rho);
#pragma unroll
        for (int g4 = 0; g4 < 4; ++g4) {
            v2u a, b2; a.x = cvt_pk_bf16(o0[4 * g4], o0[4 * g4 + 1]); a.y = cvt_pk_bf16(o0[4 * g4 + 2], o0[4 * g4 + 3]); b2.x = cvt_pk_bf16(o1[4 * g4], o1[4 * g4 + 1]); b2.y = cvt_pk_bf16(o1[4 * g4 + 2], o1[4 * g4 + 3]);
            *(LAS v2u*)(vl + r * 144 + (8 * g4 + 4 * hh) * 2) = a; *(LAS v2u*)(vl + r * 144 + (32 + 8 * g4 + 4 * hh) * 2) = b2;
        }
#pragma unroll
        for (int q4 = 0; q4 < 4; ++q4) { const int rq = q4 * 8 + (lane >> 3), ch = lane & 7;
            const v4u v = *(const LAS v4u*)(vl + rq * 144 + ch * 16);
            const int grow_q = (bh >> 4) * 2048 + (((i0 + rq) << dsh) + rho);
            if (!(mode & 16)) *(v4u*)(W_OPB(w) + ((size_t)c * M + grow_q) * 1024 + (bh & 15) * 64 + ch * 8) = v; }
        if (hh == 0 && !(mode & 16)) *(f32x2*)(W_ML(w) + (((size_t)c * M + grow) * 16 + (bh & 15)) * 2) = (f32x2){m_run, l_tot};
        c = c2; dsh = dsh2; rho = rho2; i0 = i02; kb0 = kb02; hb = hb2; bh = bh2;
    }
#undef ATT_COMPUTE
#undef VFRAG
#undef VTR
#undef TILE_SETUP
#undef LOAD_Q
#undef LOAD_KV
}

__device__ __forceinline__ int conv_ticket(LAS unsigned* q, int lane) {
    unsigned v = 0u;
    if (lane == 0) v = __hip_atomic_fetch_add(q, 1u, __ATOMIC_RELAXED, __HIP_MEMORY_SCOPE_WORKGROUP);
    return (int)__builtin_amdgcn_readfirstlane(v);
}
__device__ __forceinline__ void conv_run_dyn(const Args& A, unsigned char* w, int stage, int vcu, int G, int lane, LAS float* scr, LAS unsigned* q) {
    const int nk0 = conv_count(stage) / G, hasS = (2 * SB * H == G) ? (vcu < SB * H) : -1;
    const int nk = hasS < 0 ? nk0 : (hasS ? nk0 - CONV_SKEW : nk0 + CONV_SKEW), base = hasS < 0 ? vcu * nk0 : (hasS ? vcu * (nk0 - CONV_SKEW) : SB * H * (nk0 - CONV_SKEW) + (vcu - SB * H) * (nk0 + CONV_SKEW));
    P0Item dc, dn; f32x4 vc[8], vn[8]; float gc = 1.f, gn = 1.f;
    int k = conv_ticket(q, lane);
    if (k < nk) { p0_item_desc(A, w, stage, base + k, dc); p0_item_load(dc, lane, vc, gc); }
    while (k < nk) {
        const int k2 = conv_ticket(q, lane);
        if (k2 < nk) { p0_item_desc(A, w, stage, base + k2, dn); p0_item_load(dn, lane, vn, gn); }
        p0_item_store(dc, lane, vc, gc, scr);
        if (k2 < nk) { dc = dn; gc = gn;
#pragma unroll
            for (int i = 0; i < 8; ++i) vc[i] = vn[i]; }
        k = k2;
    }
}

__device__ __forceinline__ void att4_wait(volatile LAS unsigned* p, unsigned target);
__device__ __forceinline__ void team_bar(LAS unsigned* cnt, unsigned& epoch, int lane) {
    asm volatile("s_waitcnt vmcnt(0) lgkmcnt(0)" ::: "memory");
    if (lane == 0) (void)__hip_atomic_fetch_add(cnt, 1u, __ATOMIC_RELAXED, __HIP_MEMORY_SCOPE_WORKGROUP);
    ++epoch;
    att4_wait((volatile LAS unsigned*)cnt, 4u * epoch);
}
__device__ __forceinline__ void attn_sample_team(Frame& F, unsigned char* w, float* out, int l, int b, int h, int wv, LAS unsigned* tcnt) {
    LAS float* sm = (LAS float*)F.lds;
    const int lane = F.lane, t = wv * 64 + lane;
    unsigned epoch = 0u;
    const float* ps = W_PS(w) + (size_t)b * DIN;
    const size_t sbase = ((size_t)(l * SB + b) * WBUF) * 1024 + h * 64;
    const int e0 = t, c0 = e0 / 129, j0 = e0 - c0 * 129;
    f32x4 kreg[16];
    { const f32x4* kr = (const f32x4*)(F.state_k + sbase + (size_t)(j0 == 0 ? WBUF - 1 : WBUF - (j0 << (2 * c0))) * 1024);
#pragma unroll
      for (int d4 = 0; d4 < 16; ++d4) kreg[d4] = kr[d4]; }
    if (wv == 0) {
        const float qr = ps[h * 64 + lane], kr = ps[1024 + h * 64 + lane], vr = ps[2048 + h * 64 + lane];
        const float sq = wave_sum(qr * qr), sk = wave_sum(kr * kr);
        const float* gn = W_GN(w) + l * 128;
        const float qn = qr * __builtin_amdgcn_rsqf(sq * (1.0f / 64.0f) + EPS) * gn[lane] * QSCALE;
        const float kn = kr * __builtin_amdgcn_rsqf(sk * (1.0f / 64.0f) + EPS) * gn[64 + lane];
        sm[lane] = qn; sm[64 + lane] = kn; sm[128 + lane] = vr;
        out[O_KS + sbase + (size_t)(WBUF - 1) * 1024 + lane] = kn;
        out[O_VS + sbase + (size_t)(WBUF - 1) * 1024 + lane] = vr;
    }
    team_bar(tcnt, epoch, lane);
    {   float a = 0.f;
#pragma unroll
        for (int d4 = 0; d4 < 16; ++d4) { const f32x4 q4 = *(const LAS f32x4*)(sm + 4 * d4); f32x4 kv = kreg[d4]; if (j0 == 0) kv = *(const LAS f32x4*)(sm + 64 + 4 * d4);
            a += (kv[0] * q4[0] + kv[1] * q4[1]) + (kv[2] * q4[2] + kv[3] * q4[3]); }
        sm[192 + e0] = a + W_BT(w)[(c0 * 16 + h) * 129 + j0];
    }
    if (t + 256 < 387) {
        const int e1 = t + 256, c1 = e1 / 129, j1 = e1 - c1 * 129;
        const f32x4* kr = (const f32x4*)(F.state_k + sbase + (size_t)(j1 == 0 ? WBUF - 1 : WBUF - (j1 << (2 * c1))) * 1024);
        float a = 0.f;
#pragma unroll
        for (int d4 = 0; d4 < 16; ++d4) { const f32x4 q4 = *(const LAS f32x4*)(sm + 4 * d4); f32x4 kv = kr[d4]; if (j1 == 0) kv = *(const LAS f32x4*)(sm + 64 + 4 * d4);
            a += (kv[0] * q4[0] + kv[1] * q4[1]) + (kv[2] * q4[2] + kv[3] * q4[3]); }
        sm[192 + e1] = a + W_BT(w)[(c1 * 16 + h) * 129 + j1];
    }
    const int kg = t >> 4, dq = t & 15;
    f32x4 vreg[13];
#pragma unroll
    for (int i = 0; i < 13; ++i) { int ee = kg + 16 * i; const int cc = ee / 129, jj = ee - cc * 129;
        vreg[i] = *(const f32x4*)(F.state_v + sbase + (size_t)(jj == 0 ? WBUF - 1 : WBUF - (jj << (2 * cc))) * 1024 + dq * 4); }
    team_bar(tcnt, epoch, lane);
    float mx = -1.0e30f;
    for (int x = lane; x < 387; x += 64) mx = fmaxf(mx, sm[192 + x]);
    mx = wave_max(mx);
    float sum = 0.f;
    for (int x = lane; x < 387; x += 64) sum += __builtin_amdgcn_exp2f(sm[192 + x] - mx);
    sum = wave_sum(sum);
    f32x4 o = {0.f, 0.f, 0.f, 0.f};
#pragma unroll
    for (int i = 0; i < 13; ++i) { const int ee = kg + 16 * i;
        const float p = __builtin_amdgcn_exp2f(sm[192 + ee] - mx); f32x4 vv = vreg[i]; if (ee == 0 || ee == 129 || ee == 258) vv = *(const LAS f32x4*)(sm + 128 + dq * 4); o += vv * p; }
#pragma unroll
    for (int i = 13; i < 25; ++i) { int ee = kg + 16 * i; if (ee < 387) { const int cc = ee / 129, jj = ee - cc * 129;
        f32x4 vv = *(const f32x4*)(F.state_v + sbase + (size_t)(jj == 0 ? WBUF - 1 : WBUF - (jj << (2 * cc))) * 1024 + dq * 4);
        if (jj == 0) vv = *(const LAS f32x4*)(sm + 128 + dq * 4);
        o += vv * __builtin_amdgcn_exp2f(sm[192 + ee] - mx); } }
    *(LAS f32x4*)(sm + 1024 + kg * 64 + dq * 4) = o;
    team_bar(tcnt, epoch, lane);
    if (t < 64) {
        float tt = 0.f;
#pragma unroll
        for (int g = 0; g < 16; ++g) tt += sm[1024 + g * 64 + t];
        W_OS(w)[(size_t)b * 1024 + h * 64 + t] = tt / sum;
    }
}

constexpr int ATT4_BT = 6 * 192 * 4, ATT4_IMG = ATT4_BT, ATT4_STG = ATT4_IMG + 8 * 8192, ATT4_SYNC = ATT4_STG + 4 * 4608, ATT4_CONV = ATT4_SYNC + 256;
static_assert(ATT4_CONV + 4 * 8448 <= LDSCTL_OFF, "LDS map (attention v4)");
__device__ __forceinline__ void att4_wait(volatile LAS unsigned* p, unsigned target) {
    for (unsigned sp = 0; *p < target && sp < (1u << 22); ++sp) __builtin_amdgcn_s_sleep(1);
    asm volatile("" ::: "memory");
}
__device__ __forceinline__ void att4_signal(LAS unsigned* p, int lane) {
    asm volatile("s_waitcnt lgkmcnt(0)" ::: "memory");
    if (lane == 0) (void)__hip_atomic_fetch_add(p, 1u, __ATOMIC_RELAXED, __HIP_MEMORY_SCOPE_WORKGROUP);
    asm volatile("" ::: "memory");
}
__device__ __forceinline__ void attn_phase_prompt4(Frame& F, const Args& A, unsigned char* w, float* out, int l) {
    const int lane = F.lane, r = lane & 31, hh = lane >> 5;
    LAS float* btall = (LAS float*)F.lds;
    for (int e = F.tid; e < 6 * 192; e += NWAVES * 64) { const int t = e / 192, j = 160 - (e - t * 192), hh_ = ((((t / 3) * F.G + F.vcu) >> 3) & 15);
        btall[e] = (j >= 0 && j <= 128) ? W_BT(w)[((t % 3) * 16 + hh_) * 129 + (j < 0 ? 0 : (j > 128 ? 128 : j))] : -1.0e30f; }
    LAS unsigned* sync = (LAS unsigned*)(F.lds + ATT4_SYNC);
    if (F.tid == 0) { sync[0] = 0u; sync[16] = 0u; sync[32] = 0u; sync[48] = 0u; }
#if CONV_RING
    conv_fill_gains(A, 1 + l, (LAS float*)(F.lds + ATT4_CONV), F.tid);
#endif
    WG_BAR();
    constexpr int NWORK = 4, NMOVE = ATT4_MOVERS;
    if (F.wave >= NWORK) {
        const int mv = F.wave - NWORK;
        constexpr int CP_PER = (WBUF - 1) * 256, CP_HALF = SB * CP_PER, CP_TOT = 2 * CP_HALF, CP_ROWS = (CP_TOT + 63) / 64;
        for (int bt_ = F.vcu * NMOVE + mv; (!COPY_IN_G4 || COPY_BOTH) && bt_ * NCP < CP_ROWS; bt_ += F.G * NMOVE) {
            const int k0 = bt_ * NCP;
            f32x4 cpv[NCP];
#pragma unroll
            for (int u = 0; u < NCP; ++u) { int ci = (k0 + u) * 64 + lane; ci = ci < CP_TOT ? ci : CP_TOT - 1;
                const int kv = ci >= CP_HALF, rr = ci - kv * CP_HALF, bb = rr / CP_PER, ee = rr - bb * CP_PER;
                cpv[u] = __builtin_nontemporal_load((const f32x4*)(kv ? F.state_v : F.state_k) + ((size_t)(l * SB + bb) * WBUF + 1) * 256 + ee); }
#pragma unroll
            for (int u = 0; u < NCP; ++u) { const int ci = (k0 + u) * 64 + lane;
                if (ci < CP_TOT) { const int kv = ci >= CP_HALF, rr = ci - kv * CP_HALF, bb = rr / CP_PER, ee = rr - bb * CP_PER;
                    __builtin_nontemporal_store(cpv[u], (f32x4*)(out + (kv ? O_VS : O_KS)) + ((size_t)(l * SB + bb) * WBUF) * 256 + ee); } }
        }
#if CONV_RING
        conv_ring<CONV_DP>(A, w, 1 + l, F.vcu, F.G, lane, (const LAS float*)(F.lds + ATT4_CONV), sync + 48, F.vcu * NWAVES + F.wave);
#else
        conv_run_dyn(A, w, 1 + l, F.vcu, F.G, lane, (LAS float*)(F.lds + ATT4_CONV + mv * 8448), sync + 48);
#endif
        return;
    }
    const int wv = F.wave;
    LAS unsigned char* img = F.lds + ATT4_IMG;
    LAS unsigned char* stg = F.lds + ATT4_STG + wv * 4608;
    const int trq = (lane & 15) >> 2, trp = lane & 3, g16 = (lane >> 4) & 1, rsw = 4 * hh + trq;
    const int vt0 = rsw * 128 + (((2 * g16 + (trp >> 1)) ^ rsw) * 16) + 8 * (trp & 1), vt1 = rsw * 128 + (((4 + 2 * g16 + (trp >> 1)) ^ rsw) * 16) + 8 * (trp & 1);
    int koff[4];
#pragma unroll
    for (int s = 0; s < 4; ++s) koff[s] = r * 128 + (((4 * hh + s) ^ (r & 7)) * 16);
    const int rib = 8 * wv + (lane >> 3), woff = rib * 128 + (((lane & 7) ^ (rib & 7)) * 16);
#define UNIT_SETUP(mu_, C_, DSH_, RHO_, RB_, JV_, HB_, BH_, PAIR_) do { const int u_ = (mu_) < 5 ? (mu_) : (mu_) + 1; PAIR_ = ((mu_) == 4 || (mu_) == 9); \
        const int i_ = u_ >> 1, c_ = i_ % 3, idx_ = (i_ / 3) * F.G + F.vcu; C_ = c_; DSH_ = 2 * c_; BH_ = idx_ >> 3; \
        const int f0_ = 256 * (idx_ & 7) + 128 * (u_ & 1); RHO_ = f0_ >> (11 - DSH_); RB_ = f0_ & ((2048 >> DSH_) - 1); JV_ = RB_ == 0 ? 4 : 0; HB_ = (size_t)BH_ * 2048 * 64; } while (0)
#define UNIT_LOAD(KP, VP, QF, QFB, DSH_, RHO_, RB_, JV_, HB_, PAIR_) do { \
        _Pragma("unroll") for (int n = 0; n < 8; ++n) { \
            if (n >= (JV_)) { const size_t eo_ = HB_ + (size_t)((((RB_) - 128 + 32 * n + rib) << (DSH_)) + (RHO_)) * 64 + (lane & 7) * 8; KP[n] = *(const v4u*)(W_K(w) + eo_); VP[n] = *(const v4u*)(W_V(w) + eo_); } \
            else if (PAIR_) { const size_t eo_ = HB_ + (size_t)(((32 * n + rib) << (DSH_)) + (RHO_) + 1) * 64 + (lane & 7) * 8; KP[n] = *(const v4u*)(W_K(w) + eo_); VP[n] = *(const v4u*)(W_V(w) + eo_); } } \
        { const bf16* qp_ = W_Q(w) + HB_ + (size_t)((((RB_) + 32 * wv + r) << (DSH_)) + (RHO_)) * 64 + 32 * hh; _Pragma("unroll") for (int s = 0; s < 4; ++s) QF[s] = *(const bf16x8*)(qp_ + 8 * s); } \
        if (PAIR_) { const bf16* qp_ = W_Q(w) + HB_ + (size_t)(((32 * (3 - wv) + r) << (DSH_)) + (RHO_) + 1) * 64 + 32 * hh; _Pragma("unroll") for (int s = 0; s < 4; ++s) QFB[s] = *(const bf16x8*)(qp_ + 8 * s); } } while (0)
    int c, dsh, rho, rb, jv, bh, pair; size_t hb;
    UNIT_SETUP(0, c, dsh, rho, rb, jv, hb, bh, pair);
    int lo = jv, so = 0;
    v4u kp[8], vp[8]; bf16x8 qf[4], qfb[4];
#pragma unroll
    for (int n = 0; n < 8; ++n) { kp[n] = (v4u){0u, 0u, 0u, 0u}; vp[n] = (v4u){0u, 0u, 0u, 0u}; }
#pragma unroll
    for (int s = 0; s < 4; ++s) qfb[s] = (bf16x8){0, 0, 0, 0, 0, 0, 0, 0};
    UNIT_LOAD(kp, vp, qf, qfb, dsh, rho, rb, lo, hb, pair);
    constexpr unsigned NUNIT = 10;
    int pc = 0, pdsh = 0, prho = 0, pbh = 0, pi0 = 0; float pm = 0.f, pl = 0.f;
#define UNIT_FLUSH() do { \
        _Pragma("unroll") for (int q4 = 0; q4 < 4; ++q4) { const int rq = q4 * 8 + (lane >> 3), ch = lane & 7; \
            const v4u v = *(const LAS v4u*)(stg + rq * 144 + ch * 16); \
            const int grow_q = (pbh >> 4) * 2048 + (((pi0 + rq) << pdsh) + prho); \
            *(v4u*)(W_OPB(w) + ((size_t)pc * M + grow_q) * 1024 + (pbh & 15) * 64 + ch * 8) = v; } \
        if (hh == 0) *(f32x2*)(W_ML(w) + (((size_t)pc * M + (pbh >> 4) * 2048 + (((pi0 + r) << pdsh) + prho)) * 16 + (pbh & 15)) * 2) = (f32x2){pm, pl}; } while (0)
#define VTR(p) __builtin_bit_cast(s16x4, __builtin_amdgcn_ds_read_tr16_b64_v4i16((LAS s16x4*)(p)))
#define VFRAG4(VT_, s) ({ const s16x4 lo_ = VTR(vb_ + (16 * (s)) * 128 + (VT_)), hi_ = VTR(vb_ + (16 * (s) + 8) * 128 + (VT_)); (bf16x8){lo_[0], lo_[1], lo_[2], lo_[3], hi_[0], hi_[1], hi_[2], hi_[3]}; })
#define TILE_RUN(WQ_, SOFF_, JVV_, QC_, RHO_T_) do { \
        float m_run = -1.0e30f, l_run = 0.f; \
        f32x16 o0, o1; \
        _Pragma("unroll") for (int k = 0; k < 16; ++k) { o0[k] = 0.f; o1[k] = 0.f; } \
        _Pragma("unroll") for (int jj = 0; jj < 5; ++jj) { \
            const int j = (WQ_) + jj; \
            if (j >= (JVV_)) { \
                const LAS unsigned char* kb_ = img + ((j + (SOFF_) + so) & 7) * 8192; const LAS unsigned char* vb_ = kb_ + 4096; \
                bf16x8 kf[4]; \
                _Pragma("unroll") for (int s = 0; s < 4; ++s) kf[s] = *(const LAS bf16x8*)(kb_ + koff[s]); \
                const int bidx = 32 - r + 4 * hh + 32 * jj; \
                f32x16 sT; \
                _Pragma("unroll") for (int k = 0; k < 16; ++k) sT[k] = bt[bidx + (k & 3) + 8 * (k >> 2)]; \
                _Pragma("unroll") for (int s = 0; s < 4; ++s) sT = __builtin_amdgcn_mfma_f32_32x32x16_bf16(kf[s], QC_[s], sT, 0, 0, 0); \
                asm volatile("s_nop 15\n\ts_nop 7" : "+v"(sT)); \
                float mx = max3f(max3f(sT[0], sT[1], sT[2]), max3f(sT[3], sT[4], sT[5]), max3f(sT[6], sT[7], sT[8])); \
                mx = max3f(mx, max3f(sT[9], sT[10], sT[11]), max3f(sT[12], sT[13], max3f(sT[14], sT[15], sT[15]))); \
                asm volatile("s_nop 1" : "+v"(mx));        \
                { const unsigned mb_ = __builtin_bit_cast(unsigned, mx); const auto sw_ = __builtin_amdgcn_permlane32_swap(mb_, mb_, false, false);        \
                  const unsigned s0_ = sw_[0], s1_ = sw_[1];        \
                  mx = max3f(__builtin_bit_cast(float, s0_), __builtin_bit_cast(float, s1_), __builtin_bit_cast(float, s1_)); } \
                if (__any(mx > m_run + 8.0f)) { \
                    const float m_new = max3f(m_run, mx, mx), alpha = __builtin_amdgcn_exp2f(m_run - m_new); m_run = m_new; l_run *= alpha; \
                    _Pragma("unroll") for (int k = 0; k < 16; ++k) { o0[k] *= alpha; o1[k] *= alpha; } } \
                _Pragma("unroll") for (int k = 0; k < 16; ++k) sT[k] = __builtin_amdgcn_exp2f(sT[k] - m_run); \
                l_run += (((sT[0] + sT[1]) + (sT[2] + sT[3])) + ((sT[4] + sT[5]) + (sT[6] + sT[7]))) + (((sT[8] + sT[9]) + (sT[10] + sT[11])) + ((sT[12] + sT[13]) + (sT[14] + sT[15]))); \
                v4u pw0, pw1; \
                pw0.x = cvt_pk_bf16(sT[0], sT[1]); pw0.y = cvt_pk_bf16(sT[2], sT[3]); pw0.z = cvt_pk_bf16(sT[4], sT[5]); pw0.w = cvt_pk_bf16(sT[6], sT[7]); \
                pw1.x = cvt_pk_bf16(sT[8], sT[9]); pw1.y = cvt_pk_bf16(sT[10], sT[11]); pw1.z = cvt_pk_bf16(sT[12], sT[13]); pw1.w = cvt_pk_bf16(sT[14], sT[15]); \
                const bf16x8 pk0 = __builtin_bit_cast(bf16x8, pw0), pk1 = __builtin_bit_cast(bf16x8, pw1); \
                  \
                const bf16x8 v00 = VFRAG4(vt0, 0), v01 = VFRAG4(vt0, 1), v10 = VFRAG4(vt1, 0), v11 = VFRAG4(vt1, 1); \
                o0 = __builtin_amdgcn_mfma_f32_32x32x16_bf16(v00, pk0, o0, 0, 0, 0); o0 = __builtin_amdgcn_mfma_f32_32x32x16_bf16(v01, pk1, o0, 0, 0, 0); \
                o1 = __builtin_amdgcn_mfma_f32_32x32x16_bf16(v10, pk0, o1, 0, 0, 0); o1 = __builtin_amdgcn_mfma_f32_32x32x16_bf16(v11, pk1, o1, 0, 0, 0); \
            } \
        } \
          \
        _Pragma("unroll") for (int g4 = 0; g4 < 4; ++g4) { \
            v2u a, b2; a.x = cvt_pk_bf16(o0[4 * g4], o0[4 * g4 + 1]); a.y = cvt_pk_bf16(o0[4 * g4 + 2], o0[4 * g4 + 3]); b2.x = cvt_pk_bf16(o1[4 * g4], o1[4 * g4 + 1]); b2.y = cvt_pk_bf16(o1[4 * g4 + 2], o1[4 * g4 + 3]); \
            *(LAS v2u*)(stg + r * 144 + (8 * g4 + 4 * hh) * 2) = a; *(LAS v2u*)(stg + r * 144 + (32 + 8 * g4 + 4 * hh) * 2) = b2; } \
        pc = c; pdsh = dsh; prho = (RHO_T_); pbh = bh; pi0 = rb + 32 * (WQ_); pm = m_run; \
        { const unsigned lb_ = __builtin_bit_cast(unsigned, l_run); const auto sw_ = __builtin_amdgcn_permlane32_swap(lb_, lb_, false, false); const unsigned s0_ = sw_[0], s1_ = sw_[1]; \
          pl = __builtin_bit_cast(float, s0_) + __builtin_bit_cast(float, s1_); } } while (0)
    for (int u = 0; u < (int)NUNIT; ++u) {
        att4_wait((volatile LAS unsigned*)(sync + 16), 4u * (unsigned)u);
#pragma unroll
        for (int n = 0; n < 8; ++n) if (n >= lo || pair) { LAS unsigned char* sl_ = img + ((n + so) & 7) * 8192 + woff; *(LAS v4u*)sl_ = kp[n]; *(LAS v4u*)(sl_ + 4096) = vp[n]; }
        bf16x8 qc[4];
#pragma unroll
        for (int s = 0; s < 4; ++s) qc[s] = qf[s];
        att4_signal(sync, lane);
        if (u > 0) UNIT_FLUSH();
        att4_wait((volatile LAS unsigned*)sync, 4u * (unsigned)(u + 1));
        int c2 = 0, dsh2 = 0, rho2 = 0, rb2 = 0, jv2 = 0, bh2 = 0, pair2 = 0, lo2 = 0, so2 = 0; size_t hb2 = 0;
        if (u + 1 < (int)NUNIT) { UNIT_SETUP(u + 1, c2, dsh2, rho2, rb2, jv2, hb2, bh2, pair2);
            const int reuse2 = (u + 1 == 1 || u + 1 == 3 || u + 1 == 6 || u + 1 == 8); lo2 = reuse2 ? 4 : jv2; so2 = reuse2 ? 4 : 0;
            UNIT_LOAD(kp, vp, qf, qfb, dsh2, rho2, rb2, lo2, hb2, pair2); }
        const LAS float* bt = btall + ((u < 5 ? u : u + 1) >> 1) * 192;
        TILE_RUN(wv, 0, jv, qc, rho);
        if (pair) { UNIT_FLUSH(); TILE_RUN(3 - wv, -4, 4, qfb, rho + 1); }
        att4_signal(sync + 16, lane);
        c = c2; dsh = dsh2; rho = rho2; rb = rb2; jv = jv2; hb = hb2; bh = bh2; pair = pair2; lo = lo2; so = so2;
    }
#undef TILE_RUN
#undef VFRAG4
#undef VTR
#undef UNIT_SETUP
#undef UNIT_LOAD
    UNIT_FLUSH();
#undef UNIT_FLUSH
    att4_wait((volatile LAS unsigned*)(sync + 16), 4u * NUNIT);
    if (F.vcu < SB * H) attn_sample_team(F, w, out, l, F.vcu >> 4, F.vcu & 15, wv, sync + 32);
#if CONV_RING
    conv_ring<CONV_DP>(A, w, 1 + l, F.vcu, F.G, lane, (const LAS float*)(F.lds + ATT4_CONV), sync + 48, F.vcu * NWAVES + F.wave);
#else
    conv_run_dyn(A, w, 1 + l, F.vcu, F.G, lane, (LAS float*)(img + 16384 + wv * 8448), sync + 48);
#endif
}

__device__ __forceinline__ void attn_sample_unit(Frame& F, unsigned char* w, float* out, int l, int b, int h) {
    LAS float* sm = (LAS float*)F.lds;
    const int lane = F.lane, wave = F.wave, tid = F.tid;
    const float* ps = W_PS(w) + (size_t)b * DIN;
    const size_t sbase = ((size_t)(l * SB + b) * WBUF) * 1024 + h * 64;
    const int e = tid < 387 ? tid : 386, ec = e / 129, ej = e - ec * 129;
    f32x4 kreg[16];
    { const f32x4* kr = (const f32x4*)(F.state_k + sbase + (size_t)(ej == 0 ? WBUF - 1 : WBUF - (ej << (2 * ec))) * 1024);
#pragma unroll
      for (int d4 = 0; d4 < 16; ++d4) kreg[d4] = kr[d4]; }
    const int kg = tid >> 4, dq = tid & 15;
    f32x4 vreg[13];
#pragma unroll
    for (int i = 0; i < 13; ++i) { int ee = kg + 32 * i; ee = ee < 387 ? ee : 386; const int cc = ee / 129, jj = ee - cc * 129;
        vreg[i] = *(const f32x4*)(F.state_v + sbase + (size_t)(jj == 0 ? WBUF - 1 : WBUF - (jj << (2 * cc))) * 1024 + dq * 4); }
    if (wave == 0) {
        const float qr = ps[h * 64 + lane], kr = ps[1024 + h * 64 + lane], vr = ps[2048 + h * 64 + lane];
        const float sq = wave_sum(qr * qr), sk = wave_sum(kr * kr);
        const float* gn = W_GN(w) + l * 128;
        const float qn = qr * __builtin_amdgcn_rsqf(sq * (1.0f / 64.0f) + EPS) * gn[lane] * QSCALE;
        const float kn = kr * __builtin_amdgcn_rsqf(sk * (1.0f / 64.0f) + EPS) * gn[64 + lane];
        sm[lane] = qn; sm[64 + lane] = kn; sm[128 + lane] = vr;
        out[O_KS + sbase + (size_t)(WBUF - 1) * 1024 + lane] = kn;
        out[O_VS + sbase + (size_t)(WBUF - 1) * 1024 + lane] = vr;
    }
    WG_BAR();
    if (tid < 387) {
        float a = 0.f;
#pragma unroll
        for (int d4 = 0; d4 < 16; ++d4) { const f32x4 q4 = *(const LAS f32x4*)(sm + 4 * d4); f32x4 kv = kreg[d4]; if (ej == 0) kv = *(const LAS f32x4*)(sm + 64 + 4 * d4);
            a += (kv[0] * q4[0] + kv[1] * q4[1]) + (kv[2] * q4[2] + kv[3] * q4[3]); }
        sm[192 + tid] = a + W_BT(w)[(ec * 16 + h) * 129 + ej];
    }
    WG_BAR();
    float mx = -1.0e30f;
    for (int t = lane; t < 387; t += 64) mx = fmaxf(mx, sm[192 + t]);
    mx = wave_max(mx);
    float sum = 0.f;
    for (int t = lane; t < 387; t += 64) sum += __builtin_amdgcn_exp2f(sm[192 + t] - mx);
    sum = wave_sum(sum);
    f32x4 o = {0.f, 0.f, 0.f, 0.f};
#pragma unroll
    for (int i = 0; i < 13; ++i) { const int ee = kg + 32 * i;
        if (ee < 387) { const float p = __builtin_amdgcn_exp2f(sm[192 + ee] - mx); f32x4 vv = vreg[i]; if (ee == 0 || ee == 129 || ee == 258) vv = *(const LAS f32x4*)(sm + 128 + dq * 4); o += vv * p; } }
    *(LAS f32x4*)(sm + 1024 + kg * 64 + dq * 4) = o;
    WG_BAR();
    if (tid < 64) {
        float t = 0.f;
#pragma unroll
        for (int g = 0; g < 32; ++g) t += sm[1024 + g * 64 + tid];
        W_OS(w)[(size_t)b * 1024 + h * 64 + tid] = t / sum;
    }
    WG_BAR();
}

__device__ __forceinline__ void mix_row_prompt(unsigned char* w, float* out, int lane, int l, int row) {
    const int b = row >> 11, t = row & 2047;
    { const int head = lane >> 2, dq = (lane & 3) * 16;
      float mm[3], ll[3];
#pragma unroll
      for (int c = 0; c < 3; ++c) { const f32x2 v = *(const f32x2*)(W_ML(w) + (((size_t)c * M + row) * 16 + head) * 2); mm[c] = v[0]; ll[c] = v[1]; }
      const float mx = fmaxf(fmaxf(mm[0], mm[1]), mm[2]);
      float wgt[3], den = 0.f;
#pragma unroll
      for (int c = 0; c < 3; ++c) { wgt[c] = __builtin_amdgcn_exp2f(mm[c] - mx); den += wgt[c] * ll[c]; }
      const float inv = 1.0f / den;
      f32x4 o[4];
#pragma unroll
      for (int k = 0; k < 4; ++k) o[k] = (f32x4){0.f, 0.f, 0.f, 0.f};
#pragma unroll
      for (int c = 0; c < 3; ++c) { const v4u* p = (const v4u*)(W_OPB(w) + ((size_t)c * M + row) * 1024 + head * 64 + dq); const float wc_ = wgt[c] * inv; const v4u p0 = p[0], p1 = p[1];
#pragma unroll
          for (int e = 0; e < 4; ++e) { const int k = e >> 1, x = (e & 1) * 2;
              o[k][x] += __uint_as_float(p0[e] << 16) * wc_; o[k][x + 1] += __uint_as_float(p0[e] & 0xffff0000u) * wc_;
              o[2 + k][x] += __uint_as_float(p1[e] << 16) * wc_; o[2 + k][x + 1] += __uint_as_float(p1[e] & 0xffff0000u) * wc_; } }
      float q = 0.f;
#pragma unroll
      for (int k = 0; k < 4; ++k) q += (o[k][0] * o[k][0] + o[k][1] * o[k][1]) + (o[k][2] * o[k][2] + o[k][3] * o[k][3]);
      q = wave_sum(q);
      const float rs = __builtin_amdgcn_rsqf(q * (1.0f / 1024.0f) + EPS);
      bf16* dst = W_MIX(w) + (size_t)row * 2048 + head * 64 + dq;
      *(v4u*)dst = pack8(o[0] * rs, o[1] * rs); *(v4u*)(dst + 8) = pack8(o[2] * rs, o[3] * rs); }
    { const int c0 = lane * 16;
      float u[3][16];
#pragma unroll
      for (int k = 0; k < 3; ++k) { const int tt = t - 2 + k;
          if (tt >= 0) { const bf16* pr = W_PC(w) + (size_t)(row - 2 + k) * 2048;
              const v4u a0 = *(const v4u*)(pr + c0), a1 = *(const v4u*)(pr + c0 + 8);
#pragma unroll
              for (int e = 0; e < 4; ++e) { const unsigned va = a0[e], vb = a1[e];
                  u[k][2 * e] = __uint_as_float(va << 16); u[k][2 * e + 1] = __uint_as_float(va & 0xffff0000u);
                  u[k][8 + 2 * e] = __uint_as_float(vb << 16); u[k][8 + 2 * e + 1] = __uint_as_float(vb & 0xffff0000u); }
          } else {
#pragma unroll
              for (int e = 0; e < 16; ++e) u[k][e] = 0.f; } }
      const bf16* pr = W_PC(w) + (size_t)row * 2048 + 1024 + c0;
      const v4u b0 = *(const v4u*)pr, b1 = *(const v4u*)(pr + 8);
      float gb[16];
#pragma unroll
      for (int e = 0; e < 4; ++e) { gb[2 * e] = __uint_as_float(b0[e] << 16); gb[2 * e + 1] = __uint_as_float(b0[e] & 0xffff0000u); gb[8 + 2 * e] = __uint_as_float(b1[e] << 16); gb[8 + 2 * e + 1] = __uint_as_float(b1[e] & 0xffff0000u); }
      const float* cw = W_CW(w) + (size_t)l * 3 * DC + c0;
      float z[16]; float q = 0.f;
#pragma unroll
      for (int e4 = 0; e4 < 4; ++e4) { const f32x4 w0 = *(const f32x4*)(cw + 4 * e4), w1 = *(const f32x4*)(cw + DC + 4 * e4), w2 = *(const f32x4*)(cw + 2 * DC + 4 * e4);
#pragma unroll
          for (int e = 0; e < 4; ++e) { const int i = 4 * e4 + e; const float y = w0[e] * u[0][i] + w1[e] * u[1][i] + w2[e] * u[2][i]; z[i] = gb[i] * y; q += z[i] * z[i]; } }
      q = wave_sum(q);
      const float rs = __builtin_amdgcn_rsqf(q * (1.0f / 1024.0f) + EPS);
      bf16* dst = W_MIX(w) + (size_t)row * 2048 + 1024 + c0;
      v4u w0, w1;
#pragma unroll
      for (int e = 0; e < 4; ++e) { w0[e] = cvt_pk_bf16(z[2 * e] * rs, z[2 * e + 1] * rs); w1[e] = cvt_pk_bf16(z[8 + 2 * e] * rs, z[8 + 2 * e + 1] * rs); }
      *(v4u*)dst = w0; *(v4u*)(dst + 8) = w1;
      if (t >= S - 2) { float* cp = out + O_CP + ((size_t)(l * NB + b) * 2 + (t - (S - 2))) * DC + c0;
#pragma unroll
          for (int e4 = 0; e4 < 4; ++e4) *(f32x4*)(cp + 4 * e4) = (f32x4){u[2][4 * e4], u[2][4 * e4 + 1], u[2][4 * e4 + 2], u[2][4 * e4 + 3]}; } }
}
__device__ __forceinline__ void mix_row_sample(unsigned char* w, float* out, int lane, int l, int b) {
    { const f32x4* p = (const f32x4*)(W_OS(w) + (size_t)b * 1024 + lane * 16); f32x4 o[4]; float q = 0.f;
#pragma unroll
      for (int k = 0; k < 4; ++k) { o[k] = p[k]; q += (o[k][0] * o[k][0] + o[k][1] * o[k][1]) + (o[k][2] * o[k][2] + o[k][3] * o[k][3]); }
      q = wave_sum(q); const float rs = __builtin_amdgcn_rsqf(q * (1.0f / 1024.0f) + EPS);
      f32x4* dst = (f32x4*)(W_MIXS(w) + (size_t)b * 2048 + lane * 16);
#pragma unroll
      for (int k = 0; k < 4; ++k) dst[k] = o[k] * rs; }
    { const int c0 = lane * 16; const float* ps = W_PS(w) + (size_t)b * DIN;
      const float* st = W_SC(w) + (size_t)(l * SB + b) * 2 * DC; const float* cw = W_CW(w) + (size_t)l * 3 * DC;
      float* co = out + O_CS + (size_t)(l * SB + b) * 2 * DC;
      f32x4 z[4]; float q = 0.f;
#pragma unroll
      for (int k = 0; k < 4; ++k) { const int c = c0 + 4 * k;
          const int cv = 3072 + 256 * (c >> 7) + 64 * ((c >> 5) & 3) + (c & 31);
          const f32x4 vc = *(const f32x4*)(ps + cv), gb = *(const f32x4*)(ps + 5120 + c), gc = *(const f32x4*)(ps + cv + 32);
          const f32x4 s0 = *(const f32x4*)(st + c), s1 = *(const f32x4*)(st + DC + c);
          const f32x4 w0 = *(const f32x4*)(cw + c), w1 = *(const f32x4*)(cw + DC + c), w2 = *(const f32x4*)(cw + 2 * DC + c);
          const f32x4 un = gc * vc; const f32x4 y = w0 * s0 + w1 * s1 + w2 * un; z[k] = gb * y;
          q += (z[k][0] * z[k][0] + z[k][1] * z[k][1]) + (z[k][2] * z[k][2] + z[k][3] * z[k][3]);
          *(f32x4*)(co + c) = s1; *(f32x4*)(co + DC + c) = un; }
      q = wave_sum(q); const float rs = __builtin_amdgcn_rsqf(q * (1.0f / 1024.0f) + EPS);
      f32x4* dst = (f32x4*)(W_MIXS(w) + (size_t)b * 2048 + 1024 + c0);
#pragma unroll
      for (int k = 0; k < 4; ++k) dst[k] = z[k] * rs; }
}

#ifndef PHASE_MASK
#define PHASE_MASK 127
#endif
struct SideKV {
    static constexpr bool ON = true;
    const bf16* kb; const bf16* vb; float* ko; float* vo; int gw, ngw, lane;
    LAS unsigned char* slot; f32x2 d; f32x2* dst;
    __device__ __forceinline__ void issue(int j) {
        int o = j * ngw + gw; o = o < 131072 ? o : 131071;
        const int kv = o >> 16, rem = o & 65535, row = rem >> 3, part = rem & 7, head = 2 * part + (lane >> 5), dd = 2 * (lane & 31);
        const bf16* src = (kv ? vb : kb) + ((size_t)((row >> 11) * 16 + head) * 2048 + (row & 2047)) * 64 + dd;
        __builtin_amdgcn_global_load_lds((const unsigned*)src, (LAS unsigned*)slot, 4, 0, 0);
        dst = (f32x2*)((kv ? vo : ko) + (size_t)row * 1024 + part * 128 + 2 * lane);
    }
    __device__ __forceinline__ void prime() { issue(0); }
    __device__ __forceinline__ void fetch() { const unsigned x = *(const LAS unsigned*)(slot + lane * 4); d[0] = __uint_as_float(x << 16); d[1] = __uint_as_float(x & 0xffff0000u); }
    __device__ __forceinline__ void step(int j) { __builtin_nontemporal_store(d, dst); issue(j + 1); }
};
struct SideCopy {
    static constexpr bool ON = true;
    const float* sk; const float* sv; float* ok; float* ov; int gw, ngw, lane;
    LAS unsigned char* slot;
    f32x4 d; f32x4* dst;
    __device__ __forceinline__ void issue(int j) {
        constexpr int CP_PER = (WBUF - 1) * 256, CP_HALF = SB * CP_PER, CP_TOT = 2 * CP_HALF;
        int ci = (j * ngw + gw) * 64 + lane; ci = ci < CP_TOT ? ci : CP_TOT - 1;
        const int kv = ci >= CP_HALF, rr = ci - kv * CP_HALF, bb = rr / CP_PER, ee = rr - bb * CP_PER;
        __builtin_amdgcn_global_load_lds((const unsigned*)((const f32x4*)(kv ? sv : sk) + ((size_t)bb * WBUF + 1) * 256 + ee), (LAS unsigned*)slot, 16, 0, 0);
        dst = (f32x4*)(kv ? ov : ok) + (size_t)bb * WBUF * 256 + ee;
    }
    __device__ __forceinline__ void prime() { issue(0); }
    __device__ __forceinline__ void fetch() { d = *(const LAS f32x4*)(slot + lane * 16); }
    __device__ __forceinline__ void step(int j) { __builtin_nontemporal_store(d, dst); issue(j + 1); }
};
#define PH_ON(k) ((PHASE_MASK >> (k)) & 1)
#ifndef REPEAT_MASK
#define REPEAT_MASK 0
#endif
#define NREP(k) (((REPEAT_MASK >> (k)) & 1) ? 2 : 1)
__global__ void __launch_bounds__(NWAVES * 64, 2) mk_fwd(Args args) {
    extern __shared__ __attribute__((aligned(16))) unsigned char lds[];
    Frame F;
    F.lds = (LAS unsigned char*)lds;
    F.tid = threadIdx.x; F.lane = F.tid & 63; F.wave = __builtin_amdgcn_readfirstlane(F.tid >> 6);
    F.G = gridDim.x; { const int bx = blockIdx.x; F.vcu = (F.G % 8 == 0) ? (bx % 8) * (F.G / 8) + bx / 8 : bx; }
    F.ws = args.ws; F.out = args.out; F.x_prompt = args.in[0]; F.state_k = args.in[2]; F.state_v = args.in[3];
    for (int u = F.tid; u < (LDS_BYTES - LDSCTL_OFF) / 4; u += NWAVES * 64) ((LAS unsigned*)(F.lds + LDSCTL_OFF))[u] = 0u;
    __syncthreads();
    XcdBarrier bar; bar.wave = F.wave; bar.bar = (unsigned*)(F.ws + WS_CTL) + CW_BAR; bar.x = 0; bar.st = nullptr;
    if (MK_ONE_LAUNCH) bar = xcd_barrier_post((unsigned*)(F.ws + WS_CTL) + CW_BAR, (volatile LAS unsigned*)(F.lds + MISC_OFF) + 8, F.wave);
    const int lo = args.ph_lo, hi = args.ph_hi;
#define IN(k) (lo <= (k) && (k) < hi)
#define SEAM(k) do { if (IN(k) && IN((k) + 1)) xcd_barrier(bar); } while (0)

    if (PH_ON(0) && IN(0)) { for (int rep = 0; rep < NREP(0); ++rep) p0_prologue(F, args); SEAM(0); }

    for (int l = 0; l < DEPTH; ++l) {
        const int p0 = 1 + 6 * l;
        if (PH_ON(1) && IN(p0)) {
            unsigned char* w = opq(F.ws); float* out = opq(F.out); Frame P = F; P.tid = fresh_tid(F.wave); P.lane = P.tid & 63;
            const bool sfirst = STAGGER && (F.vcu & 1);
            if (sfirst) { sgemv<0, D, DIN>(P, W_XS(w), W_WIN(w) + (size_t)l * DIN * D, W_PS(w), nullptr); WG_BAR(); }
            for (int rep = 0; rep < NREP(1); ++rep) { pg8::Gemm g{W_XB(w), W_WIN(w) + (size_t)l * DIN * D, M, DIN, D, F.wave}; pg8::MixedOrderG1 So; So.init(M, DIN, F.G, (int)blockIdx.x);
              pg8::fill_rstd_table((LAS float*)(F.lds + RS_TAB_OFF), So, W_SSQA(w), EPS, P.tid);
              pg8::EpiG1 E{(const LAS float*)(F.lds + RS_TAB_OFF), W_GN(w) + l * 128, 64, W_Q(w), (size_t)(WS_K - WS_Q) / 2, W_PC(w), out + O_KP + (size_t)l * M * 1024, (size_t)(O_VP - O_KP), QSCALE, EPS};
              pg8::gemm_phase<pg8::EpiG1, pg8::MixedOrderG1, GEMM_ALIGN, GEMM_SP2>(F.lds, g, So, E); }
            if (!sfirst && F.wave == 0) EARLY_WB(); if (!sfirst) sgemv<0, D, DIN>(P, W_XS(w), W_WIN(w) + (size_t)l * DIN * D, W_PS(w), nullptr);
            SEAM(p0);
        }
        if (PH_ON(2) && IN(p0 + 1)) {
            unsigned char* w = opq(F.ws); float* out = opq(F.out); Frame P = F; P.tid = fresh_tid(F.wave); P.lane = P.tid & 63;
#ifdef ATT_PROBE_MODE
            attn_phase_prompt(P, w, out, l, ATT_PROBE_MODE); WG_BAR();
#endif
#if ATT_V4
            attn_phase_prompt4(P, args, w, out, l);
#else
            for (int rep = 0; rep < NREP(2); ++rep) attn_phase_prompt(P, w, out, l);
#endif
            WG_BAR();
#if !ATT_V4
            for (int rep = 0; rep < NREP(7); ++rep) if (F.vcu < SB * H) attn_sample_unit(P, w, out, l, F.vcu >> 4, F.vcu & 15);
#endif
            SEAM(p0 + 1);
        }
        if (PH_ON(3) && IN(p0 + 2)) {
            unsigned char* w = opq(F.ws); float* out = opq(F.out); Frame P = F; P.tid = fresh_tid(F.wave); P.lane = P.tid & 63;
            const int gw = F.vcu * NWAVES + F.wave, NGW = F.G * NWAVES;
            for (int rep = 0; rep < NREP(3); ++rep) for (int row = gw; row < M; row += NGW) mix_row_prompt(w, out, P.lane, l, row);
            if (F.vcu == F.G - 1) mix_row_sample(w, out, P.lane, l, P.wave);
            SEAM(p0 + 2);
        }
        if (PH_ON(4) && IN(p0 + 3)) {
            unsigned char* w = opq(F.ws); float* out = opq(F.out); Frame P = F; P.tid = fresh_tid(F.wave); P.lane = P.tid & 63;
            const bool sfirst = STAGGER && (F.vcu & 1);
            if (sfirst) { sgemv<1, D, D>(P, W_MIXS(w), W_WOUT(w) + (size_t)l * D * D, W_XS(w), nullptr); WG_BAR(); }
            if (NREP(4) > 1) { pg8::Gemm g{W_MIX(w), W_WOUT(w) + (size_t)l * D * D, M, D, D, F.wave}; pg8::StaticOrder So; So.init(M, D, F.G, (int)blockIdx.x); pg8::EpiNull E{}; pg8::gemm_phase<pg8::EpiNull, pg8::StaticOrder, false, true>(F.lds, g, So, E); }
            { pg8::Gemm g{W_MIX(w), W_WOUT(w) + (size_t)l * D * D, M, D, D, F.wave}; pg8::StaticOrder So; So.init(M, D, F.G, (int)blockIdx.x);
              pg8::EpiRes E{W_XB(w), W_SSQB(w), nullptr};
              pg8::gemm_phase<pg8::EpiRes, pg8::StaticOrder, false, GEMM_SP2>(F.lds, g, So, E); }
            if (!sfirst && F.wave == 0) EARLY_WB(); if (!sfirst) sgemv<1, D, D>(P, W_MIXS(w), W_WOUT(w) + (size_t)l * D * D, W_XS(w), nullptr);
            SEAM(p0 + 3);
        }
        if (PH_ON(5) && IN(p0 + 4)) {
            unsigned char* w = opq(F.ws); Frame P = F; P.tid = fresh_tid(F.wave); P.lane = P.tid & 63;
            const bool sfirst = STAGGER && (F.vcu & 1);
            if (sfirst) { sgemv<2, D, DFF>(P, W_XS(w), W_WUP(w) + (size_t)l * DFF * D, W_AS(w), nullptr); WG_BAR(); }
            for (int rep = 0; rep < NREP(5); ++rep) { pg8::Gemm g{W_XB(w), W_WUP(w) + (size_t)l * DFF * D, M, DFF, D, F.wave}; pg8::StaticOrder So; So.init(M, DFF, F.G, (int)blockIdx.x);
              pg8::fill_rstd_table((LAS float*)(F.lds + RS_TAB_OFF), So, W_SSQB(w), EPS, P.tid);
              pg8::EpiG3 E{(const LAS float*)(F.lds + RS_TAB_OFF), W_HB(w), DFF};
              pg8::gemm_phase<pg8::EpiG3, pg8::StaticOrder, GEMM_ALIGN, GEMM_SP2>(F.lds, g, So, E); }
            if (!sfirst && F.wave == 0) EARLY_WB(); if (!sfirst) sgemv<2, D, DFF>(P, W_XS(w), W_WUP(w) + (size_t)l * DFF * D, W_AS(w), nullptr);
            SEAM(p0 + 4);
        }
        if (PH_ON(6) && IN(p0 + 5)) {
            unsigned char* w = opq(F.ws); float* out = opq(F.out); Frame P = F; P.tid = fresh_tid(F.wave); P.lane = P.tid & 63;
            const bool sfirst = STAGGER && (F.vcu & 1);
            if (sfirst) { sgemv<3, DFF, D>(P, W_AS(w), W_WDN(w) + (size_t)l * D * DFF, W_XS(w), l == DEPTH - 1 ? out + O_YS : nullptr); WG_BAR(); }
            if (NREP(6) > 1) { pg8::Gemm g{W_HB(w), W_WDN(w) + (size_t)l * D * DFF, M, D, DFF, F.wave}; pg8::StaticOrder So; So.init(M, D, F.G, (int)blockIdx.x); pg8::EpiNull E{}; pg8::gemm_phase<pg8::EpiNull, pg8::StaticOrder, false, true>(F.lds, g, So, E); }
            { pg8::Gemm g{W_HB(w), W_WDN(w) + (size_t)l * D * DFF, M, D, DFF, F.wave}; pg8::StaticOrder So; So.init(M, D, F.G, (int)blockIdx.x);
              pg8::EpiRes E{W_XB(w), W_SSQA(w), l == DEPTH - 1 ? out + O_Y : nullptr};
#if KV_SIDE
              SideKV sc{W_K(w), W_V(w), out + O_KP + (size_t)l * M * 1024, out + O_VP + (size_t)l * M * 1024, F.vcu * NWAVES + F.wave, F.G * NWAVES, P.lane, F.lds + RS_TAB_OFF + F.wave * 1024, (f32x2){0.f, 0.f}, nullptr};
              pg8::gemm_phase<pg8::EpiRes, pg8::StaticOrder, false, true, SideKV>(F.lds, g, So, E, sc); }
#elif COPY_IN_G4
              const size_t lo_ = (size_t)l * SB * WBUF * 1024;
              SideCopy sc{F.state_k + lo_, F.state_v + lo_, out + O_KS + lo_, out + O_VS + lo_, F.vcu * NWAVES + F.wave, F.G * NWAVES, P.lane, F.lds + RS_TAB_OFF + F.wave * 1024, (f32x4){0.f, 0.f, 0.f, 0.f}, nullptr};
              pg8::gemm_phase<pg8::EpiRes, pg8::StaticOrder, false, true, SideCopy>(F.lds, g, So, E, sc); }
#else
              pg8::gemm_phase<pg8::EpiRes, pg8::StaticOrder, false, GEMM_SP2>(F.lds, g, So, E); }
#endif
            if (!sfirst && F.wave == 0) EARLY_WB(); if (!sfirst) sgemv<3, DFF, D>(P, W_AS(w), W_WDN(w) + (size_t)l * D * DFF, W_XS(w), l == DEPTH - 1 ? out + O_YS : nullptr);
            SEAM(p0 + 5);
        }
    }
#undef IN
#undef SEAM
}

extern "C" void kernel_launch(void* const* d_in, const int* in_sizes, int n_in, void* d_out, int out_size, void* d_ws, size_t ws_size, hipStream_t stream) {
    static int grid = 0;
    if (grid == 0) {
        if (n_in != 17 || (size_t)out_size != O_END || ws_size < WS_END) { fprintf(stderr, "kernel_launch: unexpected sizes (n_in %d out %d ws %zu)\n", n_in, out_size, ws_size); grid = -1; return; }
        int dev = 0, cus = 0, per_cu = 0;
        if (hipGetDevice(&dev) != hipSuccess || hipDeviceGetAttribute(&cus, hipDeviceAttributeMultiprocessorCount, dev) != hipSuccess) { grid = -1; return; }
        if (hipFuncSetAttribute((const void*)mk_fwd, hipFuncAttributeMaxDynamicSharedMemorySize, LDS_BYTES) != hipSuccess) { fprintf(stderr, "kernel_launch: hipFuncSetAttribute failed\n"); grid = -1; return; }
        if (hipOccupancyMaxActiveBlocksPerMultiprocessor(&per_cu, (const void*)mk_fwd, NWAVES * 64, LDS_BYTES) != hipSuccess || per_cu < 1) { fprintf(stderr, "kernel_launch: occupancy query says %d\n", per_cu); (void)hipGetLastError(); per_cu = 1; }
        grid = cus;
        if (grid != 256) fprintf(stderr, "kernel_launch: %d CUs (built for 256)\n", grid);
    }
    if (grid < 0) return;
    if (hipMemsetAsync((char*)d_ws + WS_CTL, 0, CTL_ZERO_BYTES, stream) != hipSuccess) return;
    Args a{};
    for (int i = 0; i < 17; ++i) a.in[i] = (const float*)d_in[i];
    a.out = (float*)d_out; a.ws = (unsigned char*)d_ws;
#if MK_ONE_LAUNCH
    a.ph_lo = 0; a.ph_hi = NPH;
    hipLaunchKernelGGL(mk_fwd, dim3(grid), dim3(NWAVES * 64), LDS_BYTES, stream, a);
#else
    for (int p = 0; p < NPH; ++p) { a.ph_lo = p; a.ph_hi = p + 1; hipLaunchKernelGGL(mk_fwd, dim3(grid), dim3(NWAVES * 64), LDS_BYTES, stream, a); }
#endif
}
```

```cpp
#include <hip/hip_runtime.h>
#include <cstdio>
#include <cstdint>
#ifndef KV_SIDE
#define KV_SIDE 1
#endif
namespace pg8 {
#define PG8_LAS __attribute__((address_space(3)))
typedef unsigned short bf16_t;
typedef short bf16x8 __attribute__((ext_vector_type(8)));
typedef float f32x4 __attribute__((ext_vector_type(4)));
typedef unsigned u32x4 __attribute__((ext_vector_type(4)));
constexpr int BM = 256, BK = 64, HALF = 128, HTB = HALF * BK * 2  , STAGE_BYTES = 8 * HTB, NXCD = 8, WGM = 4;

__host__ __device__ __forceinline__ int lds_byte(int r, int c) { const int st = (r >> 4) * 2 + (c >> 5), rr = r & 15, cc = c & 31, ob = rr * 64 + cc * 2; return st * 1024 + (ob ^ (((ob >> 9) & 1) << 5)); }
__host__ __device__ __forceinline__ void stage_rc(int b, int& R, int& C) { const int st = b / 1024, sb = b % 1024, swz = sb ^ (((sb >> 9) & 1) << 5); R = (st >> 1) * 16 + swz / 64; C = (st & 1) * 32 + (swz % 64) / 2; }
__host__ __device__ __forceinline__ int perm32(int rho) { const int n = rho >> 4, i = rho & 15; return 8 * (i >> 2) + 4 * n + (i & 3); }

struct Unit { int pm, pn; };
struct Gemm { const bf16_t* A; const bf16_t* Bt; int M, N, K, wave; };

struct StaticOrder {
    int nM, nN, nwg, G, c;
    __host__ __device__ void init(int M, int N, int G_, int c_) { nM = M / BM; nN = N / BM; nwg = nM * nN; G = G_; c = c_; }
    __host__ __device__ bool next(int i, Unit& u) const {
        const long L = (long)i * G + c; if (L >= nwg) return false;
        int wgid = (int)L; { const int q = nwg / NXCD, r = nwg % NXCD, xcd = wgid % NXCD, off = wgid / NXCD; wgid = (xcd < r ? xcd * (q + 1) : r * (q + 1) + (xcd - r) * q) + off; }
        const int nig = WGM * nN, gid = wgid / nig, fm = gid * WGM, gsz = (nM - fm) < WGM ? (nM - fm) : WGM;
        u.pm = fm + ((wgid % nig) % gsz); u.pn = (wgid % nig) / gsz; return true;
    }
    __device__ __forceinline__ void a_ready(const Unit&) const {}
    __device__ __forceinline__ void done(const Unit&) const {}
};

typedef float f32x2 __attribute__((ext_vector_type(2)));
typedef __bf16 bf16x2v __attribute__((ext_vector_type(2)));
__device__ __forceinline__ unsigned cvt_pk_bf16(float lo, float hi) { f32x2 v = {lo, hi}; bf16x2v b = __builtin_convertvector(v, bf16x2v); return __builtin_bit_cast(unsigned, b); }
__device__ __forceinline__ u32x4 pack8(const f32x4 a, const f32x4 b) { u32x4 w; w.x = cvt_pk_bf16(a[0], a[1]); w.y = cvt_pk_bf16(a[2], a[3]); w.z = cvt_pk_bf16(b[0], b[1]); w.w = cvt_pk_bf16(b[2], b[3]); return w; }
#ifndef RES_PREFETCH
#define RES_PREFETCH 0
#endif
#ifndef STORE_WT
#define STORE_WT 0
#endif
__device__ __forceinline__ void st16(bf16_t* p, const u32x4 v) {
#if STORE_WT
    asm volatile("global_store_dwordx4 %0, %1, off sc1\n\ts_nop 1" :: "v"(p), "v"(v) : "memory");
#else
    *(u32x4*)p = v;
#endif
}
__device__ __forceinline__ float row_rstd(const float* ssq, int row, float inv_n, float eps) {
    const f32x4 s0 = *(const f32x4*)(ssq + (size_t)row * 8), s1 = *(const f32x4*)(ssq + (size_t)row * 8 + 4);
    return __builtin_amdgcn_rsqf((((s0[0] + s0[1]) + (s0[2] + s0[3])) + ((s1[0] + s1[1]) + (s1[2] + s1[3]))) * inv_n + eps);
}

template <class Sched>
__device__ __forceinline__ void fill_rstd_table(PG8_LAS float* tab, const Sched& S, const float* ssq, float eps, int tid) {
    Unit u;
    for (int i = 0; S.next(i, u); ++i) if ((tid >> 8) == (i & 1)) tab[i * BM + (tid & 255)] = row_rstd(ssq, u.pm * BM + (tid & 255), 1.0f / 2048.0f, eps);
    asm volatile("s_waitcnt lgkmcnt(0)" ::: "memory"); __builtin_amdgcn_s_barrier(); asm volatile("" ::: "memory");
}

struct MixedOrderG1 : StaticOrder {
    __host__ __device__ bool next(int i, Unit& u) const { const bool ok = StaticOrder::next(i, u); if (ok) u.pn = (u.pn & 3) * 6 + (u.pn >> 2); return ok; }
};

struct EpiG1 {
    static constexpr bool AFTER_DRAIN = false;
    const PG8_LAS float* rs_tab; const float* qg; int g_stride;
    bf16_t* Q; size_t qkv_stride;
    bf16_t* PC;
    float* kout; size_t kv_out_stride;
    float qscale, eps;
    __device__ __forceinline__ void operator()(const f32x4 (&acc)[2][2][4][2], const Unit& u, int ui, int wr, int wc, int fr, int fq) const {
        const int region = u.pn >> 2, head = (u.pn & 3) * 4 + wc;
        f32x4 g[2][2];
#pragma unroll
        for (int bj = 0; bj < 2; ++bj)
#pragma unroll
            for (int n = 0; n < 2; ++n) g[bj][n] = (f32x4){1.f, 1.f, 1.f, 1.f};
        if (region < 2) { const float* gp = qg + region * g_stride; const float s = region == 0 ? qscale : 1.f;
#pragma unroll
            for (int bj = 0; bj < 2; ++bj)
#pragma unroll
                for (int n = 0; n < 2; ++n) g[bj][n] = *(const f32x4*)(gp + bj * 32 + fq * 8 + n * 4) * s; }
#pragma unroll
        for (int ai = 0; ai < 2; ++ai)
#pragma unroll
            for (int m = 0; m < 4; ++m) {
                const int row = u.pm * BM + ai * HALF + wr * 64 + m * 16 + fr;
                const float rs = rs_tab[ui * BM + ai * HALF + wr * 64 + m * 16 + fr];
                f32x4 v[2][2];
#pragma unroll
                for (int bj = 0; bj < 2; ++bj)
#pragma unroll
                    for (int n = 0; n < 2; ++n) v[bj][n] = acc[ai][bj][m][n] * rs;
                if (region < 2) {
                    float q = 0.f;
#pragma unroll
                    for (int bj = 0; bj < 2; ++bj)
#pragma unroll
                        for (int n = 0; n < 2; ++n) { const f32x4 x = v[bj][n]; q += (x[0] * x[0] + x[1] * x[1]) + (x[2] * x[2] + x[3] * x[3]); }
                    q += __shfl_xor(q, 16); q += __shfl_xor(q, 32);
                    const float rh = __builtin_amdgcn_rsqf(q * (1.0f / 64.0f) + eps);
#pragma unroll
                    for (int bj = 0; bj < 2; ++bj)
#pragma unroll
                        for (int n = 0; n < 2; ++n) v[bj][n] = v[bj][n] * rh * g[bj][n];
                }
                if (region < 3) {
                    const int b = row >> 11, t = row & 2047;
                    bf16_t* dst = Q + (size_t)region * qkv_stride + ((size_t)(b * 16 + head) * 2048 + t) * 64 + fq * 8;
#pragma unroll
                    for (int bj = 0; bj < 2; ++bj) *(u32x4*)(dst + bj * 32) = pack8(v[bj][0], v[bj][1]);
                    if (!KV_SIDE && region >= 1) { float* o = kout + (size_t)(region - 1) * kv_out_stride + (size_t)row * 1024 + head * 64 + fq * 8;
#pragma unroll
                        for (int bj = 0; bj < 2; ++bj) { __builtin_nontemporal_store(v[bj][0], (f32x4*)(o + bj * 32)); __builtin_nontemporal_store(v[bj][1], (f32x4*)(o + bj * 32 + 4)); } }
                } else if (u.pn < 20) {
                    bf16_t* dst = PC + (size_t)row * 2048 + (u.pn - 12) * 128 + wc * 32 + fq * 8;
                    *(u32x4*)dst = pack8(v[0][0] * v[1][0], v[0][1] * v[1][1]);
                } else {
                    bf16_t* dst = PC + (size_t)row * 2048 + 1024 + (u.pn - 20) * 256 + wc * 64 + fq * 8;
#pragma unroll
                    for (int bj = 0; bj < 2; ++bj) *(u32x4*)(dst + bj * 32) = pack8(v[bj][0], v[bj][1]);
                }
            }
    }
};

struct EpiG3 {
    static constexpr bool AFTER_DRAIN = false;
    const PG8_LAS float* rs_tab; bf16_t* Hb; int ldc;
    __device__ __forceinline__ void operator()(const f32x4 (&acc)[2][2][4][2], const Unit& u, int ui, int wr, int wc, int fr, int fq) const {
#pragma unroll
        for (int ai = 0; ai < 2; ++ai)
#pragma unroll
            for (int m = 0; m < 4; ++m) {
                const int row = u.pm * BM + ai * HALF + wr * 64 + m * 16 + fr;
                const float rs = rs_tab[ui * BM + ai * HALF + wr * 64 + m * 16 + fr];
                bf16_t* dst = Hb + (size_t)row * ldc + u.pn * BM + wc * 64 + fq * 8;
#pragma unroll
                for (int bj = 0; bj < 2; ++bj) {
                    f32x4 a = acc[ai][bj][m][0] * rs, b = acc[ai][bj][m][1] * rs;
#pragma unroll
                    for (int i = 0; i < 4; ++i) { const float x = fmaxf(a[i], 0.f), y = fmaxf(b[i], 0.f); a[i] = x * x; b[i] = y * y; }
                    st16(dst + bj * 32, pack8(a, b));
                }
            }
    }
};

struct EpiRes {
    static constexpr bool AFTER_DRAIN = true;
    bf16_t* xb; float* ssq_out; float* yout;
    __device__ __forceinline__ void prefetch(const Unit& u, int wr, int wc, int fr, int fq, u32x4 (&res)[2][4][2]) const {
#pragma unroll
        for (int ai = 0; ai < RES_PREFETCH; ++ai)
#pragma unroll
            for (int m = 0; m < 4; ++m) {
                const size_t off = (size_t)(u.pm * BM + ai * HALF + wr * 64 + m * 16 + fr) * 2048 + u.pn * BM + wc * 64 + fq * 8;
#pragma unroll
                for (int bj = 0; bj < 2; ++bj) res[ai][m][bj] = *(const u32x4*)(xb + off + bj * 32);
            }
    }
    __device__ __forceinline__ void fused(const f32x4 (&acc)[2][2][4][2], const u32x4 (&res)[2][4][2], const Unit& u, int wr, int wc, int fr, int fq, PG8_LAS unsigned char* lds, int wid, int lane) const {
        PG8_LAS float* P = (PG8_LAS float*)lds;
#pragma unroll
        for (int ai = 0; ai < 2; ++ai)
#pragma unroll
            for (int m = 0; m < 4; ++m) {
                const int rl = ai * HALF + wr * 64 + m * 16 + fr;
                const size_t off = (size_t)(u.pm * BM + rl) * 2048 + u.pn * BM + wc * 64 + fq * 8;
                float q = 0.f;
#pragma unroll
                for (int bj = 0; bj < 2; ++bj) {
                    const u32x4 xo = ai < RES_PREFETCH ? res[ai][m][bj] : *(const u32x4*)(xb + off + bj * 32);
                    f32x4 v0, v1;
                    v0[0] = __uint_as_float(xo[0] << 16); v0[1] = __uint_as_float(xo[0] & 0xffff0000u); v0[2] = __uint_as_float(xo[1] << 16); v0[3] = __uint_as_float(xo[1] & 0xffff0000u);
                    v1[0] = __uint_as_float(xo[2] << 16); v1[1] = __uint_as_float(xo[2] & 0xffff0000u); v1[2] = __uint_as_float(xo[3] << 16); v1[3] = __uint_as_float(xo[3] & 0xffff0000u);
                    v0 += acc[ai][bj][m][0]; v1 += acc[ai][bj][m][1];
                    if (yout) { *(f32x4*)(yout + off + bj * 32) = v0; *(f32x4*)(yout + off + bj * 32 + 4) = v1; }
                    st16(xb + off + bj * 32, pack8(v0, v1));
                    q += ((v0[0] * v0[0] + v0[1] * v0[1]) + (v0[2] * v0[2] + v0[3] * v0[3])) + ((v1[0] * v1[0] + v1[1] * v1[1]) + (v1[2] * v1[2] + v1[3] * v1[3]));
                }
                q += __shfl_xor(q, 16); q += __shfl_xor(q, 32);
                if (fq == 0) P[rl * 4 + wc] = q;
            }
        asm volatile("s_waitcnt lgkmcnt(0)" ::: "memory"); __builtin_amdgcn_s_barrier(); asm volatile("" ::: "memory");
        const int tid = wid * 64 + lane;
        if (tid < 256) { const f32x4 p = *(const PG8_LAS f32x4*)(P + tid * 4); ssq_out[(size_t)(u.pm * BM + tid) * 8 + u.pn] = (p[0] + p[1]) + (p[2] + p[3]); }
        asm volatile("s_waitcnt lgkmcnt(0)" ::: "memory"); __builtin_amdgcn_s_barrier(); asm volatile("" ::: "memory");
    }
};

struct EpiNull { static constexpr bool AFTER_DRAIN = true;
    __device__ __forceinline__ void prefetch(const Unit&, int, int, int, int, u32x4 (&)[2][4][2]) const {}
    __device__ __forceinline__ void fused(const f32x4 (&acc)[2][2][4][2], const u32x4 (&)[2][4][2], const Unit& u, int wr, int wc, int fr, int fq, PG8_LAS unsigned char* lds, int wid, int lane) const {
        float s = 0.f;
#pragma unroll
        for (int ai = 0; ai < 2; ++ai)
#pragma unroll
            for (int bj = 0; bj < 2; ++bj)
#pragma unroll
                for (int m = 0; m < 4; ++m)
#pragma unroll
                    for (int n = 0; n < 2; ++n) s += acc[ai][bj][m][n][0] + acc[ai][bj][m][n][1] + acc[ai][bj][m][n][2] + acc[ai][bj][m][n][3];
        if (s == 1.2345e-30f) *(PG8_LAS float*)lds = s;
    }
};

struct NoSide { static constexpr bool ON = false; __device__ __forceinline__ void prime() {} __device__ __forceinline__ void fetch() {} __device__ __forceinline__ void step(int) {} };
template <class Epi, class Sched, bool ALIGN_EPI = false, bool SP2 = false, class Side = NoSide>
__device__ __forceinline__ void gemm_phase(PG8_LAS unsigned char* lds, const Gemm g, const Sched& S, const Epi& E, Side side = Side()) {
    int tid_ = (int)__builtin_amdgcn_mbcnt_hi(~0u, __builtin_amdgcn_mbcnt_lo(~0u, 0u)) + 64 * g.wave; asm volatile("" : "+v"(tid_));
    const int tid = tid_, wid = __builtin_amdgcn_readfirstlane(tid >> 6), lane = tid & 63, wr = wid >> 2, wc = wid & 3, fr = lane & 15, fq = lane >> 4;
    const int K = g.K, nt = K / BK;
    unsigned voffA[2], voffB[2];
#pragma unroll
    for (int i = 0; i < 2; ++i) { int R, C; stage_rc(tid * 16 + i * 8192, R, C); const int Rb = 64 * (R >> 5) + perm32(R & 31);
        voffA[i] = (unsigned)(R * K + C) * 2u; voffB[i] = (unsigned)(Rb * K + C) * 2u; }
    const size_t kstep = (size_t)(BK * 2);
    const size_t hstep = (size_t)HALF * K * 2;
    const size_t hstepB = (size_t)32 * K * 2; const size_t tstep = 2 * hstep;
    const unsigned ldsw = (unsigned)wid * 1024u;
    const int aoff = lds_byte(wr * 64 + fr, fq * 8), boff = lds_byte(wc * 32 + fr, fq * 8);
#define PG8_SA(b, h) (((b) * 2 + (h)) * HTB)
#define PG8_SB(b, h) ((4 + (b) * 2 + (h)) * HTB)
#define PG8_STAGE(bufoff, gbase, voff) do { _Pragma("unroll") for (int _i = 0; _i < 2; ++_i) \
        __builtin_amdgcn_global_load_lds((const unsigned*)((const char*)(gbase) + (voff)[_i]), (PG8_LAS unsigned*)(lds + (bufoff) + ldsw + _i * 8192), 16, 0, 0); } while (0)
#define PG8_LDA(dst, b, h) do { _Pragma("unroll") for (int m = 0; m < 4; ++m) _Pragma("unroll") for (int k = 0; k < 2; ++k) dst[m][k] = *(const PG8_LAS bf16x8*)(lds + PG8_SA(b, h) + aoff + m * 2048 + k * 1024); } while (0)
#define PG8_LDB(dst, b, h) do { _Pragma("unroll") for (int n = 0; n < 2; ++n) _Pragma("unroll") for (int k = 0; k < 2; ++k) dst[n][k] = *(const PG8_LAS bf16x8*)(lds + PG8_SB(b, h) + boff + n * 2048 + k * 1024); } while (0)
#define PG8_MMA(ai, bj, At, Bt) do { __builtin_amdgcn_s_setprio(1); _Pragma("unroll") for (int m = 0; m < 4; ++m) _Pragma("unroll") for (int n = 0; n < 2; ++n) _Pragma("unroll") for (int k = 0; k < 2; ++k) \
        acc[ai][bj][m][n] = __builtin_amdgcn_mfma_f32_16x16x32_bf16(Bt[n][k], At[m][k], acc[ai][bj][m][n], 0, 0, 0); __builtin_amdgcn_s_setprio(0); } while (0)
#define PG8_WAIT_V(n) asm volatile("s_waitcnt vmcnt(" #n ")" ::: "memory")
#define PG8_WAIT_L(n) asm volatile("s_waitcnt lgkmcnt(" #n ")" ::: "memory")
#define PG8_BAR __builtin_amdgcn_s_barrier()
#define PG8_SCHED __builtin_amdgcn_sched_barrier(0)
    Unit cur, nxt; int ui = 0;
    if (!S.next(0, cur)) return;
    f32x4 acc[2][2][4][2];
#pragma unroll
    for (int a = 0; a < 2; ++a)
#pragma unroll
        for (int b = 0; b < 2; ++b)
#pragma unroll
            for (int m = 0; m < 4; ++m)
#pragma unroll
                for (int n = 0; n < 2; ++n) acc[a][b][m][n] = (f32x4){0.f, 0.f, 0.f, 0.f};
    bf16x8 At[4][2], B0[2][2], B1[2][2];
    const char* cA = (const char*)g.A + (size_t)cur.pm * tstep; const char* cB = (const char*)g.Bt + (size_t)cur.pn * tstep;
    S.a_ready(cur);
    if constexpr (SP2) {
        if constexpr (Side::ON) side.prime();
        PG8_STAGE(PG8_SB(0, 0), cB, voffB); PG8_STAGE(PG8_SB(0, 1), cB + hstepB, voffB); PG8_STAGE(PG8_SA(0, 0), cA, voffA); PG8_STAGE(PG8_SA(0, 1), cA + hstep, voffA);
        if (wr == 1) PG8_BAR;
        PG8_WAIT_V(2); PG8_BAR;
        PG8_STAGE(PG8_SB(1, 0), cB + kstep, voffB); PG8_STAGE(PG8_SA(1, 0), cA + kstep, voffA); PG8_STAGE(PG8_SB(1, 1), cB + hstepB + kstep, voffB);
        PG8_WAIT_V(6); PG8_BAR;
        if constexpr (Side::ON) side.fetch();
    } else {
        PG8_STAGE(PG8_SB(0, 0), cB, voffB); PG8_STAGE(PG8_SA(0, 0), cA, voffA); PG8_STAGE(PG8_SB(0, 1), cB + hstepB, voffB); PG8_STAGE(PG8_SA(0, 1), cA + hstep, voffA);
        if (wr == 1) PG8_BAR;
        PG8_WAIT_V(4); PG8_BAR;
        PG8_STAGE(PG8_SB(1, 0), cB + kstep, voffB); PG8_STAGE(PG8_SA(1, 0), cA + kstep, voffA); PG8_STAGE(PG8_SB(1, 1), cB + hstepB + kstep, voffB);
        PG8_WAIT_V(6); PG8_BAR;
    }
    for (;;) {
        const bool has_next = S.next(ui + 1, nxt);
        const char* nA = has_next ? (const char*)g.A + (size_t)nxt.pm * tstep : cA; const char* nB = has_next ? (const char*)g.Bt + (size_t)nxt.pn * tstep : cB;
        for (int t = 0; t < nt; t += 2) {
            const bool last = (t == nt - 2);
            const char* a1 = cA + (size_t)(t + 1) * kstep;
            const char* a2 = last ? nA : cA + (size_t)(t + 2) * kstep; const char* b2 = last ? nB : cB + (size_t)(t + 2) * kstep;
            const char* a3 = a2 + kstep; const char* b3 = b2 + kstep;
            if (last && has_next) S.a_ready(nxt);
            if constexpr (SP2) {
            PG8_LDB(B0, 0, 0); PG8_LDB(B1, 0, 1); PG8_SCHED; PG8_LDA(At, 0, 0); PG8_STAGE(PG8_SA(1, 1), a1 + hstep, voffA);
            if constexpr (Side::ON) { side.step(ui * (nt >> 1) + (t >> 1)); PG8_WAIT_V(9); } else PG8_WAIT_V(8);
            PG8_WAIT_L(0); PG8_BAR; PG8_MMA(0, 0, At, B0); PG8_MMA(0, 1, At, B1); PG8_BAR; PG8_SCHED;
            PG8_LDA(At, 0, 1); PG8_STAGE(PG8_SB(0, 0), b2, voffB); PG8_STAGE(PG8_SB(0, 1), b2 + hstepB, voffB); PG8_STAGE(PG8_SA(0, 0), a2, voffA);
            if constexpr (Side::ON) PG8_WAIT_V(9); else PG8_WAIT_V(8);
            PG8_WAIT_L(0); PG8_BAR; PG8_MMA(1, 0, At, B0); PG8_MMA(1, 1, At, B1); PG8_BAR; PG8_SCHED;
            PG8_LDB(B0, 1, 0); PG8_LDB(B1, 1, 1); PG8_SCHED; PG8_LDA(At, 1, 0); PG8_STAGE(PG8_SA(0, 1), a2 + hstep, voffA);
            PG8_WAIT_V(8); PG8_WAIT_L(0); PG8_BAR; PG8_MMA(0, 0, At, B0); PG8_MMA(0, 1, At, B1); PG8_BAR; PG8_SCHED;
            PG8_LDA(At, 1, 1); if constexpr (Side::ON) side.fetch();
            PG8_STAGE(PG8_SB(1, 0), b3, voffB); PG8_STAGE(PG8_SB(1, 1), b3 + hstepB, voffB); PG8_STAGE(PG8_SA(1, 0), a3, voffA);
            PG8_WAIT_V(8); PG8_WAIT_L(0); PG8_BAR; PG8_MMA(1, 0, At, B0); PG8_MMA(1, 1, At, B1); PG8_BAR; PG8_SCHED;
            } else {
            PG8_LDB(B0, 0, 0); PG8_SCHED; PG8_LDA(At, 0, 0); PG8_STAGE(PG8_SA(1, 1), a1 + hstep, voffA);
            PG8_WAIT_L(8); PG8_BAR; PG8_WAIT_L(0); PG8_MMA(0, 0, At, B0); PG8_BAR; PG8_SCHED;
            PG8_LDB(B1, 0, 1); PG8_STAGE(PG8_SB(0, 0), b2, voffB);
            PG8_BAR; PG8_WAIT_L(0); PG8_MMA(0, 1, At, B1); PG8_BAR;
            PG8_LDA(At, 0, 1); PG8_STAGE(PG8_SA(0, 0), a2, voffA);
            PG8_BAR; PG8_WAIT_L(0); PG8_MMA(1, 0, At, B0); PG8_BAR; PG8_SCHED;
            PG8_STAGE(PG8_SB(0, 1), b2 + hstepB, voffB);
            PG8_WAIT_V(6); PG8_BAR; PG8_MMA(1, 1, At, B1); PG8_BAR;
            PG8_LDB(B0, 1, 0); PG8_SCHED; PG8_LDA(At, 1, 0); PG8_STAGE(PG8_SA(0, 1), a2 + hstep, voffA);
            PG8_WAIT_L(8); PG8_BAR; PG8_WAIT_L(0); PG8_MMA(0, 0, At, B0); PG8_BAR; PG8_SCHED;
            PG8_LDB(B1, 1, 1); PG8_STAGE(PG8_SB(1, 0), b3, voffB);
            PG8_BAR; PG8_WAIT_L(0); PG8_MMA(0, 1, At, B1); PG8_BAR;
            PG8_LDA(At, 1, 1); PG8_STAGE(PG8_SA(1, 0), a3, voffA);
            PG8_BAR; PG8_WAIT_L(0); PG8_MMA(1, 0, At, B0); PG8_BAR; PG8_SCHED;
            PG8_STAGE(PG8_SB(1, 1), b3 + hstepB, voffB);
            PG8_WAIT_V(6); PG8_BAR; PG8_MMA(1, 1, At, B1); PG8_BAR;
            }
        }
        if constexpr (ALIGN_EPI) { if (wr == 0) PG8_BAR; }
        if constexpr (!Epi::AFTER_DRAIN) { E(acc, cur, ui, wr, wc, fr, fq); S.done(cur); }
        if (!has_next) break;
#pragma unroll
        for (int a = 0; a < 2; ++a)
#pragma unroll
            for (int b = 0; b < 2; ++b)
#pragma unroll
                for (int m = 0; m < 4; ++m)
#pragma unroll
                    for (int n = 0; n < 2; ++n) acc[a][b][m][n] = (f32x4){0.f, 0.f, 0.f, 0.f};
        cur = nxt; cA = nA; cB = nB; ++ui;
        if constexpr (ALIGN_EPI) { if (wr == 1) PG8_BAR; }
    }
    u32x4 res[2][4][2];
    if constexpr (Epi::AFTER_DRAIN) E.prefetch(cur, wr, wc, fr, fq, res);
    PG8_WAIT_V(0);
    if constexpr (!ALIGN_EPI) { if (wr == 0) PG8_BAR; }
    PG8_BAR;
    if constexpr (Epi::AFTER_DRAIN) { E.fused(acc, res, cur, wr, wc, fr, fq, lds, wid, lane); S.done(cur); }
#undef PG8_SA
#undef PG8_SB
#undef PG8_STAGE
#undef PG8_LDA
#undef PG8_LDB
#undef PG8_MMA
#undef PG8_WAIT_V
#undef PG8_WAIT_L
#undef PG8_BAR
#undef PG8_SCHED
}
}

constexpr int NWAVES = 8;
#ifndef MK_ONE_LAUNCH
#define MK_ONE_LAUNCH 1
#endif
#ifndef COPY_IN_P0
#define COPY_IN_P0 0
#endif
#ifndef ATT_NMOVE
#define ATT_NMOVE (COPY_IN_P0 ? 0 : 3)
#endif
#ifndef ATT_V4
#define ATT_V4 1
#endif
#ifndef ATT4_MOVERS
#define ATT4_MOVERS 4
#endif
#ifndef GEMM_ALIGN
#define GEMM_ALIGN true
#endif
#ifndef GEMM_SP2
#define GEMM_SP2 true
#endif
#ifndef STAGGER
#define STAGGER 1
#endif
#ifndef STAGGER_MODE
#define STAGGER_MODE 0
#endif
#define STAGGER_PRED(v) (STAGGER_MODE == 0 ? ((v) & 1) : STAGGER_MODE == 1 ? (((v) & 3) == 0) : STAGGER_MODE == 2 ? (((v) >> 1) & 1) : (((v) % 3) == 0))
#ifndef CONV_ORDER
#define CONV_ORDER 0
#endif
#ifndef CONV_IN_P0
#define CONV_IN_P0 0
#endif
constexpr int NB = 4, S = 2048, D = 2048, DEPTH = 4, SB = 8, WBUF = 2048, H = 16, HD = 64, DA = 1024, DC = 1024, DIN = 6144, DFF = 8192;
constexpr int M = NB * S;
constexpr float EPS = 1e-6f;
constexpr float QSCALE = 0.125f * 1.4426950408889634f;
constexpr float LOG2E = 1.4426950408889634f;
constexpr int NPH = 1 + 6 * DEPTH;

constexpr size_t O_Y = 0, O_YS = 16777216, O_KP = 16793600, O_VP = 50348032, O_CP = 83902464, O_KS = 83935232, O_VS = 151044096, O_CS = 218152960, O_END = 218218496;

constexpr size_t MiB = 1u << 20;
constexpr size_t WS_CTL = 0, CTL_ZERO_BYTES = 64 * 1024;
constexpr size_t WS_WIN = 1 * MiB;
constexpr size_t WS_WOUT = WS_WIN + 96 * MiB;
constexpr size_t WS_WUP = WS_WOUT + 32 * MiB;
constexpr size_t WS_WDN = WS_WUP + 128 * MiB;
constexpr size_t WS_XB = WS_WDN + 128 * MiB;
constexpr size_t WS_Q = WS_XB + 32 * MiB, WS_K = WS_Q + 16 * MiB, WS_V = WS_K + 16 * MiB;
constexpr size_t WS_PC = WS_V + 16 * MiB;
constexpr size_t WS_OP = WS_PC + 48 * MiB;
constexpr size_t WS_ML = WS_OP + 96 * MiB;
constexpr size_t WS_MIX = WS_ML + 3 * MiB;
constexpr size_t WS_HB = WS_MIX + 32 * MiB;
constexpr size_t WS_SSQA = WS_HB + 128 * MiB;
constexpr size_t WS_SSQB = WS_SSQA + 256 * 1024;
constexpr size_t WS_SMALL = WS_SSQB + 256 * 1024 + 512 * 1024;
constexpr size_t WS_XS = WS_SMALL;
constexpr size_t WS_PS = WS_XS + 64 * 1024;
constexpr size_t WS_OS = WS_PS + 192 * 1024;
constexpr size_t WS_MIXS = WS_OS + 32 * 1024;
constexpr size_t WS_AS = WS_MIXS + 64 * 1024;
constexpr size_t WS_BT = WS_AS + 256 * 1024;
constexpr size_t WS_GN = WS_BT + 32 * 1024;
constexpr size_t WS_CW = WS_GN + 4 * 1024;
constexpr size_t WS_SC = WS_CW + 64 * 1024;
constexpr size_t WS_SINK = WS_SMALL + 1 * MiB;
constexpr size_t WS_END = WS_SINK + 8 * MiB;
static_assert(WS_SC + 256 * 1024 <= WS_END, "small buffers");
constexpr int CW_BAR = 4096;

#ifndef EARLY_WBL2
#define EARLY_WBL2 0
#endif
#if EARLY_WBL2
#define EARLY_WB() asm volatile("buffer_wbl2 sc1" ::: "memory")
#else
#define EARLY_WB() do {} while (0)
#endif
#ifndef CONV_SKEW
#define CONV_SKEW 3
#endif
#ifndef COPY_IN_G4
#define COPY_IN_G4 0
#endif
#ifndef COPY_BOTH
#define COPY_BOTH 0
#endif
#ifndef CONV_RING
#define CONV_RING 0
#endif
#ifndef CONV_DP
#define CONV_DP 5
#endif
constexpr int LDS_BYTES = 147456;
constexpr int LDSCTL_OFF = LDS_BYTES - 512;
constexpr int MISC_OFF = LDSCTL_OFF;
constexpr int RS_TAB_OFF = 131072;
static_assert(RS_TAB_OFF + 4 * 256 * 4 <= LDSCTL_OFF, "LDS map");

#define GAS __attribute__((address_space(1)))
#define LAS __attribute__((address_space(3)))
typedef unsigned short bf16;
typedef unsigned v4u __attribute__((ext_vector_type(4)));
typedef unsigned v2u __attribute__((ext_vector_type(2)));
typedef float f32x4 __attribute__((ext_vector_type(4)));
typedef float f32x2 __attribute__((ext_vector_type(2)));
typedef float f32x16 __attribute__((ext_vector_type(16)));
typedef short bf16x8 __attribute__((ext_vector_type(8)));
typedef short s16x4 __attribute__((ext_vector_type(4)));
typedef GAS unsigned gu32;
#define RLX_AGENT __ATOMIC_RELAXED, __HIP_MEMORY_SCOPE_AGENT
using pg8::cvt_pk_bf16;
using pg8::pack8;

#define XB_TMO      128
#define XB_XCNT(j)  (256  + 64 * (j))
#define XB_XSUB(j)  (1280 + 64 * (j))
#define XB_XGEN(j)  (2304 + 64 * (j))
#define XB_TOP      3328
#define XB_TOPGEN   3392
#define XCD_BAR_WORDS 3456
#define XB_SPIN_CAP (1u << 18)

__device__ __forceinline__ unsigned xb_ld(unsigned* p)              { return __hip_atomic_load(p, __ATOMIC_RELAXED, __HIP_MEMORY_SCOPE_AGENT); }
__device__ __forceinline__ unsigned xb_add(unsigned* p, unsigned v) { return __hip_atomic_fetch_add(p, v, __ATOMIC_RELAXED, __HIP_MEMORY_SCOPE_AGENT); }
__device__ __forceinline__ unsigned xb_xcc_id() { return (unsigned)__builtin_amdgcn_s_getreg((3 << 11) | 20) & 0xFu; }
#define XB_SPIN(cond, bar) do { unsigned _sp = 0; while (cond) { __builtin_amdgcn_s_sleep(1); \
    if ((++_sp & 255u) == 0u) { if (xb_ld(&(bar)[XB_TMO])) break; if (_sp > XB_SPIN_CAP) { atomicAdd(&(bar)[XB_TMO], 1u); break; } } } } while (0)

__device__ __forceinline__ bool xb_lane0() { return __builtin_amdgcn_mbcnt_hi(~0u, __builtin_amdgcn_mbcnt_lo(~0u, 0u)) == 0u; }
struct XcdBarrier {
    int wave;
    unsigned* bar; unsigned x;
    volatile LAS unsigned* st;
};

__device__ __forceinline__ XcdBarrier xcd_barrier_post(unsigned* bar, volatile LAS unsigned* st, int wave) {
    XcdBarrier b; b.wave = wave; b.bar = bar; b.x = xb_xcc_id(); b.st = st;
    if (wave == 0 && xb_lane0()) (void)xb_add(&bar[XB_XCNT(b.x)], 1u);
    return b;
}
__device__ __forceinline__ void xcd_barrier_complete(unsigned* bar, unsigned x, unsigned& nloc, unsigned& nx) {
    const unsigned G = gridDim.x * gridDim.y * gridDim.z;
    unsigned sum, cnt, mine, sp = 0u;
    for (;;) {
        sum = 0u; cnt = 0u; mine = 0u;
#pragma unroll
        for (unsigned j = 0; j < 16; ++j) { const unsigned c = xb_ld(&bar[XB_XCNT(j)]); sum += c; cnt += (c > 0u) ? 1u : 0u; mine = (j == x) ? c : mine; }
        if (sum == G) break;
        __builtin_amdgcn_s_sleep(1);
        if ((++sp & 255u) == 0u) { if (xb_ld(&bar[XB_TMO])) break; if (sp > XB_SPIN_CAP) { atomicAdd(&bar[XB_TMO], 1u); break; } }
    }
    nloc = mine > 0u ? mine : 1u; nx = cnt > 0u ? cnt : 1u;
}

__device__ __forceinline__ void xcd_barrier(const XcdBarrier& b) {
    asm volatile("s_waitcnt vmcnt(0)" ::: "memory");
    __syncthreads();
    if (b.wave == 0 && xb_lane0()) {
        unsigned* bar = b.bar;
        __builtin_amdgcn_s_waitcnt(0);
        unsigned nloc = b.st[0], nx = b.st[1];
        if (nloc == 0u) { xcd_barrier_complete(bar, b.x, nloc, nx); b.st[0] = nloc; b.st[1] = nx; }
        const unsigned old = xb_add(&bar[XB_XSUB(b.x)], 1u);
        const unsigned gen = old / nloc;
        if (old + 1u == (gen + 1u) * nloc) {
            __builtin_amdgcn_fence(__ATOMIC_RELEASE, "agent");
            asm volatile("s_waitcnt vmcnt(0)" ::: "memory");
            const unsigned og = xb_add(&bar[XB_TOP], 1u);
            const unsigned tg = og / nx;
            if (og + 1u == (tg + 1u) * nx) xb_add(&bar[XB_TOPGEN], 1u);
            else XB_SPIN(xb_ld(&bar[XB_TOPGEN]) == tg, bar);
            __builtin_amdgcn_fence(__ATOMIC_ACQUIRE, "agent");
            xb_add(&bar[XB_XGEN(b.x)], 1u);
            asm volatile("s_waitcnt vmcnt(0)" ::: "memory");
        } else {
            XB_SPIN(xb_ld(&bar[XB_XGEN(b.x)]) == gen, bar);
            __builtin_amdgcn_fence(__ATOMIC_ACQUIRE, "agent");
            asm volatile("s_waitcnt vmcnt(0)" ::: "memory");
        }
    }
    __syncthreads();
}


struct Frame {
    LAS unsigned char* lds;
    int tid, lane, wave, vcu, G;
    unsigned char* ws; float* out;
    const float *x_prompt, *state_k, *state_v;
};
template <class T> __device__ __forceinline__ T* opq(T* p) { GAS T* g = (GAS T*)p; asm volatile("" : "+s"(g)); return (T*)g; }
__device__ __forceinline__ int opqv(int x) { asm volatile("" : "+v"(x)); return x; }
__device__ __forceinline__ int fresh_tid(int wave) { int l = (int)__builtin_amdgcn_mbcnt_hi(~0u, __builtin_amdgcn_mbcnt_lo(~0u, 0u)); asm volatile("" : "+v"(l)); return 64 * wave + l; }
#define W_WIN(w) ((bf16*)((w) + WS_WIN))
#define W_WOUT(w) ((bf16*)((w) + WS_WOUT))
#define W_WUP(w) ((bf16*)((w) + WS_WUP))
#define W_WDN(w) ((bf16*)((w) + WS_WDN))
#define W_XB(w) ((bf16*)((w) + WS_XB))
#define W_Q(w) ((bf16*)((w) + WS_Q))
#define W_K(w) ((bf16*)((w) + WS_K))
#define W_V(w) ((bf16*)((w) + WS_V))
#define W_PC(w) ((bf16*)((w) + WS_PC))
#define W_MIX(w) ((bf16*)((w) + WS_MIX))
#define W_HB(w) ((bf16*)((w) + WS_HB))
#define W_OPB(w) ((bf16*)((w) + WS_OP))
#define W_ML(w) ((float*)((w) + WS_ML))
#define W_SSQA(w) ((float*)((w) + WS_SSQA))
#define W_SSQB(w) ((float*)((w) + WS_SSQB))
#define W_XS(w) ((float*)((w) + WS_XS))
#define W_PS(w) ((float*)((w) + WS_PS))
#define W_OS(w) ((float*)((w) + WS_OS))
#define W_MIXS(w) ((float*)((w) + WS_MIXS))
#define W_AS(w) ((float*)((w) + WS_AS))
#define W_BT(w) ((float*)((w) + WS_BT))
#define W_GN(w) ((float*)((w) + WS_GN))
#define W_CW(w) ((float*)((w) + WS_CW))
#define W_SC(w) ((float*)((w) + WS_SC))

__device__ __forceinline__ float wave_sum(float v) {
#pragma unroll
    for (int o = 1; o < 64; o <<= 1) v += __shfl_xor(v, o);
    return v;
}
__device__ __forceinline__ float wave_max(float v) {
#pragma unroll
    for (int o = 1; o < 64; o <<= 1) v = fmaxf(v, __shfl_xor(v, o));
    return v;
}
__device__ __forceinline__ float max3f(float a, float b, float c) { float r; asm("v_max3_f32 %0, %1, %2, %3" : "=v"(r) : "v"(a), "v"(b), "v"(c)); return r; }
#define LDS_WAIT() asm volatile("s_waitcnt lgkmcnt(0)" ::: "memory")
#define WG_BAR() do { asm volatile("s_waitcnt vmcnt(0) lgkmcnt(0)" ::: "memory"); __builtin_amdgcn_s_barrier(); asm volatile("" ::: "memory"); } while (0)

struct Args { const float* in[17]; float* out; unsigned char* ws; int ph_lo, ph_hi; };
struct P0Item { const float* W; const float* g; bf16* WT; int K, N, k0, n0, perm; };
__device__ __forceinline__ int win_row(int col) {
    if (col < 3072) return col;
    if (col < 4096) { const int c = col - 3072; return 3072 + 256 * (c >> 7) + 64 * ((c >> 5) & 3) + (c & 31); }
    if (col < 5120) return 5120 + (col - 4096);
    const int c = col - 5120; return 3072 + 256 * (c >> 7) + 64 * ((c >> 5) & 3) + 32 + (c & 31);
}
__device__ __forceinline__ void p0_item_load(const P0Item& d, int lane, f32x4 (&v)[8], float& gk) {
#pragma unroll
    for (int i = 0; i < 8; ++i) v[i] = __builtin_nontemporal_load((const f32x4*)(d.W + (size_t)(d.k0 + 8 * i + (lane >> 3)) * d.N + d.n0 + (lane & 7) * 4));
    gk = d.g ? d.g[d.k0 + lane] : 1.f;
}
__device__ __forceinline__ void p0_item_store(const P0Item& d, int lane, const f32x4 (&v)[8], float gk, LAS float* scr) {
#pragma unroll
    for (int i = 0; i < 8; ++i) { const int kk = 8 * i + (lane >> 3); const float gg = __shfl(gk, kk);
        LAS float* s = scr + kk * 33 + (lane & 7) * 4; s[0] = v[i][0] * gg; s[1] = v[i][1] * gg; s[2] = v[i][2] * gg; s[3] = v[i][3] * gg; }
    LDS_WAIT(); asm volatile("" ::: "memory");
    const int c = lane & 7;
#pragma unroll
    for (int j = 0; j < 4; ++j) { const int n = (lane >> 3) + 8 * j; const LAS float* s = scr + (8 * c) * 33 + n;
        v4u o; o.x = cvt_pk_bf16(s[0 * 33], s[1 * 33]); o.y = cvt_pk_bf16(s[2 * 33], s[3 * 33]); o.z = cvt_pk_bf16(s[4 * 33], s[5 * 33]); o.w = cvt_pk_bf16(s[6 * 33], s[7 * 33]);
        __builtin_nontemporal_store(o, (GAS v4u*)(d.WT + (size_t)(d.perm ? win_row(d.n0 + n) : d.n0 + n) * d.K + d.k0 + 8 * c)); }
    LDS_WAIT(); asm volatile("" ::: "memory");
}
__device__ __forceinline__ int t5_bucket(int dist) {
    if (dist < 16) return dist;
    int b = 16;
    b += dist >= 22; b += dist >= 30; b += dist >= 40; b += dist >= 54; b += dist >= 73; b += dist >= 99; b += dist >= 134; b += dist >= 182;
    b += dist >= 246; b += dist >= 332; b += dist >= 450; b += dist >= 609; b += dist >= 825; b += dist >= 1117; b += dist >= 1513;
    return b;
}
constexpr int I_IN = (D / 64) * (DIN / 32), I_OUT = (D / 64) * (D / 32), I_UP = (D / 64) * (DFF / 32), I_DN = (DFF / 64) * (D / 32);
__device__ __forceinline__ int conv_count(int stage) { return stage == 0 ? I_IN : I_OUT + I_UP + I_DN + (stage < DEPTH ? I_IN : 0); }
__device__ __forceinline__ void p0_item_desc(const Args& A, unsigned char* w, int stage, int it, P0Item& d) {
    int l = stage == 0 ? 0 : stage - 1, r = it, mat = 0;
    if (stage != 0) { if (r < I_OUT) mat = 1; else if ((r -= I_OUT) < I_UP) mat = 2; else if ((r -= I_UP) < I_DN) mat = 3; else { r -= I_DN; mat = 0; l += 1; } }
    d.perm = mat == 0;
    if (mat == 0) { d.W = A.in[7] + (size_t)l * D * DIN; d.K = D; d.N = DIN; d.g = A.in[6] + l * D; d.WT = W_WIN(w) + (size_t)l * DIN * D; }
    else if (mat == 1) { d.W = A.in[13] + (size_t)l * D * D; d.K = D; d.N = D; d.g = nullptr; d.WT = W_WOUT(w) + (size_t)l * D * D; }
    else if (mat == 2) { d.W = A.in[15] + (size_t)l * D * DFF; d.K = D; d.N = DFF; d.g = A.in[14] + l * D; d.WT = W_WUP(w) + (size_t)l * DFF * D; }
    else { d.W = A.in[16] + (size_t)l * DFF * D; d.K = DFF; d.N = D; d.g = nullptr; d.WT = W_WDN(w) + (size_t)l * D * DFF; }
    const int nblk = d.N / 32, kb = r / nblk; d.k0 = 64 * kb; d.n0 = 32 * (r - kb * nblk);
    if (mat == 1) d.g = (d.k0 < DA ? A.in[11] + l * DA : A.in[12] + l * DC - DA);
}
__device__ __forceinline__ void conv_run(const Args& A, unsigned char* w, int stage, int it0, int stride, int lane, LAS float* scr) {
    const int n = conv_count(stage);
    P0Item dc, dn; f32x4 vc[8], vn[8]; float gc = 1.f, gn = 1.f;
    int it = it0;
    if (it < n) { p0_item_desc(A, w, stage, it, dc); p0_item_load(dc, lane, vc, gc); }
    for (; it < n; it += stride) {
        const bool more = it + stride < n;
        if (more) { p0_item_desc(A, w, stage, it + stride, dn); p0_item_load(dn, lane, vn, gn); }
        p0_item_store(dc, lane, vc, gc, scr);
        if (more) { dc = dn; gc = gn;
#pragma unroll
            for (int i = 0; i < 8; ++i) vc[i] = vn[i]; }
    }
}
struct CDesc { const float* W; bf16* WT; int N, K, goff; };
__device__ __forceinline__ void cdesc(const Args& A, unsigned char* w, int stage, int it, int sinkoff, CDesc& d) {
    if (it < 0) { d.W = A.in[7]; d.N = 0; d.WT = (bf16*)(w + WS_SINK) + sinkoff; d.K = 64; d.goff = 3 * 2048; return; }
    int l = stage == 0 ? 0 : stage - 1, r = it, mat = 0;
    if (stage != 0) { if (r < I_OUT) mat = 1; else if ((r -= I_OUT) < I_UP) mat = 2; else if ((r -= I_UP) < I_DN) mat = 3; else { r -= I_DN; mat = 0; l += 1; } }
    const float* Wb; bf16* WTb; int K, N;
    if (mat == 0) { Wb = A.in[7] + (size_t)l * D * DIN; K = D; N = DIN; WTb = W_WIN(w) + (size_t)l * DIN * D; }
    else if (mat == 1) { Wb = A.in[13] + (size_t)l * D * D; K = D; N = D; WTb = W_WOUT(w) + (size_t)l * D * D; }
    else if (mat == 2) { Wb = A.in[15] + (size_t)l * D * DFF; K = D; N = DFF; WTb = W_WUP(w) + (size_t)l * DFF * D; }
    else { Wb = A.in[16] + (size_t)l * DFF * D; K = DFF; N = D; WTb = W_WDN(w) + (size_t)l * D * DFF; }
    const int nblk = N / 32, kb = r / nblk, k0 = 64 * kb, n0 = 32 * (r - kb * nblk);
    d.W = Wb + (size_t)k0 * N + n0; d.N = N; d.K = K;
    d.WT = WTb + (size_t)(mat == 0 ? win_row(n0) : n0) * K + k0;
    d.goff = mat == 3 ? 3 * 2048 : mat * 2048 + k0;
}
__device__ __forceinline__ void conv_fill_gains(const Args& A, int stage, LAS float* gtab, int tid) {
    const int l = stage == 0 ? 0 : stage - 1, lin = stage == 0 ? 0 : (stage < DEPTH ? stage : DEPTH - 1);
    for (int e = tid; e < 4 * 2048; e += NWAVES * 64) { const int t = e >> 11, k = e & 2047;
        gtab[e] = t == 0 ? A.in[6][lin * D + k] : t == 1 ? (k < DA ? A.in[11][l * DA + k] : A.in[12][l * DC + k - DA]) : t == 2 ? A.in[14][l * D + k] : 1.f; }
}
__device__ __forceinline__ int conv_ticket(LAS unsigned* q, int lane);
template <int DP>
__device__ __forceinline__ void conv_ring(const Args& A, unsigned char* w, int stage, int vcu, int G, int lane, const LAS float* gtab, LAS unsigned* q, int gwave) {
    const int nk = conv_count(stage) / G;
    const int lq = lane & 7, lc = lane >> 3, bp = 4 * ((lane >> 3) + 8 * (lane & 7)), sinkoff = gwave * 2048;
    f32x4 v[DP][8]; int kt[DP];
#define CR_LOAD(s_) do { CDesc d_; cdesc(A, w, stage, kt[s_] < nk ? vcu * nk + kt[s_] : -1, sinkoff, d_); const float* wp_ = d_.W + (size_t)(8 * lc) * d_.N + 4 * lq; \
        _Pragma("unroll") for (int i = 0; i < 8; ++i) v[s_][i] = __builtin_nontemporal_load((const f32x4*)(wp_ + (size_t)i * d_.N)); } while (0)
#define CR_STORE(s_) do { CDesc d_; cdesc(A, w, stage, kt[s_] < nk ? vcu * nk + kt[s_] : -1, sinkoff, d_); \
        const LAS f32x4* gp_ = (const LAS f32x4*)(gtab + d_.goff + 8 * lc); const f32x4 g0_ = gp_[0], g1_ = gp_[1]; \
        bf16* op_ = d_.WT + (size_t)(4 * lc) * d_.K + 8 * lq;              \
        _Pragma("unroll") for (int e = 0; e < 4; ++e) { v4u o_; \
            o_.x = (unsigned)__builtin_amdgcn_ds_bpermute(bp, (int)cvt_pk_bf16(v[s_][0][e] * g0_[0], v[s_][1][e] * g0_[1])); \
            o_.y = (unsigned)__builtin_amdgcn_ds_bpermute(bp, (int)cvt_pk_bf16(v[s_][2][e] * g0_[2], v[s_][3][e] * g0_[3])); \
            o_.z = (unsigned)__builtin_amdgcn_ds_bpermute(bp, (int)cvt_pk_bf16(v[s_][4][e] * g1_[0], v[s_][5][e] * g1_[1])); \
            o_.w = (unsigned)__builtin_amdgcn_ds_bpermute(bp, (int)cvt_pk_bf16(v[s_][6][e] * g1_[2], v[s_][7][e] * g1_[3])); \
            *(GAS v4u*)(op_ + (size_t)e * d_.K) = o_; } } while (0)
#pragma unroll
    for (int s = 0; s < DP; ++s) {
        kt[s] = conv_ticket(q, lane);
        { bf16* sk = (bf16*)(w + WS_SINK) + sinkoff + (4 * lc) * 64 + 8 * lq;
#pragma unroll
          for (int e = 0; e < 4; ++e) *(GAS v4u*)(sk + e * 64) = (v4u){0u, 0u, 0u, 0u}; }
        CR_LOAD(s);
    }
    while (kt[0] < nk) {
#pragma unroll
        for (int s = 0; s < DP; ++s) { CR_STORE(s); kt[s] = conv_ticket(q, lane); CR_LOAD(s); }
    }
#undef CR_LOAD
#undef CR_STORE
}
__device__ __forceinline__ void p0_prologue(Frame& F, const Args& A) {
    unsigned char* w = F.ws;
    const int gw = F.vcu * NWAVES + F.wave, NGW = F.G * NWAVES;
#if CONV_RING
    { LAS float* gtab = (LAS float*)(F.lds + 1024); LAS unsigned* tq = (LAS unsigned*)F.lds;
      conv_fill_gains(A, 0, gtab, F.tid); if (F.tid == 0) tq[0] = 0u;
      WG_BAR();
      conv_ring<CONV_DP>(A, w, 0, F.vcu, F.G, F.lane, gtab, tq, gw); }
#else
    conv_run(A, w, 0, gw, NGW, F.lane, (LAS float*)(F.lds + F.wave * 8448));
#endif
    for (int m = gw; m < M; m += NGW) {
        const GAS f32x4* xr = (const GAS f32x4*)(A.in[0] + (size_t)m * D) + F.lane; GAS v2u* o8 = (GAS v2u*)(W_XB(w) + (size_t)m * D) + F.lane;
        float s = 0.f;
#pragma unroll
        for (int j = 0; j < 8; ++j) { const f32x4 v = xr[64 * j]; s += (v[0] * v[0] + v[1] * v[1]) + (v[2] * v[2] + v[3] * v[3]); v2u pw; pw.x = cvt_pk_bf16(v[0], v[1]); pw.y = cvt_pk_bf16(v[2], v[3]); o8[64 * j] = pw; }
        s = wave_sum(s);
        if (F.lane < 8) W_SSQA(w)[(size_t)m * 8 + F.lane] = F.lane == 0 ? s : 0.f;
    }
    const int gt = F.vcu * (NWAVES * 64) + F.tid, NGT = F.G * NWAVES * 64;
    for (int i = gt; i < SB * D; i += NGT) W_XS(w)[i] = A.in[1][i];
    for (int i = gt; i < DEPTH * 128; i += NGT) { const int l = i >> 7, r = i & 127; W_GN(w)[i] = r < 64 ? A.in[8][l * 64 + r] : A.in[9][l * 64 + r - 64]; }
    for (int i = gt; i < DEPTH * 3 * DC; i += NGT) W_CW(w)[i] = A.in[10][i];
    for (int i = gt; i < DEPTH * SB * 2 * DC; i += NGT) W_SC(w)[i] = A.in[4][i];
    for (int i = gt; i < 3 * 16 * 129; i += NGT) { const int c = i / (16 * 129), r = i - c * (16 * 129), h = r / 129, j = r - h * 129; W_BT(w)[i] = A.in[5][t5_bucket(j << (2 * c)) * 16 + h] * LOG2E; }
#if COPY_IN_P0
    { constexpr int ROWV = 1024 / 4, PER = (WBUF - 1) * ROWV, TOT = DEPTH * SB * PER;
      for (int i0 = gt; i0 < 2 * TOT; i0 += 8 * NGT) { f32x4 v[8];
#pragma unroll
          for (int u = 0; u < 8; ++u) { const int i = i0 + u * NGT; if (i < 2 * TOT) { const int kv = i >= TOT, r = i - kv * TOT, lb = r / PER, e = r - lb * PER;
              v[u] = __builtin_nontemporal_load((const f32x4*)(kv ? A.in[3] : A.in[2]) + (size_t)lb * (WBUF * ROWV) + ROWV + e); } }
#pragma unroll
          for (int u = 0; u < 8; ++u) { const int i = i0 + u * NGT; if (i < 2 * TOT) { const int kv = i >= TOT, r = i - kv * TOT, lb = r / PER, e = r - lb * PER;
              __builtin_nontemporal_store(v[u], (f32x4*)(F.out + (kv ? O_VS : O_KS)) + (size_t)lb * (WBUF * ROWV) + e); } } } }
#endif
}

template <int MODE, int K, int N>
__device__ __forceinline__ void sgemv(Frame& F, const float* A, const bf16* Wt, float* out, float* yout) {
    constexpr int NPW = N / 256, NG = (NPW + 15) / 16, KW = K / 8, STEPS = KW / 32;
    LAS float* red = (LAS float*)F.lds;
    LAS float* sq = (LAS float*)(F.lds + 8 * NG * 1024);
    const int lane = F.lane, wv = F.wave, fr = lane & 15, fq = lane >> 4;
    const int n0 = (F.vcu & 255) * NPW;
    {
        f32x4 acc[NG];
#pragma unroll
        for (int g = 0; g < NG; ++g) acc[g] = (f32x4){0.f, 0.f, 0.f, 0.f};
        float ssq = 0.f;
        const float* ap = A + (size_t)(fr & 7) * K + wv * KW + fq * 8;
        const bf16* wp[NG];
#pragma unroll
        for (int g = 0; g < NG; ++g) { const int nl = 16 * g + fr; wp[g] = Wt + (size_t)(n0 + (nl < NPW ? nl : NPW - 1)) * K + wv * KW + fq * 8; }
#pragma unroll 16
        for (int s = 0; s < STEPS; ++s) {
            v4u yw = {0u, 0u, 0u, 0u};
            if (fr < 8) { const f32x4 a0 = *(const f32x4*)(ap + 32 * s), a1 = *(const f32x4*)(ap + 32 * s + 4); yw = pack8(a0, a1);
                ssq += ((a0[0] * a0[0] + a0[1] * a0[1]) + (a0[2] * a0[2] + a0[3] * a0[3])) + ((a1[0] * a1[0] + a1[1] * a1[1]) + (a1[2] * a1[2] + a1[3] * a1[3])); }
#pragma unroll
            for (int g = 0; g < NG; ++g) { const bf16x8 X = *(const bf16x8*)(wp[g] + 32 * s); acc[g] = __builtin_amdgcn_mfma_f32_16x16x32_bf16(X, __builtin_bit_cast(bf16x8, yw), acc[g], 0, 0, 0); }
        }
#pragma unroll
        for (int g = 0; g < NG; ++g) *(LAS f32x4*)(red + (wv * NG + g) * 256 + lane * 4) = acc[g];
        if (MODE == 0 || MODE == 2) { ssq += __shfl_xor(ssq, 16); ssq += __shfl_xor(ssq, 32); if (lane < 8) sq[wv * 8 + lane] = ssq; }
    }
    float prev = 0.f;
    if ((MODE == 1 || MODE == 3) && F.tid < 8 * NPW) prev = out[(size_t)(F.tid & 7) * N + n0 + (F.tid >> 3)];
    WG_BAR();
    if (F.tid < 8 * NPW) {
        const int nl = F.tid >> 3, tok = F.tid & 7, g = nl >> 4, lp = ((nl & 15) >> 2) * 16 + tok, i = nl & 3;
        float v = 0.f;
#pragma unroll
        for (int ww = 0; ww < 8; ++ww) v += red[(ww * NG + g) * 256 + lp * 4 + i];
        float rs = 1.f;
        if (MODE == 0 || MODE == 2) { float q = 0.f;
#pragma unroll
            for (int ww = 0; ww < 8; ++ww) q += sq[ww * 8 + tok];
            rs = __builtin_amdgcn_rsqf(q * (1.0f / (float)K) + EPS); }
        float* op = out + (size_t)tok * N + n0 + nl;
        if (MODE == 0) *op = v * rs;
        else if (MODE == 2) { const float z = fmaxf(v * rs, 0.f); *op = z * z; }
        else { const float z = prev + v; *op = z; if (yout) yout[(size_t)tok * N + n0 + nl] = z; }
    }
}

constexpr int ATT_BT_BYTES = 48 * 192 * 4, ATT_V_BYTES = 32 * 192;
constexpr int NCP = 32;
__device__ __forceinline__ void attn_phase_prompt(Frame& F, unsigned char* w, float* out, int l, int mode = 3) {
    const int lane = F.lane, r = lane & 31, hh = lane >> 5;
    LAS float* btall = (LAS float*)F.lds;
    for (int e = F.tid; e < 48 * 192; e += NWAVES * 64) { const int t = e / 192, j = 160 - (e - t * 192); btall[e] = (j >= 0 && j <= 128) ? W_BT(w)[t * 129 + (j < 0 ? 0 : (j > 128 ? 128 : j))] : -1.0e30f; }
    WG_BAR();
    LAS unsigned char* vl = F.lds + ATT_BT_BYTES + F.wave * ATT_V_BYTES;
    const int trq = (lane & 15) >> 2, trp = lane & 3, g16 = (lane >> 4) & 1;
    LAS unsigned char* vtr0 = vl + (4 * hh + trq) * 192 + g16 * 32 + trp * 8;
    constexpr int NMOVE = ATT_NMOVE, NWORK = NWAVES - NMOVE;
    if (NMOVE > 0 && F.wave >= NWORK) {
        if (!(mode & 2)) return;
        const int mv = F.wave - NWORK;
        constexpr int CP_PER = (WBUF - 1) * 256, CP_HALF = SB * CP_PER, CP_TOT = 2 * CP_HALF, CP_ROWS = (CP_TOT + 63) / 64;
        for (int k0 = mv * NCP; k0 * F.G < CP_ROWS; k0 += (NMOVE > 0 ? NMOVE : 1) * NCP) {
            f32x4 cpv[NCP];
#pragma unroll
            for (int u = 0; u < NCP; ++u) { int ci = ((k0 + u) * F.G + F.vcu) * 64 + lane; ci = ci < CP_TOT ? ci : CP_TOT - 1;
                const int kv = ci >= CP_HALF, rr = ci - kv * CP_HALF, bb = rr / CP_PER, ee = rr - bb * CP_PER;
                cpv[u] = __builtin_nontemporal_load((const f32x4*)(kv ? F.state_v : F.state_k) + ((size_t)(l * SB + bb) * WBUF + 1) * 256 + ee); }
#pragma unroll
            for (int u = 0; u < NCP; ++u) { const int ci = ((k0 + u) * F.G + F.vcu) * 64 + lane;
                if (ci < CP_TOT) { const int kv = ci >= CP_HALF, rr = ci - kv * CP_HALF, bb = rr / CP_PER, ee = rr - bb * CP_PER;
                    __builtin_nontemporal_store(cpv[u], (f32x4*)(out + (kv ? O_VS : O_KS)) + ((size_t)(l * SB + bb) * WBUF) * 256 + ee); } }
        }
        return;
    }
    if (!(mode & 1)) return;
    const int ntile = (3 * (NB * H * 8) / F.G * 8 - F.wave + NWORK - 1) / NWORK;
#define TILE_SETUP(j_, C_, DSH_, RHO_, I0_, KB0_, HB_, BH_) do { const int t_ = F.wave + NWORK * (j_), i_ = t_ >> 3, c_ = i_ % 3, idx_ = (i_ / 3) * F.G + F.vcu; C_ = c_; DSH_ = 2 * c_; BH_ = idx_ >> 3; \
        const int f0_ = 256 * (idx_ & 7) + 32 * (t_ & 7); RHO_ = f0_ >> (11 - DSH_); I0_ = f0_ & ((2048 >> DSH_) - 1); KB0_ = I0_ >= 128 ? 0 : ((128 - I0_) >> 5); HB_ = (size_t)BH_ * 2048 * 64; } while (0)
#define LOAD_Q(QF, HB_, DSH_, RHO_, I0_) do { const char* qt_ = (const char*)(W_Q(w) + HB_ + (RHO_) * 64) + ((size_t)((I0_) << (DSH_))) * 128; const unsigned ql_ = ((unsigned)(r << (DSH_))) * 128u + 64u * hh; \
        _Pragma("unroll") for (int s = 0; s < 4; ++s) QF[s] = *(const bf16x8*)(qt_ + ql_ + 16 * s); } while (0)
#define LOAD_KV(KF, VV, kb_, HB_, DSH_, RHO_, I0_, KB0_) do { const int kbe_ = (kb_) < (KB0_) ? (KB0_) : (kb_); const size_t bo_ = ((size_t)(((I0_) - 128 + 32 * kbe_) << (DSH_))) * 128; \
        const char* kt_ = (const char*)(W_K(w) + HB_ + (RHO_) * 64) + bo_; const char* vt_ = (const char*)(W_V(w) + HB_ + (RHO_) * 64) + bo_; \
        const unsigned kl_ = ((unsigned)(r << (DSH_))) * 128u + 64u * hh, vl_ = ((unsigned)((lane >> 3) << (DSH_))) * 128u + 16u * (lane & 7), vs_ = (8u << (DSH_)) * 128u; \
        _Pragma("unroll") for (int s = 0; s < 4; ++s) KF[s] = *(const bf16x8*)(kt_ + kl_ + 16 * s); \
        _Pragma("unroll") for (int c4 = 0; c4 < 4; ++c4) VV[c4] = *(const v4u*)(vt_ + vl_ + c4 * vs_); } while (0)
#define VTR(p) __builtin_bit_cast(s16x4, __builtin_amdgcn_ds_read_tr16_b64_v4i16((LAS s16x4*)(p)))
#define VFRAG(db, s) ({ const s16x4 lo_ = VTR(vtr0 + (16 * (s)) * 192 + (db) * 64), hi_ = VTR(vtr0 + (16 * (s) + 8) * 192 + (db) * 64); (bf16x8){lo_[0], lo_[1], lo_[2], lo_[3], hi_[0], hi_[1], hi_[2], hi_[3]}; })
#define ATT_COMPUTE(KF, VV, kb_) do { \
        _Pragma("unroll") for (int c4 = 0; c4 < 4; ++c4) *(LAS v4u*)(vl + ((lane >> 3) + 8 * c4) * 192 + (lane & 7) * 16) = VV[c4]; \
        const int bidx = 32 - r + 4 * hh + 32 * (kb_);            \
        f32x16 sT; _Pragma("unroll") for (int k = 0; k < 16; ++k) sT[k] = bt[bidx + (k & 3) + 8 * (k >> 2)];        \
        _Pragma("unroll") for (int s = 0; s < 4; ++s) sT = __builtin_amdgcn_mfma_f32_32x32x16_bf16(KF[s], qf[s], sT, 0, 0, 0); \
        asm volatile("s_nop 15\n\ts_nop 7" : "+v"(sT));            \
        float mx = max3f(max3f(sT[0], sT[1], sT[2]), max3f(sT[3], sT[4], sT[5]), max3f(sT[6], sT[7], sT[8])); \
        mx = max3f(mx, max3f(sT[9], sT[10], sT[11]), max3f(sT[12], sT[13], max3f(sT[14], sT[15], sT[15]))); \
        mx = max3f(mx, __shfl_xor(mx, 32), mx); \
        if (__any(mx > m_run + 8.0f)) {                            \
            const float m_new = max3f(m_run, mx, mx), alpha = __builtin_amdgcn_exp2f(m_run - m_new); m_run = m_new; l_run *= alpha; \
            _Pragma("unroll") for (int k = 0; k < 16; ++k) { o0[k] *= alpha; o1[k] *= alpha; } } \
        _Pragma("unroll") for (int k = 0; k < 16; ++k) sT[k] = __builtin_amdgcn_exp2f(sT[k] - m_run); \
        l_run += (((sT[0] + sT[1]) + (sT[2] + sT[3])) + ((sT[4] + sT[5]) + (sT[6] + sT[7]))) + (((sT[8] + sT[9]) + (sT[10] + sT[11])) + ((sT[12] + sT[13]) + (sT[14] + sT[15]))); \
        v4u pw0, pw1; \
        pw0.x = cvt_pk_bf16(sT[0], sT[1]); pw0.y = cvt_pk_bf16(sT[2], sT[3]); pw0.z = cvt_pk_bf16(sT[4], sT[5]); pw0.w = cvt_pk_bf16(sT[6], sT[7]); \
        pw1.x = cvt_pk_bf16(sT[8], sT[9]); pw1.y = cvt_pk_bf16(sT[10], sT[11]); pw1.z = cvt_pk_bf16(sT[12], sT[13]); pw1.w = cvt_pk_bf16(sT[14], sT[15]); \
        const bf16x8 pk0 = __builtin_bit_cast(bf16x8, pw0), pk1 = __builtin_bit_cast(bf16x8, pw1); \
        const bf16x8 v00 = VFRAG(0, 0), v01 = VFRAG(0, 1), v10 = VFRAG(1, 0), v11 = VFRAG(1, 1); \
        o0 = __builtin_amdgcn_mfma_f32_32x32x16_bf16(v00, pk0, o0, 0, 0, 0); o0 = __builtin_amdgcn_mfma_f32_32x32x16_bf16(v01, pk1, o0, 0, 0, 0); \
        o1 = __builtin_amdgcn_mfma_f32_32x32x16_bf16(v10, pk0, o1, 0, 0, 0); o1 = __builtin_amdgcn_mfma_f32_32x32x16_bf16(v11, pk1, o1, 0, 0, 0); } while (0)
    int c, dsh, rho, i0, kb0, bh; size_t hb;
    TILE_SETUP(0, c, dsh, rho, i0, kb0, hb, bh);
    bf16x8 qf[4], kA[4], kB[4]; v4u vA[4];
    LOAD_Q(qf, hb, dsh, rho, i0);
    { v4u vdummy[4]; LOAD_KV(kA, vA, 0, hb, dsh, rho, i0, kb0); LOAD_KV(kB, vdummy, 1, hb, dsh, rho, i0, kb0); (void)vdummy; }
    for (int i = 0; i < ntile; ++i) {
        int c2 = 0, dsh2 = 0, rho2 = 0, i02 = 0, kb02 = 0, bh2 = 0; size_t hb2 = 0; const bool has_next = i + 1 < ntile;
        if (has_next) TILE_SETUP(i + 1, c2, dsh2, rho2, i02, kb02, hb2, bh2);
        const LAS float* bt = btall + (c * 16 + (bh & 15)) * 192;
        float m_run = -1.0e30f, l_run = 0.f;
        f32x16 o0, o1;
#pragma unroll
        for (int k = 0; k < 16; ++k) { o0[k] = 0.f; o1[k] = 0.f; }
        bf16x8 kC[4], kD[4], kE[4]; v4u vB[4], vC[4], vD[4], vE[4];
#define SB0() __builtin_amdgcn_sched_barrier(0)
#define LOAD_K(KF, kb_, HB_, DSH_, RHO_, I0_, KB0_) do { const int kbe_ = (kb_) < (KB0_) ? (KB0_) : (kb_); const char* kt_ = (const char*)(W_K(w) + HB_ + (RHO_) * 64) + ((size_t)(((I0_) - 128 + 32 * kbe_) << (DSH_))) * 128; \
        const unsigned kl_ = ((unsigned)(r << (DSH_))) * 128u + 64u * hh; if (!(mode & 8)) { _Pragma("unroll") for (int s = 0; s < 4; ++s) KF[s] = *(const bf16x8*)(kt_ + kl_ + 16 * s); } } while (0)
#define LOAD_V(VV, kb_, HB_, DSH_, RHO_, I0_, KB0_) do { const int kbe_ = (kb_) < (KB0_) ? (KB0_) : (kb_); const char* vt_ = (const char*)(W_V(w) + HB_ + (RHO_) * 64) + ((size_t)(((I0_) - 128 + 32 * kbe_) << (DSH_))) * 128; \
        const unsigned vl_ = ((unsigned)((lane >> 3) << (DSH_))) * 128u + 16u * (lane & 7), vs_ = (8u << (DSH_)) * 128u; if (!(mode & 8)) { _Pragma("unroll") for (int c4 = 0; c4 < 4; ++c4) VV[c4] = *(const v4u*)(vt_ + vl_ + c4 * vs_); } } while (0)
        SB0(); LOAD_K(kC, 2, hb, dsh, rho, i0, kb0); LOAD_V(vB, 1, hb, dsh, rho, i0, kb0); SB0();
        if (kb0 <= 0) ATT_COMPUTE(kA, vA, 0);
        SB0(); LOAD_K(kD, 3, hb, dsh, rho, i0, kb0); LOAD_V(vC, 2, hb, dsh, rho, i0, kb0); SB0();
        if (kb0 <= 1) ATT_COMPUTE(kB, vB, 1);
        SB0(); LOAD_K(kE, 4, hb, dsh, rho, i0, kb0); LOAD_V(vD, 3, hb, dsh, rho, i0, kb0); SB0();
        if (kb0 <= 2) ATT_COMPUTE(kC, vC, 2);
        SB0(); if (has_next) LOAD_K(kA, 0, hb2, dsh2, rho2, i02, kb02); LOAD_V(vE, 4, hb, dsh, rho, i0, kb0); SB0();
        if (kb0 <= 3) ATT_COMPUTE(kD, vD, 3);
        SB0(); if (has_next) { LOAD_K(kB, 1, hb2, dsh2, rho2, i02, kb02); LOAD_V(vA, 0, hb2, dsh2, rho2, i02, kb02); } SB0();
        ATT_COMPUTE(kE, vE, 4);
        SB0(); if (has_next) LOAD_Q(qf, hb2, dsh2, rho2, i02); SB0();
#undef SB0
#undef LOAD_K
#undef LOAD_V
        const float l_tot = l_run + __shfl_xor(l_run, 32);
        const int grow = (bh >> 4) * 2048 + (((i0 + r) << dsh) + rho);
#pragma unroll
        for (int g4 = 0; g4 < 4; ++g4) {
            v2u a, b2; a.x = cvt_pk_bf16(o0[4 * g4], o0[4 * g4 + 1]); a.y = cvt_pk_bf16(o0[4 * g4 + 2], o0[4 * g4 + 3]); b2.x = cvt_pk_bf16(o1[4 * g4], o1[4 * g4 + 1]); b2.y = cvt_pk_bf16(o1[4 * g4 + 2], o1[4 * g4 + 3]);
            *(LAS v2u*)(vl + r * 144 + (8 * g4 + 4 * hh) * 2) = a; *(LAS v2u*)(vl + r * 144 + (32 + 8 * g4 + 4 * hh) * 2) = b2;
        }
#pragma unroll
        for (int q4 = 0; q4 < 4; ++q4) { const int rq = q4 * 8 + (lane >> 3), ch = lane & 7;
            const v4u v = *(const LAS v4u*)(vl + rq * 144 + ch * 16);
            const int grow_q = (bh >> 4) * 2048 + (((i0 + rq) << dsh) + rho);
            if (!(mode & 16)) *(v4u*)(W_OPB(w) + ((size_t)c * M + grow_q) * 1024 + (bh & 15) * 64 + ch * 8) = v; }
        if (hh == 0 && !(mode & 16)) *(f32x2*)(W_ML(w) + (((size_t)c * M + grow) * 16 + (bh & 15)) * 2) = (f32x2){m_run, l_tot};
        c = c2; dsh = dsh2; rho = rho2; i0 = i02; kb0 = kb02; hb = hb2; bh = bh2;
    }
#undef ATT_COMPUTE
#undef VFRAG
#undef VTR
#undef TILE_SETUP
#undef LOAD_Q
#undef LOAD_KV
}

__device__ __forceinline__ int conv_ticket(LAS unsigned* q, int lane) {
    unsigned v = 0u;
    if (lane == 0) v = __hip_atomic_fetch_add(q, 1u, __ATOMIC_RELAXED, __HIP_MEMORY_SCOPE_WORKGROUP);
    return (int)__builtin_amdgcn_readfirstlane(v);
}
__device__ __forceinline__ void conv_run_dyn(const Args& A, unsigned char* w, int stage, int vcu, int G, int lane, LAS float* scr, LAS unsigned* q) {
    const int nk0 = conv_count(stage) / G, hasS = (2 * SB * H == G) ? (vcu < SB * H) : -1;
    const int nk = hasS < 0 ? nk0 : (hasS ? nk0 - CONV_SKEW : nk0 + CONV_SKEW), base = hasS < 0 ? vcu * nk0 : (hasS ? vcu * (nk0 - CONV_SKEW) : SB * H * (nk0 - CONV_SKEW) + (vcu - SB * H) * (nk0 + CONV_SKEW));
    P0Item dc, dn; f32x4 vc[8], vn[8]; float gc = 1.f, gn = 1.f;
    int k = conv_ticket(q, lane);
    if (k < nk) { p0_item_desc(A, w, stage, base + k, dc); p0_item_load(dc, lane, vc, gc); }
    while (k < nk) {
        const int k2 = conv_ticket(q, lane);
        if (k2 < nk) { p0_item_desc(A, w, stage, base + k2, dn); p0_item_load(dn, lane, vn, gn); }
        p0_item_store(dc, lane, vc, gc, scr);
        if (k2 < nk) { dc = dn; gc = gn;
#pragma unroll
            for (int i = 0; i < 8; ++i) vc[i] = vn[i]; }
        k = k2;
    }
}

__device__ __forceinline__ void att4_wait(volatile LAS unsigned* p, unsigned target);
__device__ __forceinline__ void team_bar(LAS unsigned* cnt, unsigned& epoch, int lane) {
    asm volatile("s_waitcnt vmcnt(0) lgkmcnt(0)" ::: "memory");
    if (lane == 0) (void)__hip_atomic_fetch_add(cnt, 1u, __ATOMIC_RELAXED, __HIP_MEMORY_SCOPE_WORKGROUP);
    ++epoch;
    att4_wait((volatile LAS unsigned*)cnt, 4u * epoch);
}
__device__ __forceinline__ void attn_sample_team(Frame& F, unsigned char* w, float* out, int l, int b, int h, int wv, LAS unsigned* tcnt) {
    LAS float* sm = (LAS float*)F.lds;
    const int lane = F.lane, t = wv * 64 + lane;
    unsigned epoch = 0u;
    const float* ps = W_PS(w) + (size_t)b * DIN;
    const size_t sbase = ((size_t)(l * SB + b) * WBUF) * 1024 + h * 64;
    const int e0 = t, c0 = e0 / 129, j0 = e0 - c0 * 129;
    f32x4 kreg[16];
    { const f32x4* kr = (const f32x4*)(F.state_k + sbase + (size_t)(j0 == 0 ? WBUF - 1 : WBUF - (j0 << (2 * c0))) * 1024);
#pragma unroll
      for (int d4 = 0; d4 < 16; ++d4) kreg[d4] = kr[d4]; }
    if (wv == 0) {
        const float qr = ps[h * 64 + lane], kr = ps[1024 + h * 64 + lane], vr = ps[2048 + h * 64 + lane];
        const float sq = wave_sum(qr * qr), sk = wave_sum(kr * kr);
        const float* gn = W_GN(w) + l * 128;
        const float qn = qr * __builtin_amdgcn_rsqf(sq * (1.0f / 64.0f) + EPS) * gn[lane] * QSCALE;
        const float kn = kr * __builtin_amdgcn_rsqf(sk * (1.0f / 64.0f) + EPS) * gn[64 + lane];
        sm[lane] = qn; sm[64 + lane] = kn; sm[128 + lane] = vr;
        out[O_KS + sbase + (size_t)(WBUF - 1) * 1024 + lane] = kn;
        out[O_VS + sbase + (size_t)(WBUF - 1) * 1024 + lane] = vr;
    }
    team_bar(tcnt, epoch, lane);
    {   float a = 0.f;
#pragma unroll
        for (int d4 = 0; d4 < 16; ++d4) { const f32x4 q4 = *(const LAS f32x4*)(sm + 4 * d4); f32x4 kv = kreg[d4]; if (j0 == 0) kv = *(const LAS f32x4*)(sm + 64 + 4 * d4);
            a += (kv[0] * q4[0] + kv[1] * q4[1]) + (kv[2] * q4[2] + kv[3] * q4[3]); }
        sm[192 + e0] = a + W_BT(w)[(c0 * 16 + h) * 129 + j0];
    }
    if (t + 256 < 387) {
        const int e1 = t + 256, c1 = e1 / 129, j1 = e1 - c1 * 129;
        const f32x4* kr = (const f32x4*)(F.state_k + sbase + (size_t)(j1 == 0 ? WBUF - 1 : WBUF - (j1 << (2 * c1))) * 1024);
        float a = 0.f;
#pragma unroll
        for (int d4 = 0; d4 < 16; ++d4) { const f32x4 q4 = *(const LAS f32x4*)(sm + 4 * d4); f32x4 kv = kr[d4]; if (j1 == 0) kv = *(const LAS f32x4*)(sm + 64 + 4 * d4);
            a += (kv[0] * q4[0] + kv[1] * q4[1]) + (kv[2] * q4[2] + kv[3] * q4[3]); }
        sm[192 + e1] = a + W_BT(w)[(c1 * 16 + h) * 129 + j1];
    }
    const int kg = t >> 4, dq = t & 15;
    f32x4 vreg[13];
#pragma unroll
    for (int i = 0; i < 13; ++i) { int ee = kg + 16 * i; const int cc = ee / 129, jj = ee - cc * 129;
        vreg[i] = *(const f32x4*)(F.state_v + sbase + (size_t)(jj == 0 ? WBUF - 1 : WBUF - (jj << (2 * cc))) * 1024 + dq * 4); }
    team_bar(tcnt, epoch, lane);
    float mx = -1.0e30f;
    for (int x = lane; x < 387; x += 64) mx = fmaxf(mx, sm[192 + x]);
    mx = wave_max(mx);
    float sum = 0.f;
    for (int x = lane; x < 387; x += 64) sum += __builtin_amdgcn_exp2f(sm[192 + x] - mx);
    sum = wave_sum(sum);
    f32x4 o = {0.f, 0.f, 0.f, 0.f};
#pragma unroll
    for (int i = 0; i < 13; ++i) { const int ee = kg + 16 * i;
        const float p = __builtin_amdgcn_exp2f(sm[192 + ee] - mx); f32x4 vv = vreg[i]; if (ee == 0 || ee == 129 || ee == 258) vv = *(const LAS f32x4*)(sm + 128 + dq * 4); o += vv * p; }
#pragma unroll
    for (int i = 13; i < 25; ++i) { int ee = kg + 16 * i; if (ee < 387) { const int cc = ee / 129, jj = ee - cc * 129;
        f32x4 vv = *(const f32x4*)(F.state_v + sbase + (size_t)(jj == 0 ? WBUF - 1 : WBUF - (jj << (2 * cc))) * 1024 + dq * 4);
        if (jj == 0) vv = *(const LAS f32x4*)(sm + 128 + dq * 4);
        o += vv * __builtin_amdgcn_exp2f(sm[192 + ee] - mx); } }
    *(LAS f32x4*)(sm + 1024 + kg * 64 + dq * 4) = o;
    team_bar(tcnt, epoch, lane);
    if (t < 64) {
        float tt = 0.f;
#pragma unroll
        for (int g = 0; g < 16; ++g) tt += sm[1024 + g * 64 + t];
        W_OS(w)[(size_t)b * 1024 + h * 64 + t] = tt / sum;
    }
}

constexpr int ATT4_BT = 6 * 192 * 4, ATT4_IMG = ATT4_BT, ATT4_STG = ATT4_IMG + 8 * 8192, ATT4_SYNC = ATT4_STG + 4 * 4608, ATT4_CONV = ATT4_SYNC + 256;
static_assert(ATT4_CONV + 4 * 8448 <= LDSCTL_OFF, "LDS map (attention v4)");
__device__ __forceinline__ void att4_wait(volatile LAS unsigned* p, unsigned target) {
    for (unsigned sp = 0; *p < target && sp < (1u << 22); ++sp) __builtin_amdgcn_s_sleep(1);
    asm volatile("" ::: "memory");
}
__device__ __forceinline__ void att4_signal(LAS unsigned* p, int lane) {
    asm volatile("s_waitcnt lgkmcnt(0)" ::: "memory");
    if (lane == 0) (void)__hip_atomic_fetch_add(p, 1u, __ATOMIC_RELAXED, __HIP_MEMORY_SCOPE_WORKGROUP);
    asm volatile("" ::: "memory");
}
__device__ __forceinline__ void attn_phase_prompt4(Frame& F, const Args& A, unsigned char* w, float* out, int l) {
    const int lane = F.lane, r = lane & 31, hh = lane >> 5;
    LAS float* btall = (LAS float*)F.lds;
    for (int e = F.tid; e < 6 * 192; e += NWAVES * 64) { const int t = e / 192, j = 160 - (e - t * 192), hh_ = ((((t / 3) * F.G + F.vcu) >> 3) & 15);
        btall[e] = (j >= 0 && j <= 128) ? W_BT(w)[((t % 3) * 16 + hh_) * 129 + (j < 0 ? 0 : (j > 128 ? 128 : j))] : -1.0e30f; }
    LAS unsigned* sync = (LAS unsigned*)(F.lds + ATT4_SYNC);
    if (F.tid == 0) { sync[0] = 0u; sync[16] = 0u; sync[32] = 0u; sync[48] = 0u; }
#if CONV_RING
    conv_fill_gains(A, 1 + l, (LAS float*)(F.lds + ATT4_CONV), F.tid);
#endif
    WG_BAR();
    constexpr int NWORK = 4, NMOVE = ATT4_MOVERS;
    if (F.wave >= NWORK) {
        const int mv = F.wave - NWORK;
        constexpr int CP_PER = (WBUF - 1) * 256, CP_HALF = SB * CP_PER, CP_TOT = 2 * CP_HALF, CP_ROWS = (CP_TOT + 63) / 64;
        for (int bt_ = F.vcu * NMOVE + mv; (!COPY_IN_G4 || COPY_BOTH) && bt_ * NCP < CP_ROWS; bt_ += F.G * NMOVE) {
            const int k0 = bt_ * NCP;
            f32x4 cpv[NCP];
#pragma unroll
            for (int u = 0; u < NCP; ++u) { int ci = (k0 + u) * 64 + lane; ci = ci < CP_TOT ? ci : CP_TOT - 1;
                const int kv = ci >= CP_HALF, rr = ci - kv * CP_HALF, bb = rr / CP_PER, ee = rr - bb * CP_PER;
                cpv[u] = __builtin_nontemporal_load((const f32x4*)(kv ? F.state_v : F.state_k) + ((size_t)(l * SB + bb) * WBUF + 1) * 256 + ee); }
#pragma unroll
            for (int u = 0; u < NCP; ++u) { const int ci = (k0 + u) * 64 + lane;
                if (ci < CP_TOT) { const int kv = ci >= CP_HALF, rr = ci - kv * CP_HALF, bb = rr / CP_PER, ee = rr - bb * CP_PER;
                    __builtin_nontemporal_store(cpv[u], (f32x4*)(out + (kv ? O_VS : O_KS)) + ((size_t)(l * SB + bb) * WBUF) * 256 + ee); } }
        }
#if CONV_RING
        conv_ring<CONV_DP>(A, w, 1 + l, F.vcu, F.G, lane, (const LAS float*)(F.lds + ATT4_CONV), sync + 48, F.vcu * NWAVES + F.wave);
#else
        conv_run_dyn(A, w, 1 + l, F.vcu, F.G, lane, (LAS float*)(F.lds + ATT4_CONV + mv * 8448), sync + 48);
#endif
        return;
    }
    const int wv = F.wave;
    LAS unsigned char* img = F.lds + ATT4_IMG;
    LAS unsigned char* stg = F.lds + ATT4_STG + wv * 4608;
    const int trq = (lane & 15) >> 2, trp = lane & 3, g16 = (lane >> 4) & 1, rsw = 4 * hh + trq;
    const int vt0 = rsw * 128 + (((2 * g16 + (trp >> 1)) ^ rsw) * 16) + 8 * (trp & 1), vt1 = rsw * 128 + (((4 + 2 * g16 + (trp >> 1)) ^ rsw) * 16) + 8 * (trp & 1);
    int koff[4];
#pragma unroll
    for (int s = 0; s < 4; ++s) koff[s] = r * 128 + (((4 * hh + s) ^ (r & 7)) * 16);
    const int rib = 8 * wv + (lane >> 3), woff = rib * 128 + (((lane & 7) ^ (rib & 7)) * 16);
#define UNIT_SETUP(mu_, C_, DSH_, RHO_, RB_, JV_, HB_, BH_, PAIR_) do { const int u_ = (mu_) < 5 ? (mu_) : (mu_) + 1; PAIR_ = ((mu_) == 4 || (mu_) == 9); \
        const int i_ = u_ >> 1, c_ = i_ % 3, idx_ = (i_ / 3) * F.G + F.vcu; C_ = c_; DSH_ = 2 * c_; BH_ = idx_ >> 3; \
        const int f0_ = 256 * (idx_ & 7) + 128 * (u_ & 1); RHO_ = f0_ >> (11 - DSH_); RB_ = f0_ & ((2048 >> DSH_) - 1); JV_ = RB_ == 0 ? 4 : 0; HB_ = (size_t)BH_ * 2048 * 64; } while (0)
#define UNIT_LOAD(KP, VP, QF, QFB, DSH_, RHO_, RB_, JV_, HB_, PAIR_) do { \
        _Pragma("unroll") for (int n = 0; n < 8; ++n) { \
            if (n >= (JV_)) { const size_t eo_ = HB_ + (size_t)((((RB_) - 128 + 32 * n + rib) << (DSH_)) + (RHO_)) * 64 + (lane & 7) * 8; KP[n] = *(const v4u*)(W_K(w) + eo_); VP[n] = *(const v4u*)(W_V(w) + eo_); } \
            else if (PAIR_) { const size_t eo_ = HB_ + (size_t)(((32 * n + rib) << (DSH_)) + (RHO_) + 1) * 64 + (lane & 7) * 8; KP[n] = *(const v4u*)(W_K(w) + eo_); VP[n] = *(const v4u*)(W_V(w) + eo_); } } \
        { const bf16* qp_ = W_Q(w) + HB_ + (size_t)((((RB_) + 32 * wv + r) << (DSH_)) + (RHO_)) * 64 + 32 * hh; _Pragma("unroll") for (int s = 0; s < 4; ++s) QF[s] = *(const bf16x8*)(qp_ + 8 * s); } \
        if (PAIR_) { const bf16* qp_ = W_Q(w) + HB_ + (size_t)(((32 * (3 - wv) + r) << (DSH_)) + (RHO_) + 1) * 64 + 32 * hh; _Pragma("unroll") for (int s = 0; s < 4; ++s) QFB[s] = *(const bf16x8*)(qp_ + 8 * s); } } while (0)
    int c, dsh, rho, rb, jv, bh, pair; size_t hb;
    UNIT_SETUP(0, c, dsh, rho, rb, jv, hb, bh, pair);
    int lo = jv, so = 0;
    v4u kp[8], vp[8]; bf16x8 qf[4], qfb[4];
#pragma unroll
    for (int n = 0; n < 8; ++n) { kp[n] = (v4u){0u, 0u, 0u, 0u}; vp[n] = (v4u){0u, 0u, 0u, 0u}; }
#pragma unroll
    for (int s = 0; s < 4; ++s) qfb[s] = (bf16x8){0, 0, 0, 0, 0, 0, 0, 0};
    UNIT_LOAD(kp, vp, qf, qfb, dsh, rho, rb, lo, hb, pair);
    constexpr unsigned NUNIT = 10;
    int pc = 0, pdsh = 0, prho = 0, pbh = 0, pi0 = 0; float pm = 0.f, pl = 0.f;
#define UNIT_FLUSH() do { \
        _Pragma("unroll") for (int q4 = 0; q4 < 4; ++q4) { const int rq = q4 * 8 + (lane >> 3), ch = lane & 7; \
            const v4u v = *(const LAS v4u*)(stg + rq * 144 + ch * 16); \
            const int grow_q = (pbh >> 4) * 2048 + (((pi0 + rq) << pdsh) + prho); \
            *(v4u*)(W_OPB(w) + ((size_t)pc * M + grow_q) * 1024 + (pbh & 15) * 64 + ch * 8) = v; } \
        if (hh == 0) *(f32x2*)(W_ML(w) + (((size_t)pc * M + (pbh >> 4) * 2048 + (((pi0 + r) << pdsh) + prho)) * 16 + (pbh & 15)) * 2) = (f32x2){pm, pl}; } while (0)
#define VTR(p) __builtin_bit_cast(s16x4, __builtin_amdgcn_ds_read_tr16_b64_v4i16((LAS s16x4*)(p)))
#define VFRAG4(VT_, s) ({ const s16x4 lo_ = VTR(vb_ + (16 * (s)) * 128 + (VT_)), hi_ = VTR(vb_ + (16 * (s) + 8) * 128 + (VT_)); (bf16x8){lo_[0], lo_[1], lo_[2], lo_[3], hi_[0], hi_[1], hi_[2], hi_[3]}; })
#define TILE_RUN(WQ_, SOFF_, JVV_, QC_, RHO_T_) do { \
        float m_run = -1.0e30f, l_run = 0.f; \
        f32x16 o0, o1; \
        _Pragma("unroll") for (int k = 0; k < 16; ++k) { o0[k] = 0.f; o1[k] = 0.f; } \
        _Pragma("unroll") for (int jj = 0; jj < 5; ++jj) { \
            const int j = (WQ_) + jj; \
            if (j >= (JVV_)) { \
                const LAS unsigned char* kb_ = img + ((j + (SOFF_) + so) & 7) * 8192; const LAS unsigned char* vb_ = kb_ + 4096; \
                bf16x8 kf[4]; \
                _Pragma("unroll") for (int s = 0; s < 4; ++s) kf[s] = *(const LAS bf16x8*)(kb_ + koff[s]); \
                const int bidx = 32 - r + 4 * hh + 32 * jj; \
                f32x16 sT; \
                _Pragma("unroll") for (int k = 0; k < 16; ++k) sT[k] = bt[bidx + (k & 3) + 8 * (k >> 2)]; \
                _Pragma("unroll") for (int s = 0; s < 4; ++s) sT = __builtin_amdgcn_mfma_f32_32x32x16_bf16(kf[s], QC_[s], sT, 0, 0, 0); \
                asm volatile("s_nop 15\n\ts_nop 7" : "+v"(sT)); \
                float mx = max3f(max3f(sT[0], sT[1], sT[2]), max3f(sT[3], sT[4], sT[5]), max3f(sT[6], sT[7], sT[8])); \
                mx = max3f(mx, max3f(sT[9], sT[10], sT[11]), max3f(sT[12], sT[13], max3f(sT[14], sT[15], sT[15]))); \
                asm volatile("s_nop 1" : "+v"(mx));        \
                { const unsigned mb_ = __builtin_bit_cast(unsigned, mx); const auto sw_ = __builtin_amdgcn_permlane32_swap(mb_, mb_, false, false);        \
                  const unsigned s0_ = sw_[0], s1_ = sw_[1];        \
                  mx = max3f(__builtin_bit_cast(float, s0_), __builtin_bit_cast(float, s1_), __builtin_bit_cast(float, s1_)); } \
                if (__any(mx > m_run + 8.0f)) { \
                    const float m_new = max3f(m_run, mx, mx), alpha = __builtin_amdgcn_exp2f(m_run - m_new); m_run = m_new; l_run *= alpha; \
                    _Pragma("unroll") for (int k = 0; k < 16; ++k) { o0[k] *= alpha; o1[k] *= alpha; } } \
                _Pragma("unroll") for (int k = 0; k < 16; ++k) sT[k] = __builtin_amdgcn_exp2f(sT[k] - m_run); \
                l_run += (((sT[0] + sT[1]) + (sT[2] + sT[3])) + ((sT[4] + sT[5]) + (sT[6] + sT[7]))) + (((sT[8] + sT[9]) + (sT[10] + sT[11])) + ((sT[12] + sT[13]) + (sT[14] + sT[15]))); \
                v4u pw0, pw1; \
                pw0.x = cvt_pk_bf16(sT[0], sT[1]); pw0.y = cvt_pk_bf16(sT[2], sT[3]); pw0.z = cvt_pk_bf16(sT[4], sT[5]); pw0.w = cvt_pk_bf16(sT[6], sT[7]); \
                pw1.x = cvt_pk_bf16(sT[8], sT[9]); pw1.y = cvt_pk_bf16(sT[10], sT[11]); pw1.z = cvt_pk_bf16(sT[12], sT[13]); pw1.w = cvt_pk_bf16(sT[14], sT[15]); \
                const bf16x8 pk0 = __builtin_bit_cast(bf16x8, pw0), pk1 = __builtin_bit_cast(bf16x8, pw1); \
                  \
                const bf16x8 v00 = VFRAG4(vt0, 0), v01 = VFRAG4(vt0, 1), v10 = VFRAG4(vt1, 0), v11 = VFRAG4(vt1, 1); \
                o0 = __builtin_amdgcn_mfma_f32_32x32x16_bf16(v00, pk0, o0, 0, 0, 0); o0 = __builtin_amdgcn_mfma_f32_32x32x16_bf16(v01, pk1, o0, 0, 0, 0); \
                o1 = __builtin_amdgcn_mfma_f32_32x32x16_bf16(v10, pk0, o1, 0, 0, 0); o1 = __builtin_amdgcn_mfma_f32_32x32x16_bf16(v11, pk1, o1, 0, 0, 0); \
            } \
        } \
          \
        _Pragma("unroll") for (int g4 = 0; g4 < 4; ++g4) { \
            v2u a, b2; a.x = cvt_pk_bf16(o0[4 * g4], o0[4 * g4 + 1]); a.y = cvt_pk_bf16(o0[4 * g4 + 2], o0[4 * g4 + 3]); b2.x = cvt_pk_bf16(o1[4 * g4], o1[4 * g4 + 1]); b2.y = cvt_pk_bf16(o1[4 * g4 + 2], o1[4 * g4 + 3]); \
            *(LAS v2u*)(stg + r * 144 + (8 * g4 + 4 * hh) * 2) = a; *(LAS v2u*)(stg + r * 144 + (32 + 8 * g4 + 4 * hh) * 2) = b2; } \
        pc = c; pdsh = dsh; prho = (RHO_T_); pbh = bh; pi0 = rb + 32 * (WQ_); pm = m_run; \
        { const unsigned lb_ = __builtin_bit_cast(unsigned, l_run); const auto sw_ = __builtin_amdgcn_permlane32_swap(lb_, lb_, false, false); const unsigned s0_ = sw_[0], s1_ = sw_[1]; \
          pl = __builtin_bit_cast(float, s0_) + __builtin_bit_cast(float, s1_); } } while (0)
    for (int u = 0; u < (int)NUNIT; ++u) {
        att4_wait((volatile LAS unsigned*)(sync + 16), 4u * (unsigned)u);
#pragma unroll
        for (int n = 0; n < 8; ++n) if (n >= lo || pair) { LAS unsigned char* sl_ = img + ((n + so) & 7) * 8192 + woff; *(LAS v4u*)sl_ = kp[n]; *(LAS v4u*)(sl_ + 4096) = vp[n]; }
        bf16x8 qc[4];
#pragma unroll
        for (int s = 0; s < 4; ++s) qc[s] = qf[s];
        att4_signal(sync, lane);
        if (u > 0) UNIT_FLUSH();
        att4_wait((volatile LAS unsigned*)sync, 4u * (unsigned)(u + 1));
        int c2 = 0, dsh2 = 0, rho2 = 0, rb2 = 0, jv2 = 0, bh2 = 0, pair2 = 0, lo2 = 0, so2 = 0; size_t hb2 = 0;
        if (u + 1 < (int)NUNIT) { UNIT_SETUP(u + 1, c2, dsh2, rho2, rb2, jv2, hb2, bh2, pair2);
            const int reuse2 = (u + 1 == 1 || u + 1 == 3 || u + 1 == 6 || u + 1 == 8); lo2 = reuse2 ? 4 : jv2; so2 = reuse2 ? 4 : 0;
            UNIT_LOAD(kp, vp, qf, qfb, dsh2, rho2, rb2, lo2, hb2, pair2); }
        const LAS float* bt = btall + ((u < 5 ? u : u + 1) >> 1) * 192;
        TILE_RUN(wv, 0, jv, qc, rho);
        if (pair) { UNIT_FLUSH(); TILE_RUN(3 - wv, -4, 4, qfb, rho + 1); }
        att4_signal(sync + 16, lane);
        c = c2; dsh = dsh2; rho = rho2; rb = rb2; jv = jv2; hb = hb2; bh = bh2; pair = pair2; lo = lo2; so = so2;
    }
#undef TILE_RUN
#undef VFRAG4
#undef VTR
#undef UNIT_SETUP
#undef UNIT_LOAD
    UNIT_FLUSH();
#undef UNIT_FLUSH
    att4_wait((volatile LAS unsigned*)(sync + 16), 4u * NUNIT);
    if (F.vcu < SB * H) attn_sample_team(F, w, out, l, F.vcu >> 4, F.vcu & 15, wv, sync + 32);
#if CONV_RING
    conv_ring<CONV_DP>(A, w, 1 + l, F.vcu, F.G, lane, (const LAS float*)(F.lds + ATT4_CONV), sync + 48, F.vcu * NWAVES + F.wave);
#else
    conv_run_dyn(A, w, 1 + l, F.vcu, F.G, lane, (LAS float*)(img + 16384 + wv * 8448), sync + 48);
#endif
}

__device__ __forceinline__ void attn_sample_unit(Frame& F, unsigned char* w, float* out, int l, int b, int h) {
    LAS float* sm = (LAS float*)F.lds;
    const int lane = F.lane, wave = F.wave, tid = F.tid;
    const float* ps = W_PS(w) + (size_t)b * DIN;
    const size_t sbase = ((size_t)(l * SB + b) * WBUF) * 1024 + h * 64;
    const int e = tid < 387 ? tid : 386, ec = e / 129, ej = e - ec * 129;
    f32x4 kreg[16];
    { const f32x4* kr = (const f32x4*)(F.state_k + sbase + (size_t)(ej == 0 ? WBUF - 1 : WBUF - (ej << (2 * ec))) * 1024);
#pragma unroll
      for (int d4 = 0; d4 < 16; ++d4) kreg[d4] = kr[d4]; }
    const int kg = tid >> 4, dq = tid & 15;
    f32x4 vreg[13];
#pragma unroll
    for (int i = 0; i < 13; ++i) { int ee = kg + 32 * i; ee = ee < 387 ? ee : 386; const int cc = ee / 129, jj = ee - cc * 129;
        vreg[i] = *(const f32x4*)(F.state_v + sbase + (size_t)(jj == 0 ? WBUF - 1 : WBUF - (jj << (2 * cc))) * 1024 + dq * 4); }
    if (wave == 0) {
        const float qr = ps[h * 64 + lane], kr = ps[1024 + h * 64 + lane], vr = ps[2048 + h * 64 + lane];
        const float sq = wave_sum(qr * qr), sk = wave_sum(kr * kr);
        const float* gn = W_GN(w) + l * 128;
        const float qn = qr * __builtin_amdgcn_rsqf(sq * (1.0f / 64.0f) + EPS) * gn[lane] * QSCALE;
        const float kn = kr * __builtin_amdgcn_rsqf(sk * (1.0f / 64.0f) + EPS) * gn[64 + lane];
        sm[lane] = qn; sm[64 + lane] = kn; sm[128 + lane] = vr;
        out[O_KS + sbase + (size_t)(WBUF - 1) * 1024 + lane] = kn;
        out[O_VS + sbase + (size_t)(WBUF - 1) * 1024 + lane] = vr;
    }
    WG_BAR();
    if (tid < 387) {
        float a = 0.f;
#pragma unroll
        for (int d4 = 0; d4 < 16; ++d4) { const f32x4 q4 = *(const LAS f32x4*)(sm + 4 * d4); f32x4 kv = kreg[d4]; if (ej == 0) kv = *(const LAS f32x4*)(sm + 64 + 4 * d4);
            a += (kv[0] * q4[0] + kv[1] * q4[1]) + (kv[2] * q4[2] + kv[3] * q4[3]); }
        sm[192 + tid] = a + W_BT(w)[(ec * 16 + h) * 129 + ej];
    }
    WG_BAR();
    float mx = -1.0e30f;
    for (int t = lane; t < 387; t += 64) mx = fmaxf(mx, sm[192 + t]);
    mx = wave_max(mx);
    float sum = 0.f;
    for (int t = lane; t < 387; t += 64) sum += __builtin_amdgcn_exp2f(sm[192 + t] - mx);
    sum = wave_sum(sum);
    f32x4 o = {0.f, 0.f, 0.f, 0.f};
#pragma unroll
    for (int i = 0; i < 13; ++i) { const int ee = kg + 32 * i;
        if (ee < 387) { const float p = __builtin_amdgcn_exp2f(sm[192 + ee] - mx); f32x4 vv = vreg[i]; if (ee == 0 || ee == 129 || ee == 258) vv = *(const LAS f32x4*)(sm + 128 + dq * 4); o += vv * p; } }
    *(LAS f32x4*)(sm + 1024 + kg * 64 + dq * 4) = o;
    WG_BAR();
    if (tid < 64) {
        float t = 0.f;
#pragma unroll
        for (int g = 0; g < 32; ++g) t += sm[1024 + g * 64 + tid];
        W_OS(w)[(size_t)b * 1024 + h * 64 + tid] = t / sum;
    }
    WG_BAR();
}

__device__ __forceinline__ void mix_row_prompt(unsigned char* w, float* out, int lane, int l, int row) {
    const int b = row >> 11, t = row & 2047;
    { const int head = lane >> 2, dq = (lane & 3) * 16;
      float mm[3], ll[3];
#pragma unroll
      for (int c = 0; c < 3; ++c) { const f32x2 v = *(const f32x2*)(W_ML(w) + (((size_t)c * M + row) * 16 + head) * 2); mm[c] = v[0]; ll[c] = v[1]; }
      const float mx = fmaxf(fmaxf(mm[0], mm[1]), mm[2]);
      float wgt[3], den = 0.f;
#pragma unroll
      for (int c = 0; c < 3; ++c) { wgt[c] = __builtin_amdgcn_exp2f(mm[c] - mx); den += wgt[c] * ll[c]; }
      const float inv = 1.0f / den;
      f32x4 o[4];
#pragma unroll
      for (int k = 0; k < 4; ++k) o[k] = (f32x4){0.f, 0.f, 0.f, 0.f};
#pragma unroll
      for (int c = 0; c < 3; ++c) { const v4u* p = (const v4u*)(W_OPB(w) + ((size_t)c * M + row) * 1024 + head * 64 + dq); const float wc_ = wgt[c] * inv; const v4u p0 = p[0], p1 = p[1];
#pragma unroll
          for (int e = 0; e < 4; ++e) { const int k = e >> 1, x = (e & 1) * 2;
              o[k][x] += __uint_as_float(p0[e] << 16) * wc_; o[k][x + 1] += __uint_as_float(p0[e] & 0xffff0000u) * wc_;
              o[2 + k][x] += __uint_as_float(p1[e] << 16) * wc_; o[2 + k][x + 1] += __uint_as_float(p1[e] & 0xffff0000u) * wc_; } }
      float q = 0.f;
#pragma unroll
      for (int k = 0; k < 4; ++k) q += (o[k][0] * o[k][0] + o[k][1] * o[k][1]) + (o[k][2] * o[k][2] + o[k][3] * o[k][3]);
      q = wave_sum(q);
      const float rs = __builtin_amdgcn_rsqf(q * (1.0f / 1024.0f) + EPS);
      bf16* dst = W_MIX(w) + (size_t)row * 2048 + head * 64 + dq;
      *(v4u*)dst = pack8(o[0] * rs, o[1] * rs); *(v4u*)(dst + 8) = pack8(o[2] * rs, o[3] * rs); }
    { const int c0 = lane * 16;
      float u[3][16];
#pragma unroll
      for (int k = 0; k < 3; ++k) { const int tt = t - 2 + k;
          if (tt >= 0) { const bf16* pr = W_PC(w) + (size_t)(row - 2 + k) * 2048;
              const v4u a0 = *(const v4u*)(pr + c0), a1 = *(const v4u*)(pr + c0 + 8);
#pragma unroll
              for (int e = 0; e < 4; ++e) { const unsigned va = a0[e], vb = a1[e];
                  u[k][2 * e] = __uint_as_float(va << 16); u[k][2 * e + 1] = __uint_as_float(va & 0xffff0000u);
                  u[k][8 + 2 * e] = __uint_as_float(vb << 16); u[k][8 + 2 * e + 1] = __uint_as_float(vb & 0xffff0000u); }
          } else {
#pragma unroll
              for (int e = 0; e < 16; ++e) u[k][e] = 0.f; } }
      const bf16* pr = W_PC(w) + (size_t)row * 2048 + 1024 + c0;
      const v4u b0 = *(const v4u*)pr, b1 = *(const v4u*)(pr + 8);
      float gb[16];
#pragma unroll
      for (int e = 0; e < 4; ++e) { gb[2 * e] = __uint_as_float(b0[e] << 16); gb[2 * e + 1] = __uint_as_float(b0[e] & 0xffff0000u); gb[8 + 2 * e] = __uint_as_float(b1[e] << 16); gb[8 + 2 * e + 1] = __uint_as_float(b1[e] & 0xffff0000u); }
      const float* cw = W_CW(w) + (size_t)l * 3 * DC + c0;
      float z[16]; float q = 0.f;
#pragma unroll
      for (int e4 = 0; e4 < 4; ++e4) { const f32x4 w0 = *(const f32x4*)(cw + 4 * e4), w1 = *(const f32x4*)(cw + DC + 4 * e4), w2 = *(const f32x4*)(cw + 2 * DC + 4 * e4);
#pragma unroll
          for (int e = 0; e < 4; ++e) { const int i = 4 * e4 + e; const float y = w0[e] * u[0][i] + w1[e] * u[1][i] + w2[e] * u[2][i]; z[i] = gb[i] * y; q += z[i] * z[i]; } }
      q = wave_sum(q);
      const float rs = __builtin_amdgcn_rsqf(q * (1.0f / 1024.0f) + EPS);
      bf16* dst = W_MIX(w) + (size_t)row * 2048 + 1024 + c0;
      v4u w0, w1;
#pragma unroll
      for (int e = 0; e < 4; ++e) { w0[e] = cvt_pk_bf16(z[2 * e] * rs, z[2 * e + 1] * rs); w1[e] = cvt_pk_bf16(z[8 + 2 * e] * rs, z[8 + 2 * e + 1] * rs); }
      *(v4u*)dst = w0; *(v4u*)(dst + 8) = w1;
      if (t >= S - 2) { float* cp = out + O_CP + ((size_t)(l * NB + b) * 2 + (t - (S - 2))) * DC + c0;
#pragma unroll
          for (int e4 = 0; e4 < 4; ++e4) *(f32x4*)(cp + 4 * e4) = (f32x4){u[2][4 * e4], u[2][4 * e4 + 1], u[2][4 * e4 + 2], u[2][4 * e4 + 3]}; } }
}
__device__ __forceinline__ void mix_row_sample(unsigned char* w, float* out, int lane, int l, int b) {
    { const f32x4* p = (const f32x4*)(W_OS(w) + (size_t)b * 1024 + lane * 16); f32x4 o[4]; float q = 0.f;
#pragma unroll
      for (int k = 0; k < 4; ++k) { o[k] = p[k]; q += (o[k][0] * o[k][0] + o[k][1] * o[k][1]) + (o[k][2] * o[k][2] + o[k][3] * o[k][3]); }
      q = wave_sum(q); const float rs = __builtin_amdgcn_rsqf(q * (1.0f / 1024.0f) + EPS);
      f32x4* dst = (f32x4*)(W_MIXS(w) + (size_t)b * 2048 + lane * 16);
#pragma unroll
      for (int k = 0; k < 4; ++k) dst[k] = o[k] * rs; }
    { const int c0 = lane * 16; const float* ps = W_PS(w) + (size_t)b * DIN;
      const float* st = W_SC(w) + (size_t)(l * SB + b) * 2 * DC; const float* cw = W_CW(w) + (size_t)l * 3 * DC;
      float* co = out + O_CS + (size_t)(l * SB + b) * 2 * DC;
      f32x4 z[4]; float q = 0.f;
#pragma unroll
      for (int k = 0; k < 4; ++k) { const int c = c0 + 4 * k;
          const int cv = 3072 + 256 * (c >> 7) + 64 * ((c >> 5) & 3) + (c & 31);
          const f32x4 vc = *(const f32x4*)(ps + cv), gb = *(const f32x4*)(ps + 5120 + c), gc = *(const f32x4*)(ps + cv + 32);
          const f32x4 s0 = *(const f32x4*)(st + c), s1 = *(const f32x4*)(st + DC + c);
          const f32x4 w0 = *(const f32x4*)(cw + c), w1 = *(const f32x4*)(cw + DC + c), w2 = *(const f32x4*)(cw + 2 * DC + c);
          const f32x4 un = gc * vc; const f32x4 y = w0 * s0 + w1 * s1 + w2 * un; z[k] = gb * y;
          q += (z[k][0] * z[k][0] + z[k][1] * z[k][1]) + (z[k][2] * z[k][2] + z[k][3] * z[k][3]);
          *(f32x4*)(co + c) = s1; *(f32x4*)(co + DC + c) = un; }
      q = wave_sum(q); const float rs = __builtin_amdgcn_rsqf(q * (1.0f / 1024.0f) + EPS);
      f32x4* dst = (f32x4*)(W_MIXS(w) + (size_t)b * 2048 + 1024 + c0);
#pragma unroll
      for (int k = 0; k < 4; ++k) dst[k] = z[k] * rs; }
}

#ifndef PHASE_MASK
#define PHASE_MASK 127
#endif
struct SideKV {
    static constexpr bool ON = true;
    const bf16* kb; const bf16* vb; float* ko; float* vo; int gw, ngw, lane;
    LAS unsigned char* slot; f32x2 d; f32x2* dst;
    __device__ __forceinline__ void issue(int j) {
        int o = j * ngw + gw; o = o < 131072 ? o : 131071;
        const int kv = o >> 16, rem = o & 65535, row = rem >> 3, part = rem & 7, head = 2 * part + (lane >> 5), dd = 2 * (lane & 31);
        const bf16* src = (kv ? vb : kb) + ((size_t)((row >> 11) * 16 + head) * 2048 + (row & 2047)) * 64 + dd;
        __builtin_amdgcn_global_load_lds((const unsigned*)src, (LAS unsigned*)slot, 4, 0, 0);
        dst = (f32x2*)((kv ? vo : ko) + (size_t)row * 1024 + part * 128 + 2 * lane);
    }
    __device__ __forceinline__ void prime() { issue(0); }
    __device__ __forceinline__ void fetch() { const unsigned x = *(const LAS unsigned*)(slot + lane * 4); d[0] = __uint_as_float(x << 16); d[1] = __uint_as_float(x & 0xffff0000u); }
    __device__ __forceinline__ void step(int j) { __builtin_nontemporal_store(d, dst); issue(j + 1); }
};
struct SideCopy {
    static constexpr bool ON = true;
    const float* sk; const float* sv; float* ok; float* ov; int gw, ngw, lane;
    LAS unsigned char* slot;
    f32x4 d; f32x4* dst;
    __device__ __forceinline__ void issue(int j) {
        constexpr int CP_PER = (WBUF - 1) * 256, CP_HALF = SB * CP_PER, CP_TOT = 2 * CP_HALF;
        int ci = (j * ngw + gw) * 64 + lane; ci = ci < CP_TOT ? ci : CP_TOT - 1;
        const int kv = ci >= CP_HALF, rr = ci - kv * CP_HALF, bb = rr / CP_PER, ee = rr - bb * CP_PER;
        __builtin_amdgcn_global_load_lds((const unsigned*)((const f32x4*)(kv ? sv : sk) + ((size_t)bb * WBUF + 1) * 256 + ee), (LAS unsigned*)slot, 16, 0, 0);
        dst = (f32x4*)(kv ? ov : ok) + (size_t)bb * WBUF * 256 + ee;
    }
    __device__ __forceinline__ void prime() { issue(0); }
    __device__ __forceinline__ void fetch() { d = *(const LAS f32x4*)(slot + lane * 16); }
    __device__ __forceinline__ void step(int j) { __builtin_nontemporal_store(d, dst); issue(j + 1); }
};
#define PH_ON(k) ((PHASE_MASK >> (k)) & 1)
#ifndef REPEAT_MASK
#define REPEAT_MASK 0
#endif
#define NREP(k) (((REPEAT_MASK >> (k)) & 1) ? 2 : 1)
__global__ void __launch_bounds__(NWAVES * 64, 2) mk_fwd(Args args) {
    extern __shared__ __attribute__((aligned(16))) unsigned char lds[];
    Frame F;
    F.lds = (LAS unsigned char*)lds;
    F.tid = threadIdx.x; F.lane = F.tid & 63; F.wave = __builtin_amdgcn_readfirstlane(F.tid >> 6);
    F.G = gridDim.x; { const int bx = blockIdx.x; F.vcu = (F.G % 8 == 0) ? (bx % 8) * (F.G / 8) + bx / 8 : bx; }
    F.ws = args.ws; F.out = args.out; F.x_prompt = args.in[0]; F.state_k = args.in[2]; F.state_v = args.in[3];
    for (int u = F.tid; u < (LDS_BYTES - LDSCTL_OFF) / 4; u += NWAVES * 64) ((LAS unsigned*)(F.lds + LDSCTL_OFF))[u] = 0u;
    __syncthreads();
    XcdBarrier bar; bar.wave = F.wave; bar.bar = (unsigned*)(F.ws + WS_CTL) + CW_BAR; bar.x = 0; bar.st = nullptr;
    if (MK_ONE_LAUNCH) bar = xcd_barrier_post((unsigned*)(F.ws + WS_CTL) + CW_BAR, (volatile LAS unsigned*)(F.lds + MISC_OFF) + 8, F.wave);
    const int lo = args.ph_lo, hi = args.ph_hi;
#define IN(k) (lo <= (k) && (k) < hi)
#define SEAM(k) do { if (IN(k) && IN((k) + 1)) xcd_barrier(bar); } while (0)

    if (PH_ON(0) && IN(0)) { for (int rep = 0; rep < NREP(0); ++rep) p0_prologue(F, args); SEAM(0); }

    for (int l = 0; l < DEPTH; ++l) {
        const int p0 = 1 + 6 * l;
        if (PH_ON(1) && IN(p0)) {
            unsigned char* w = opq(F.ws); float* out = opq(F.out); Frame P = F; P.tid = fresh_tid(F.wave); P.lane = P.tid & 63;
            const bool sfirst = STAGGER && (F.vcu & 1);
            if (sfirst) { sgemv<0, D, DIN>(P, W_XS(w), W_WIN(w) + (size_t)l * DIN * D, W_PS(w), nullptr); WG_BAR(); }
            for (int rep = 0; rep < NREP(1); ++rep) { pg8::Gemm g{W_XB(w), W_WIN(w) + (size_t)l * DIN * D, M, DIN, D, F.wave}; pg8::MixedOrderG1 So; So.init(M, DIN, F.G, (int)blockIdx.x);
              pg8::fill_rstd_table((LAS float*)(F.lds + RS_TAB_OFF), So, W_SSQA(w), EPS, P.tid);
              pg8::EpiG1 E{(const LAS float*)(F.lds + RS_TAB_OFF), W_GN(w) + l * 128, 64, W_Q(w), (size_t)(WS_K - WS_Q) / 2, W_PC(w), out + O_KP + (size_t)l * M * 1024, (size_t)(O_VP - O_KP), QSCALE, EPS};
              pg8::gemm_phase<pg8::EpiG1, pg8::MixedOrderG1, GEMM_ALIGN, GEMM_SP2>(F.lds, g, So, E); }
            if (!sfirst && F.wave == 0) EARLY_WB(); if (!sfirst) sgemv<0, D, DIN>(P, W_XS(w), W_WIN(w) + (size_t)l * DIN * D, W_PS(w), nullptr);
            SEAM(p0);
        }
        if (PH_ON(2) && IN(p0 + 1)) {
            unsigned char* w = opq(F.ws); float* out = opq(F.out); Frame P = F; P.tid = fresh_tid(F.wave); P.lane = P.tid & 63;
#ifdef ATT_PROBE_MODE
            attn_phase_prompt(P, w, out, l, ATT_PROBE_MODE); WG_BAR();
#endif
#if ATT_V4
            attn_phase_prompt4(P, args, w, out, l);
#else
            for (int rep = 0; rep < NREP(2); ++rep) attn_phase_prompt(P, w, out, l);
#endif
            WG_BAR();
#if !ATT_V4
            for (int rep = 0; rep < NREP(7); ++rep) if (F.vcu < SB * H) attn_sample_unit(P, w, out, l, F.vcu >> 4, F.vcu & 15);
#endif
            SEAM(p0 + 1);
        }
        if (PH_ON(3) && IN(p0 + 2)) {
            unsigned char* w = opq(F.ws); float* out = opq(F.out); Frame P = F; P.tid = fresh_tid(F.wave); P.lane = P.tid & 63;
            const int gw = F.vcu * NWAVES + F.wave, NGW = F.G * NWAVES;
            for (int rep = 0; rep < NREP(3); ++rep) for (int row = gw; row < M; row += NGW) mix_row_prompt(w, out, P.lane, l, row);
            if (F.vcu == F.G - 1) mix_row_sample(w, out, P.lane, l, P.wave);
            SEAM(p0 + 2);
        }
        if (PH_ON(4) && IN(p0 + 3)) {
            unsigned char* w = opq(F.ws); float* out = opq(F.out); Frame P = F; P.tid = fresh_tid(F.wave); P.lane = P.tid & 63;
            const bool sfirst = STAGGER && (F.vcu & 1);
            if (sfirst) { sgemv<1, D, D>(P, W_MIXS(w), W_WOUT(w) + (size_t)l * D * D, W_XS(w), nullptr); WG_BAR(); }
            if (NREP(4) > 1) { pg8::Gemm g{W_MIX(w), W_WOUT(w) + (size_t)l * D * D, M, D, D, F.wave}; pg8::StaticOrder So; So.init(M, D, F.G, (int)blockIdx.x); pg8::EpiNull E{}; pg8::gemm_phase<pg8::EpiNull, pg8::StaticOrder, false, true>(F.lds, g, So, E); }
            { pg8::Gemm g{W_MIX(w), W_WOUT(w) + (size_t)l * D * D, M, D, D, F.wave}; pg8::StaticOrder So; So.init(M, D, F.G, (int)blockIdx.x);
              pg8::EpiRes E{W_XB(w), W_SSQB(w), nullptr};
              pg8::gemm_phase<pg8::EpiRes, pg8::StaticOrder, false, GEMM_SP2>(F.lds, g, So, E); }
            if (!sfirst && F.wave == 0) EARLY_WB(); if (!sfirst) sgemv<1, D, D>(P, W_MIXS(w), W_WOUT(w) + (size_t)l * D * D, W_XS(w), nullptr);
            SEAM(p0 + 3);
        }
        if (PH_ON(5) && IN(p0 + 4)) {
            unsigned char* w = opq(F.ws); Frame P = F; P.tid = fresh_tid(F.wave); P.lane = P.tid & 63;
            const bool sfirst = STAGGER && (F.vcu & 1);
            if (sfirst) { sgemv<2, D, DFF>(P, W_XS(w), W_WUP(w) + (size_t)l * DFF * D, W_AS(w), nullptr); WG_BAR(); }
            for (int rep = 0; rep < NREP(5); ++rep) { pg8::Gemm g{W_XB(w), W_WUP(w) + (size_t)l * DFF * D, M, DFF, D, F.wave}; pg8::StaticOrder So; So.init(M, DFF, F.G, (int)blockIdx.x);
              pg8::fill_rstd_table((LAS float*)(F.lds + RS_TAB_OFF), So, W_SSQB(w), EPS, P.tid);
              pg8::EpiG3 E{(const LAS float*)(F.lds + RS_TAB_OFF), W_HB(w), DFF};
              pg8::gemm_phase<pg8::EpiG3, pg8::StaticOrder, GEMM_ALIGN, GEMM_SP2>(F.lds, g, So, E); }
            if (!sfirst && F.wave == 0) EARLY_WB(); if (!sfirst) sgemv<2, D, DFF>(P, W_XS(w), W_WUP(w) + (size_t)l * DFF * D, W_AS(w), nullptr);
            SEAM(p0 + 4);
        }
        if (PH_ON(6) && IN(p0 + 5)) {
            unsigned char* w = opq(F.ws); float* out = opq(F.out); Frame P = F; P.tid = fresh_tid(F.wave); P.lane = P.tid & 63;
            const bool sfirst = STAGGER && (F.vcu & 1);
            if (sfirst) { sgemv<3, DFF, D>(P, W_AS(w), W_WDN(w) + (size_t)l * D * DFF, W_XS(w), l == DEPTH - 1 ? out + O_YS : nullptr); WG_BAR(); }
            if (NREP(6) > 1) { pg8::Gemm g{W_HB(w), W_WDN(w) + (size_t)l * D * DFF, M, D, DFF, F.wave}; pg8::StaticOrder So; So.init(M, D, F.G, (int)blockIdx.x); pg8::EpiNull E{}; pg8::gemm_phase<pg8::EpiNull, pg8::StaticOrder, false, true>(F.lds, g, So, E); }
            { pg8::Gemm g{W_HB(w), W_WDN(w) + (size_t)l * D * DFF, M, D, DFF, F.wave}; pg8::StaticOrder So; So.init(M, D, F.G, (int)blockIdx.x);
              pg8::EpiRes E{W_XB(w), W_SSQA(w), l == DEPTH - 1 ? out + O_Y : nullptr};
#if KV_SIDE
              SideKV sc{W_K(w), W_V(w), out + O_KP + (size_t)l * M * 1024, out + O_VP + (size_t)l * M * 1024, F.vcu * NWAVES + F.wave, F.G * NWAVES, P.lane, F.lds + RS_TAB_OFF + F.wave * 1024, (f32x2){0.f, 0.f}, nullptr};
              pg8::gemm_phase<pg8::EpiRes, pg8::StaticOrder, false, true, SideKV>(F.lds, g, So, E, sc); }
#elif COPY_IN_G4
              const size_t lo_ = (size_t)l * SB * WBUF * 1024;
              SideCopy sc{F.state_k + lo_, F.state_v + lo_, out + O_KS + lo_, out + O_VS + lo_, F.vcu * NWAVES + F.wave, F.G * NWAVES, P.lane, F.lds + RS_TAB_OFF + F.wave * 1024, (f32x4){0.f, 0.f, 0.f, 0.f}, nullptr};
              pg8::gemm_phase<pg8::EpiRes, pg8::StaticOrder, false, true, SideCopy>(F.lds, g, So, E, sc); }
#else
              pg8::gemm_phase<pg8::EpiRes, pg8::StaticOrder, false, GEMM_SP2>(F.lds, g, So, E); }
#endif
            if (!sfirst && F.wave == 0) EARLY_WB(); if (!sfirst) sgemv<3, DFF, D>(P, W_AS(w), W_WDN(w) + (size_t)l * D * DFF, W_XS(w), l == DEPTH - 1 ? out + O_YS : nullptr);
            SEAM(p0 + 5);
        }
    }
#undef IN
#undef SEAM
}

extern "C" void kernel_launch(void* const* d_in, const int* in_sizes, int n_in, void* d_out, int out_size, void* d_ws, size_t ws_size, hipStream_t stream) {
    static int grid = 0;
    if (grid == 0) {
        if (n_in != 17 || (size_t)out_size != O_END || ws_size < WS_END) { fprintf(stderr, "kernel_launch: unexpected sizes (n_in %d out %d ws %zu)\n", n_in, out_size, ws_size); grid = -1; return; }
        int dev = 0, cus = 0, per_cu = 0;
        if (hipGetDevice(&dev) != hipSuccess || hipDeviceGetAttribute(&cus, hipDeviceAttributeMultiprocessorCount, dev) != hipSuccess) { grid = -1; return; }
        if (hipFuncSetAttribute((const void*)mk_fwd, hipFuncAttributeMaxDynamicSharedMemorySize, LDS_BYTES) != hipSuccess) { fprintf(stderr, "kernel_launch: hipFuncSetAttribute failed\n"); grid = -1; return; }
        if (hipOccupancyMaxActiveBlocksPerMultiprocessor(&per_cu, (const void*)mk_fwd, NWAVES * 64, LDS_BYTES) != hipSuccess || per_cu < 1) { fprintf(stderr, "kernel_launch: occupancy query says %d\n", per_cu); (void)hipGetLastError(); per_cu = 1; }
        grid = cus;
        if (grid != 256) fprintf(stderr, "kernel_launch: %d CUs (built for 256)\n", grid);
    }
    if (grid < 0) return;
    if (hipMemsetAsync((char*)d_ws + WS_CTL, 0, CTL_ZERO_BYTES, stream) != hipSuccess) return;
    Args a{};
    for (int i = 0; i < 17; ++i) a.in[i] = (const float*)d_in[i];
    a.out = (float*)d_out; a.ws = (unsigned char*)d_ws;
#if MK_ONE_LAUNCH
    a.ph_lo = 0; a.ph_hi = NPH;
    hipLaunchKernelGGL(mk_fwd, dim3(grid), dim3(NWAVES * 64), LDS_BYTES, stream, a);
#else
    for (int p = 0; p < NPH; ++p) { a.ph_lo = p; a.ph_hi = p + 1; hipLaunchKernelGGL(mk_fwd, dim3(grid), dim3(NWAVES * 64), LDS_BYTES, stream, a); }
#endif
}
```

```cpp
#include <hip/hip_runtime.h>
#include <cstdio>
#include <cstdint>
#ifndef KV_SIDE
#define KV_SIDE 1
#endif
namespace pg8 {
#define PG8_LAS __attribute__((address_space(3)))
typedef unsigned short bf16_t;
typedef short bf16x8 __attribute__((ext_vector_type(8)));
typedef float f32x4 __attribute__((ext_vector_type(4)));
typedef unsigned u32x4 __attribute__((ext_vector_type(4)));
constexpr int BM = 256, BK = 64, HALF = 128, HTB = HALF * BK * 2  , STAGE_BYTES = 8 * HTB, NXCD = 8, WGM = 4;

__host__ __device__ __forceinline__ int lds_byte(int r, int c) { const int st = (r >> 4) * 2 + (c >> 5), rr = r & 15, cc = c & 31, ob = rr * 64 + cc * 2; return st * 1024 + (ob ^ (((ob >> 9) & 1) << 5)); }
__host__ __device__ __forceinline__ void stage_rc(int b, int& R, int& C) { const int st = b / 1024, sb = b % 1024, swz = sb ^ (((sb >> 9) & 1) << 5); R = (st >> 1) * 16 + swz / 64; C = (st & 1) * 32 + (swz % 64) / 2; }
__host__ __device__ __forceinline__ int perm32(int rho) { const int n = rho >> 4, i = rho & 15; return 8 * (i >> 2) + 4 * n + (i & 3); }

struct Unit { int pm, pn; };
struct Gemm { const bf16_t* A; const bf16_t* Bt; int M, N, K, wave; };

struct StaticOrder {
    int nM, nN, nwg, G, c;
    __host__ __device__ void init(int M, int N, int G_, int c_) { nM = M / BM; nN = N / BM; nwg = nM * nN; G = G_; c = c_; }
    __host__ __device__ bool next(int i, Unit& u) const {
        const long L = (long)i * G + c; if (L >= nwg) return false;
        int wgid = (int)L; { const int q = nwg / NXCD, r = nwg % NXCD, xcd = wgid % NXCD, off = wgid / NXCD; wgid = (xcd < r ? xcd * (q + 1) : r * (q + 1) + (xcd - r) * q) + off; }
        const int nig = WGM * nN, gid = wgid / nig, fm = gid * WGM, gsz = (nM - fm) < WGM ? (nM - fm) : WGM;
        u.pm = fm + ((wgid % nig) % gsz); u.pn = (wgid % nig) / gsz; return true;
    }
    __device__ __forceinline__ void a_ready(const Unit&) const {}
    __device__ __forceinline__ void done(const Unit&) const {}
};

typedef float f32x2 __attribute__((ext_vector_type(2)));
typedef __bf16 bf16x2v __attribute__((ext_vector_type(2)));
__device__ __forceinline__ unsigned cvt_pk_bf16(float lo, float hi) { f32x2 v = {lo, hi}; bf16x2v b = __builtin_convertvector(v, bf16x2v); return __builtin_bit_cast(unsigned, b); }
__device__ __forceinline__ u32x4 pack8(const f32x4 a, const f32x4 b) { u32x4 w; w.x = cvt_pk_bf16(a[0], a[1]); w.y = cvt_pk_bf16(a[2], a[3]); w.z = cvt_pk_bf16(b[0], b[1]); w.w = cvt_pk_bf16(b[2], b[3]); return w; }
#ifndef RES_PREFETCH
#define RES_PREFETCH 0
#endif
#ifndef STORE_WT
#define STORE_WT 0
#endif
__device__ __forceinline__ void st16(bf16_t* p, const u32x4 v) {
#if STORE_WT
    asm volatile("global_store_dwordx4 %0, %1, off sc1\n\ts_nop 1" :: "v"(p), "v"(v) : "memory");
#else
    *(u32x4*)p = v;
#endif
}
__device__ __forceinline__ float row_rstd(const float* ssq, int row, float inv_n, float eps) {
    const f32x4 s0 = *(const f32x4*)(ssq + (size_t)row * 8), s1 = *(const f32x4*)(ssq + (size_t)row * 8 + 4);
    return __builtin_amdgcn_rsqf((((s0[0] + s0[1]) + (s0[2] + s0[3])) + ((s1[0] + s1[1]) + (s1[2] + s1[3]))) * inv_n + eps);
}

template <class Sched>
__device__ __forceinline__ void fill_rstd_table(PG8_LAS float* tab, const Sched& S, const float* ssq, float eps, int tid) {
    Unit u;
    for (int i = 0; S.next(i, u); ++i) if ((tid >> 8) == (i & 1)) tab[i * BM + (tid & 255)] = row_rstd(ssq, u.pm * BM + (tid & 255), 1.0f / 2048.0f, eps);
    asm volatile("s_waitcnt lgkmcnt(0)" ::: "memory"); __builtin_amdgcn_s_barrier(); asm volatile("" ::: "memory");
}

struct MixedOrderG1 : StaticOrder {
    __host__ __device__ bool next(int i, Unit& u) const { const bool ok = StaticOrder::next(i, u); if (ok) u.pn = (u.pn & 3) * 6 + (u.pn >> 2); return ok; }
};

struct EpiG1 {
    static constexpr bool AFTER_DRAIN = false;
    const PG8_LAS float* rs_tab; const float* qg; int g_stride;
    bf16_t* Q; size_t qkv_stride;
    bf16_t* PC;
    float* kout; size_t kv_out_stride;
    float qscale, eps;
    __device__ __forceinline__ void operator()(const f32x4 (&acc)[2][2][4][2], const Unit& u, int ui, int wr, int wc, int fr, int fq) const {
        const int region = u.pn >> 2, head = (u.pn & 3) * 4 + wc;
        f32x4 g[2][2];
#pragma unroll
        for (int bj = 0; bj < 2; ++bj)
#pragma unroll
            for (int n = 0; n < 2; ++n) g[bj][n] = (f32x4){1.f, 1.f, 1.f, 1.f};
        if (region < 2) { const float* gp = qg + region * g_stride; const float s = region == 0 ? qscale : 1.f;
#pragma unroll
            for (int bj = 0; bj < 2; ++bj)
#pragma unroll
                for (int n = 0; n < 2; ++n) g[bj][n] = *(const f32x4*)(gp + bj * 32 + fq * 8 + n * 4) * s; }
#pragma unroll
        for (int ai = 0; ai < 2; ++ai)
#pragma unroll
            for (int m = 0; m < 4; ++m) {
                const int row = u.pm * BM + ai * HALF + wr * 64 + m * 16 + fr;
                const float rs = rs_tab[ui * BM + ai * HALF + wr * 64 + m * 16 + fr];
                f32x4 v[2][2];
#pragma unroll
                for (int bj = 0; bj < 2; ++bj)
#pragma unroll
                    for (int n = 0; n < 2; ++n) v[bj][n] = acc[ai][bj][m][n] * rs;
                if (region < 2) {
                    float q = 0.f;
#pragma unroll
                    for (int bj = 0; bj < 2; ++bj)
#pragma unroll
                        for (int n = 0; n < 2; ++n) { const f32x4 x = v[bj][n]; q += (x[0] * x[0] + x[1] * x[1]) + (x[2] * x[2] + x[3] * x[3]); }
                    q += __shfl_xor(q, 16); q += __shfl_xor(q, 32);
                    const float rh = __builtin_amdgcn_rsqf(q * (1.0f / 64.0f) + eps);
#pragma unroll
                    for (int bj = 0; bj < 2; ++bj)
#pragma unroll
                        for (int n = 0; n < 2; ++n) v[bj][n] = v[bj][n] * rh * g[bj][n];
                }
                if (region < 3) {
                    const int b = row >> 11, t = row & 2047;
                    bf16_t* dst = Q + (size_t)region * qkv_stride + ((size_t)(b * 16 + head) * 2048 + t) * 64 + fq * 8;
#pragma unroll
                    for (int bj = 0; bj < 2; ++bj) *(u32x4*)(dst + bj * 32) = pack8(v[bj][0], v[bj][1]);
                    if (!KV_SIDE && region >= 1) { float* o = kout + (size_t)(region - 1) * kv_out_stride + (size_t)row * 1024 + head * 64 + fq * 8;
#pragma unroll
                        for (int bj = 0; bj < 2; ++bj) { __builtin_nontemporal_store(v[bj][0], (f32x4*)(o + bj * 32)); __builtin_nontemporal_store(v[bj][1], (f32x4*)(o + bj * 32 + 4)); } }
                } else if (u.pn < 20) {
                    bf16_t* dst = PC + (size_t)row * 2048 + (u.pn - 12) * 128 + wc * 32 + fq * 8;
                    *(u32x4*)dst = pack8(v[0][0] * v[1][0], v[0][1] * v[1][1]);
                } else {
                    bf16_t* dst = PC + (size_t)row * 2048 + 1024 + (u.pn - 20) * 256 + wc * 64 + fq * 8;
#pragma unroll
                    for (int bj = 0; bj < 2; ++bj) *(u32x4*)(dst + bj * 32) = pack8(v[bj][0], v[bj][1]);
                }
            }
    }
};

struct EpiG3 {
    static constexpr bool AFTER_DRAIN = false;
    const PG8_LAS float* rs_tab; bf16_t* Hb; int ldc;
    __device__ __forceinline__ void operator()(const f32x4 (&acc)[2][2][4][2], const Unit& u, int ui, int wr, int wc, int fr, int fq) const {
#pragma unroll
        for (int ai = 0; ai < 2; ++ai)
#pragma unroll
            for (int m = 0; m < 4; ++m) {
                const int row = u.pm * BM + ai * HALF + wr * 64 + m * 16 + fr;
                const float rs = rs_tab[ui * BM + ai * HALF + wr * 64 + m * 16 + fr];
                bf16_t* dst = Hb + (size_t)row * ldc + u.pn * BM + wc * 64 + fq * 8;
#pragma unroll
                for (int bj = 0; bj < 2; ++bj) {
                    f32x4 a = acc[ai][bj][m][0] * rs, b = acc[ai][bj][m][1] * rs;
#pragma unroll
                    for (int i = 0; i < 4; ++i) { const float x = fmaxf(a[i], 0.f), y = fmaxf(b[i], 0.f); a[i] = x * x; b[i] = y * y; }
                    st16(dst + bj * 32, pack8(a, b));
                }
            }
    }
};

struct EpiRes {
    static constexpr bool AFTER_DRAIN = true;
    bf16_t* xb; float* ssq_out; float* yout;
    __device__ __forceinline__ void prefetch(const Unit& u, int wr, int wc, int fr, int fq, u32x4 (&res)[2][4][2]) const {
#pragma unroll
        for (int ai = 0; ai < RES_PREFETCH; ++ai)
#pragma unroll
            for (int m = 0; m < 4; ++m) {
                const size_t off = (size_t)(u.pm * BM + ai * HALF + wr * 64 + m * 16 + fr) * 2048 + u.pn * BM + wc * 64 + fq * 8;
#pragma unroll
                for (int bj = 0; bj < 2; ++bj) res[ai][m][bj] = *(const u32x4*)(xb + off + bj * 32);
            }
    }
    __device__ __forceinline__ void fused(const f32x4 (&acc)[2][2][4][2], const u32x4 (&res)[2][4][2], const Unit& u, int wr, int wc, int fr, int fq, PG8_LAS unsigned char* lds, int wid, int lane) const {
        PG8_LAS float* P = (PG8_LAS float*)lds;
#pragma unroll
        for (int ai = 0; ai < 2; ++ai)
#pragma unroll
            for (int m = 0; m < 4; ++m) {
                const int rl = ai * HALF + wr * 64 + m * 16 + fr;
                const size_t off = (size_t)(u.pm * BM + rl) * 2048 + u.pn * BM + wc * 64 + fq * 8;
                float q = 0.f;
#pragma unroll
                for (int bj = 0; bj < 2; ++bj) {
                    const u32x4 xo = ai < RES_PREFETCH ? res[ai][m][bj] : *(const u32x4*)(xb + off + bj * 32);
                    f32x4 v0, v1;
                    v0[0] = __uint_as_float(xo[0] << 16); v0[1] = __uint_as_float(xo[0] & 0xffff0000u); v0[2] = __uint_as_float(xo[1] << 16); v0[3] = __uint_as_float(xo[1] & 0xffff0000u);
                    v1[0] = __uint_as_float(xo[2] << 16); v1[1] = __uint_as_float(xo[2] & 0xffff0000u); v1[2] = __uint_as_float(xo[3] << 16); v1[3] = __uint_as_float(xo[3] & 0xffff0000u);
                    v0 += acc[ai][bj][m][0]; v1 += acc[ai][bj][m][1];
                    if (yout) { *(f32x4*)(yout + off + bj * 32) = v0; *(f32x4*)(yout + off + bj * 32 + 4) = v1; }
                    st16(xb + off + bj * 32, pack8(v0, v1));
                    q += ((v0[0] * v0[0] + v0[1] * v0[1]) + (v0[2] * v0[2] + v0[3] * v0[3])) + ((v1[0] * v1[0] + v1[1] * v1[1]) + (v1[2] * v1[2] + v1[3] * v1[3]));
                }
                q += __shfl_xor(q, 16); q += __shfl_xor(q, 32);
                if (fq == 0) P[rl * 4 + wc] = q;
            }
        asm volatile("s_waitcnt lgkmcnt(0)" ::: "memory"); __builtin_amdgcn_s_barrier(); asm volatile("" ::: "memory");
        const int tid = wid * 64 + lane;
        if (tid < 256) { const f32x4 p = *(const PG8_LAS f32x4*)(P + tid * 4); ssq_out[(size_t)(u.pm * BM + tid) * 8 + u.pn] = (p[0] + p[1]) + (p[2] + p[3]); }
        asm volatile("s_waitcnt lgkmcnt(0)" ::: "memory"); __builtin_amdgcn_s_barrier(); asm volatile("" ::: "memory");
    }
};

struct EpiNull { static constexpr bool AFTER_DRAIN = true;
    __device__ __forceinline__ void prefetch(const Unit&, int, int, int, int, u32x4 (&)[2][4][2]) const {}
    __device__ __forceinline__ void fused(const f32x4 (&acc)[2][2][4][2], const u32x4 (&)[2][4][2], const Unit& u, int wr, int wc, int fr, int fq, PG8_LAS unsigned char* lds, int wid, int lane) const {
        float s = 0.f;
#pragma unroll
        for (int ai = 0; ai < 2; ++ai)
#pragma unroll
            for (int bj = 0; bj < 2; ++bj)
#pragma unroll
                for (int m = 0; m < 4; ++m)
#pragma unroll
                    for (int n = 0; n < 2; ++n) s += acc[ai][bj][m][n][0] + acc[ai][bj][m][n][1] + acc[ai][bj][m][n][2] + acc[ai][bj][m][n][3];
        if (s == 1.2345e-30f) *(PG8_LAS float*)lds = s;
    }
};

struct NoSide { static constexpr bool ON = false; __device__ __forceinline__ void prime() {} __device__ __forceinline__ void fetch() {} __device__ __forceinline__ void step(int) {} };
template <class Epi, class Sched, bool ALIGN_EPI = false, bool SP2 = false, class Side = NoSide>
__device__ __forceinline__ void gemm_phase(PG8_LAS unsigned char* lds, const Gemm g, const Sched& S, const Epi& E, Side side = Side()) {
    int tid_ = (int)__builtin_amdgcn_mbcnt_hi(~0u, __builtin_amdgcn_mbcnt_lo(~0u, 0u)) + 64 * g.wave; asm volatile("" : "+v"(tid_));
    const int tid = tid_, wid = __builtin_amdgcn_readfirstlane(tid >> 6), lane = tid & 63, wr = wid >> 2, wc = wid & 3, fr = lane & 15, fq = lane >> 4;
    const int K = g.K, nt = K / BK;
    unsigned voffA[2], voffB[2];
#pragma unroll
    for (int i = 0; i < 2; ++i) { int R, C; stage_rc(tid * 16 + i * 8192, R, C); const int Rb = 64 * (R >> 5) + perm32(R & 31);
        voffA[i] = (unsigned)(R * K + C) * 2u; voffB[i] = (unsigned)(Rb * K + C) * 2u; }
    const size_t kstep = (size_t)(BK * 2);
    const size_t hstep = (size_t)HALF * K * 2;
    const size_t hstepB = (size_t)32 * K * 2; const size_t tstep = 2 * hstep;
    const unsigned ldsw = (unsigned)wid * 1024u;
    const int aoff = lds_byte(wr * 64 + fr, fq * 8), boff = lds_byte(wc * 32 + fr, fq * 8);
#define PG8_SA(b, h) (((b) * 2 + (h)) * HTB)
#define PG8_SB(b, h) ((4 + (b) * 2 + (h)) * HTB)
#define PG8_STAGE(bufoff, gbase, voff) do { _Pragma("unroll") for (int _i = 0; _i < 2; ++_i) \
        __builtin_amdgcn_global_load_lds((const unsigned*)((const char*)(gbase) + (voff)[_i]), (PG8_LAS unsigned*)(lds + (bufoff) + ldsw + _i * 8192), 16, 0, 0); } while (0)
#define PG8_LDA(dst, b, h) do { _Pragma("unroll") for (int m = 0; m < 4; ++m) _Pragma("unroll") for (int k = 0; k < 2; ++k) dst[m][k] = *(const PG8_LAS bf16x8*)(lds + PG8_SA(b, h) + aoff + m * 2048 + k * 1024); } while (0)
#define PG8_LDB(dst, b, h) do { _Pragma("unroll") for (int n = 0; n < 2; ++n) _Pragma("unroll") for (int k = 0; k < 2; ++k) dst[n][k] = *(const PG8_LAS bf16x8*)(lds + PG8_SB(b, h) + boff + n * 2048 + k * 1024); } while (0)
#define PG8_MMA(ai, bj, At, Bt) do { __builtin_amdgcn_s_setprio(1); _Pragma("unroll") for (int m = 0; m < 4; ++m) _Pragma("unroll") for (int n = 0; n < 2; ++n) _Pragma("unroll") for (int k = 0; k < 2; ++k) \
        acc[ai][bj][m][n] = __builtin_amdgcn_mfma_f32_16x16x32_bf16(Bt[n][k], At[m][k], acc[ai][bj][m][n], 0, 0, 0); __builtin_amdgcn_s_setprio(0); } while (0)
#define PG8_WAIT_V(n) asm volatile("s_waitcnt vmcnt(" #n ")" ::: "memory")
#define PG8_WAIT_L(n) asm volatile("s_waitcnt lgkmcnt(" #n ")" ::: "memory")
#define PG8_BAR __builtin_amdgcn_s_barrier()
#define PG8_SCHED __builtin_amdgcn_sched_barrier(0)
    Unit cur, nxt; int ui = 0;
    if (!S.next(0, cur)) return;
    f32x4 acc[2][2][4][2];
#pragma unroll
    for (int a = 0; a < 2; ++a)
#pragma unroll
        for (int b = 0; b < 2; ++b)
#pragma unroll
            for (int m = 0; m < 4; ++m)
#pragma unroll
                for (int n = 0; n < 2; ++n) acc[a][b][m][n] = (f32x4){0.f, 0.f, 0.f, 0.f};
    bf16x8 At[4][2], B0[2][2], B1[2][2];
    const char* cA = (const char*)g.A + (size_t)cur.pm * tstep; const char* cB = (const char*)g.Bt + (size_t)cur.pn * tstep;
    S.a_ready(cur);
    if constexpr (SP2) {
        if constexpr (Side::ON) side.prime();
        PG8_STAGE(PG8_SB(0, 0), cB, voffB); PG8_STAGE(PG8_SB(0, 1), cB + hstepB, voffB); PG8_STAGE(PG8_SA(0, 0), cA, voffA); PG8_STAGE(PG8_SA(0, 1), cA + hstep, voffA);
        if (wr == 1) PG8_BAR;
        PG8_WAIT_V(2); PG8_BAR;
        PG8_STAGE(PG8_SB(1, 0), cB + kstep, voffB); PG8_STAGE(PG8_SA(1, 0), cA + kstep, voffA); PG8_STAGE(PG8_SB(1, 1), cB + hstepB + kstep, voffB);
        PG8_WAIT_V(6); PG8_BAR;
        if constexpr (Side::ON) side.fetch();
    } else {
        PG8_STAGE(PG8_SB(0, 0), cB, voffB); PG8_STAGE(PG8_SA(0, 0), cA, voffA); PG8_STAGE(PG8_SB(0, 1), cB + hstepB, voffB); PG8_STAGE(PG8_SA(0, 1), cA + hstep, voffA);
        if (wr == 1) PG8_BAR;
        PG8_WAIT_V(4); PG8_BAR;
        PG8_STAGE(PG8_SB(1, 0), cB + kstep, voffB); PG8_STAGE(PG8_SA(1, 0), cA + kstep, voffA); PG8_STAGE(PG8_SB(1, 1), cB + hstepB + kstep, voffB);
        PG8_WAIT_V(6); PG8_BAR;
    }
    for (;;) {
        const bool has_next = S.next(ui + 1, nxt);
        const char* nA = has_next ? (const char*)g.A + (size_t)nxt.pm * tstep : cA; const char* nB = has_next ? (const char*)g.Bt + (size_t)nxt.pn * tstep : cB;
        for (int t = 0; t < nt; t += 2) {
            const bool last = (t == nt - 2);
            const char* a1 = cA + (size_t)(t + 1) * kstep;
            const char* a2 = last ? nA : cA + (size_t)(t + 2) * kstep; const char* b2 = last ? nB : cB + (size_t)(t + 2) * kstep;
            const char* a3 = a2 + kstep; const char* b3 = b2 + kstep;
            if (last && has_next) S.a_ready(nxt);
            if constexpr (SP2) {
            PG8_LDB(B0, 0, 0); PG8_LDB(B1, 0, 1); PG8_SCHED; PG8_LDA(At, 0, 0); PG8_STAGE(PG8_SA(1, 1), a1 + hstep, voffA);
            if constexpr (Side::ON) { side.step(ui * (nt >> 1) + (t >> 1)); PG8_WAIT_V(9); } else PG8_WAIT_V(8);
            PG8_WAIT_L(0); PG8_BAR; PG8_MMA(0, 0, At, B0); PG8_MMA(0, 1, At, B1); PG8_BAR; PG8_SCHED;
            PG8_LDA(At, 0, 1); PG8_STAGE(PG8_SB(0, 0), b2, voffB); PG8_STAGE(PG8_SB(0, 1), b2 + hstepB, voffB); PG8_STAGE(PG8_SA(0, 0), a2, voffA);
            if constexpr (Side::ON) PG8_WAIT_V(9); else PG8_WAIT_V(8);
            PG8_WAIT_L(0); PG8_BAR; PG8_MMA(1, 0, At, B0); PG8_MMA(1, 1, At, B1); PG8_BAR; PG8_SCHED;
            PG8_LDB(B0, 1, 0); PG8_LDB(B1, 1, 1); PG8_SCHED; PG8_LDA(At, 1, 0); PG8_STAGE(PG8_SA(0, 1), a2 + hstep, voffA);
            PG8_WAIT_V(8); PG8_WAIT_L(0); PG8_BAR; PG8_MMA(0, 0, At, B0); PG8_MMA(0, 1, At, B1); PG8_BAR; PG8_SCHED;
            PG8_LDA(At, 1, 1); if constexpr (Side::ON) side.fetch();
            PG8_STAGE(PG8_SB(1, 0), b3, voffB); PG8_STAGE(PG8_SB(1, 1), b3 + hstepB, voffB); PG8_STAGE(PG8_SA(1, 0), a3, voffA);
            PG8_WAIT_V(8); PG8_WAIT_L(0); PG8_BAR; PG8_MMA(1, 0, At, B0); PG8_MMA(1, 1, At, B1); PG8_BAR; PG8_SCHED;
            } else {
            PG8_LDB(B0, 0, 0); PG8_SCHED; PG8_LDA(At, 0, 0); PG8_STAGE(PG8_SA(1, 1), a1 + hstep, voffA);
            PG8_WAIT_L(8); PG8_BAR; PG8_WAIT_L(0); PG8_MMA(0, 0, At, B0); PG8_BAR; PG8_SCHED;
            PG8_LDB(B1, 0, 1); PG8_STAGE(PG8_SB(0, 0), b2, voffB);
            PG8_BAR; PG8_WAIT_L(0); PG8_MMA(0, 1, At, B1); PG8_BAR;
            PG8_LDA(At, 0, 1); PG8_STAGE(PG8_SA(0, 0), a2, voffA);
            PG8_BAR; PG8_WAIT_L(0); PG8_MMA(1, 0, At, B0); PG8_BAR; PG8_SCHED;
            PG8_STAGE(PG8_SB(0, 1), b2 + hstepB, voffB);
            PG8_WAIT_V(6); PG8_BAR; PG8_MMA(1, 1, At, B1); PG8_BAR;
            PG8_LDB(B0, 1, 0); PG8_SCHED; PG8_LDA(At, 1, 0); PG8_STAGE(PG8_SA(0, 1), a2 + hstep, voffA);
            PG8_WAIT_L(8); PG8_BAR; PG8_WAIT_L(0); PG8_MMA(0, 0, At, B0); PG8_BAR; PG8_SCHED;
            PG8_LDB(B1, 1, 1); PG8_STAGE(PG8_SB(1, 0), b3, voffB);
            PG8_BAR; PG8_WAIT_L(0); PG8_MMA(0, 1, At, B1); PG8_BAR;
            PG8_LDA(At, 1, 1); PG8_STAGE(PG8_SA(1, 0), a3, voffA);
            PG8_BAR; PG8_WAIT_L(0); PG8_MMA(1, 0, At, B0); PG8_BAR; PG8_SCHED;
            PG8_STAGE(PG8_SB(1, 1), b3 + hstepB, voffB);
            PG8_WAIT_V(6); PG8_BAR; PG8_MMA(1, 1, At, B1); PG8_BAR;
            }
        }
        if constexpr (ALIGN_EPI) { if (wr == 0) PG8_BAR; }
        if constexpr (!Epi::AFTER_DRAIN) { E(acc, cur, ui, wr, wc, fr, fq); S.done(cur); }
        if (!has_next) break;
#pragma unroll
        for (int a = 0; a < 2; ++a)
#pragma unroll
            for (int b = 0; b < 2; ++b)
#pragma unroll
                for (int m = 0; m < 4; ++m)
#pragma unroll
                    for (int n = 0; n < 2; ++n) acc[a][b][m][n] = (f32x4){0.f, 0.f, 0.f, 0.f};
        cur = nxt; cA = nA; cB = nB; ++ui;
        if constexpr (ALIGN_EPI) { if (wr == 1) PG8_BAR; }
    }
    u32x4 res[2][4][2];
    if constexpr (Epi::AFTER_DRAIN) E.prefetch(cur, wr, wc, fr, fq, res);
    PG8_WAIT_V(0);
    if constexpr (!ALIGN_EPI) { if (wr == 0) PG8_BAR; }
    PG8_BAR;
    if constexpr (Epi::AFTER_DRAIN) { E.fused(acc, res, cur, wr, wc, fr, fq, lds, wid, lane); S.done(cur); }
#undef PG8_SA
#undef PG8_SB
#undef PG8_STAGE
#undef PG8_LDA
#undef PG8_LDB
#undef PG8_MMA
#undef PG8_WAIT_V
#undef PG8_WAIT_L
#undef PG8_BAR
#undef PG8_SCHED
}
}

constexpr int NWAVES = 8;
#ifndef MK_ONE_LAUNCH
#define MK_ONE_LAUNCH 1
#endif
#ifndef COPY_IN_P0
#define COPY_IN_P0 0
#endif
#ifndef ATT_NMOVE
#define ATT_NMOVE (COPY_IN_P0 ? 0 : 3)
#endif
#ifndef ATT_V4
#define ATT_V4 1
#endif
#ifndef ATT4_MOVERS
#define ATT4_MOVERS 4
#endif
#ifndef GEMM_ALIGN
#define GEMM_ALIGN true
#endif
#ifndef GEMM_SP2
#define GEMM_SP2 true
#endif
#ifndef STAGGER
#define STAGGER 1
#endif
#ifndef STAGGER_MODE
#define STAGGER_MODE 0
#endif
#define STAGGER_PRED(v) (STAGGER_MODE == 0 ? ((v) & 1) : STAGGER_MODE == 1 ? (((v) & 3) == 0) : STAGGER_MODE == 2 ? (((v) >> 1) & 1) : (((v) % 3) == 0))
#ifndef CONV_ORDER
#define CONV_ORDER 0
#endif
#ifndef CONV_IN_P0
#define CONV_IN_P0 0
#endif
constexpr int NB = 4, S = 2048, D = 2048, DEPTH = 4, SB = 8, WBUF = 2048, H = 16, HD = 64, DA = 1024, DC = 1024, DIN = 6144, DFF = 8192;
constexpr int M = NB * S;
constexpr float EPS = 1e-6f;
constexpr float QSCALE = 0.125f * 1.4426950408889634f;
constexpr float LOG2E = 1.4426950408889634f;
constexpr int NPH = 1 + 6 * DEPTH;

constexpr size_t O_Y = 0, O_YS = 16777216, O_KP = 16793600, O_VP = 50348032, O_CP = 83902464, O_KS = 83935232, O_VS = 151044096, O_CS = 218152960, O_END = 218218496;

constexpr size_t MiB = 1u << 20;
constexpr size_t WS_CTL = 0, CTL_ZERO_BYTES = 64 * 1024;
constexpr size_t WS_WIN = 1 * MiB;
constexpr size_t WS_WOUT = WS_WIN + 96 * MiB;
constexpr size_t WS_WUP = WS_WOUT + 32 * MiB;
constexpr size_t WS_WDN = WS_WUP + 128 * MiB;
constexpr size_t WS_XB = WS_WDN + 128 * MiB;
constexpr size_t WS_Q = WS_XB + 32 * MiB, WS_K = WS_Q + 16 * MiB, WS_V = WS_K + 16 * MiB;
constexpr size_t WS_PC = WS_V + 16 * MiB;
constexpr size_t WS_OP = WS_PC + 48 * MiB;
constexpr size_t WS_ML = WS_OP + 96 * MiB;
constexpr size_t WS_MIX = WS_ML + 3 * MiB;
constexpr size_t WS_HB = WS_MIX + 32 * MiB;
constexpr size_t WS_SSQA = WS_HB + 128 * MiB;
constexpr size_t WS_SSQB = WS_SSQA + 256 * 1024;
constexpr size_t WS_SMALL = WS_SSQB + 256 * 1024 + 512 * 1024;
constexpr size_t WS_XS = WS_SMALL;
constexpr size_t WS_PS = WS_XS + 64 * 1024;
constexpr size_t WS_OS = WS_PS + 192 * 1024;
constexpr size_t WS_MIXS = WS_OS + 32 * 1024;
constexpr size_t WS_AS = WS_MIXS + 64 * 1024;
constexpr size_t WS_BT = WS_AS + 256 * 1024;
constexpr size_t WS_GN = WS_BT + 32 * 1024;
constexpr size_t WS_CW = WS_GN + 4 * 1024;
constexpr size_t WS_SC = WS_CW + 64 * 1024;
constexpr size_t WS_SINK = WS_SMALL + 1 * MiB;
constexpr size_t WS_END = WS_SINK + 8 * MiB;
static_assert(WS_SC + 256 * 1024 <= WS_END, "small buffers");
constexpr int CW_BAR = 4096;

#ifndef EARLY_WBL2
#define EARLY_WBL2 0
#endif
#if EARLY_WBL2
#define EARLY_WB() asm volatile("buffer_wbl2 sc1" ::: "memory")
#else
#define EARLY_WB() do {} while (0)
#endif
#ifndef CONV_SKEW
#define CONV_SKEW 3
#endif
#ifndef COPY_IN_G4
#define COPY_IN_G4 0
#endif
#ifndef COPY_BOTH
#define COPY_BOTH 0
#endif
#ifndef CONV_RING
#define CONV_RING 0
#endif
#ifndef CONV_DP
#define CONV_DP 5
#endif
constexpr int LDS_BYTES = 147456;
constexpr int LDSCTL_OFF = LDS_BYTES - 512;
constexpr int MISC_OFF = LDSCTL_OFF;
constexpr int RS_TAB_OFF = 131072;
static_assert(RS_TAB_OFF + 4 * 256 * 4 <= LDSCTL_OFF, "LDS map");

#define GAS __attribute__((address_space(1)))
#define LAS __attribute__((address_space(3)))
typedef unsigned short bf16;
typedef unsigned v4u __attribute__((ext_vector_type(4)));
typedef unsigned v2u __attribute__((ext_vector_type(2)));
typedef float f32x4 __attribute__((ext_vector_type(4)));
typedef float f32x2 __attribute__((ext_vector_type(2)));
typedef float f32x16 __attribute__((ext_vector_type(16)));
typedef short bf16x8 __attribute__((ext_vector_type(8)));
typedef short s16x4 __attribute__((ext_vector_type(4)));
typedef GAS unsigned gu32;
#define RLX_AGENT __ATOMIC_RELAXED, __HIP_MEMORY_SCOPE_AGENT
using pg8::cvt_pk_bf16;
using pg8::pack8;

#define XB_TMO      128
#define XB_XCNT(j)  (256  + 64 * (j))
#define XB_XSUB(j)  (1280 + 64 * (j))
#define XB_XGEN(j)  (2304 + 64 * (j))
#define XB_TOP      3328
#define XB_TOPGEN   3392
#define XCD_BAR_WORDS 3456
#define XB_SPIN_CAP (1u << 18)

__device__ __forceinline__ unsigned xb_ld(unsigned* p)              { return __hip_atomic_load(p, __ATOMIC_RELAXED, __HIP_MEMORY_SCOPE_AGENT); }
__device__ __forceinline__ unsigned xb_add(unsigned* p, unsigned v) { return __hip_atomic_fetch_add(p, v, __ATOMIC_RELAXED, __HIP_MEMORY_SCOPE_AGENT); }
__device__ __forceinline__ unsigned xb_xcc_id() { return (unsigned)__builtin_amdgcn_s_getreg((3 << 11) | 20) & 0xFu; }
#define XB_SPIN(cond, bar) do { unsigned _sp = 0; while (cond) { __builtin_amdgcn_s_sleep(1); \
    if ((++_sp & 255u) == 0u) { if (xb_ld(&(bar)[XB_TMO])) break; if (_sp > XB_SPIN_CAP) { atomicAdd(&(bar)[XB_TMO], 1u); break; } } } } while (0)

__device__ __forceinline__ bool xb_lane0() { return __builtin_amdgcn_mbcnt_hi(~0u, __builtin_amdgcn_mbcnt_lo(~0u, 0u)) == 0u; }
struct XcdBarrier {
    int wave;
    unsigned* bar; unsigned x;
    volatile LAS unsigned* st;
};

__device__ __forceinline__ XcdBarrier xcd_barrier_post(unsigned* bar, volatile LAS unsigned* st, int wave) {
    XcdBarrier b; b.wave = wave; b.bar = bar; b.x = xb_xcc_id(); b.st = st;
    if (wave == 0 && xb_lane0()) (void)xb_add(&bar[XB_XCNT(b.x)], 1u);
    return b;
}
__device__ __forceinline__ void xcd_barrier_complete(unsigned* bar, unsigned x, unsigned& nloc, unsigned& nx) {
    const unsigned G = gridDim.x * gridDim.y * gridDim.z;
    unsigned sum, cnt, mine, sp = 0u;
    for (;;) {
        sum = 0u; cnt = 0u; mine = 0u;
#pragma unroll
        for (unsigned j = 0; j < 16; ++j) { const unsigned c = xb_ld(&bar[XB_XCNT(j)]); sum += c; cnt += (c > 0u) ? 1u : 0u; mine = (j == x) ? c : mine; }
        if (sum == G) break;
        __builtin_amdgcn_s_sleep(1);
        if ((++sp & 255u) == 0u) { if (xb_ld(&bar[XB_TMO])) break; if (sp > XB_SPIN_CAP) { atomicAdd(&bar[XB_TMO], 1u); break; } }
    }
    nloc = mine > 0u ? mine : 1u; nx = cnt > 0u ? cnt : 1u;
}

__device__ __forceinline__ void xcd_barrier(const XcdBarrier& b) {
    asm volatile("s_waitcnt vmcnt(0)" ::: "memory");
    __syncthreads();
    if (b.wave == 0 && xb_lane0()) {
        unsigned* bar = b.bar;
        __builtin_amdgcn_s_waitcnt(0);
        unsigned nloc = b.st[0], nx = b.st[1];
        if (nloc == 0u) { xcd_barrier_complete(bar, b.x, nloc, nx); b.st[0] = nloc; b.st[1] = nx; }
        const unsigned old = xb_add(&bar[XB_XSUB(b.x)], 1u);
        const unsigned gen = old / nloc;
        if (old + 1u == (gen + 1u) * nloc) {
            __builtin_amdgcn_fence(__ATOMIC_RELEASE, "agent");
            asm volatile("s_waitcnt vmcnt(0)" ::: "memory");
            const unsigned og = xb_add(&bar[XB_TOP], 1u);
            const unsigned tg = og / nx;
            if (og + 1u == (tg + 1u) * nx) xb_add(&bar[XB_TOPGEN], 1u);
            else XB_SPIN(xb_ld(&bar[XB_TOPGEN]) == tg, bar);
            __builtin_amdgcn_fence(__ATOMIC_ACQUIRE, "agent");
            xb_add(&bar[XB_XGEN(b.x)], 1u);
            asm volatile("s_waitcnt vmcnt(0)" ::: "memory");
        } else {
            XB_SPIN(xb_ld(&bar[XB_XGEN(b.x)]) == gen, bar);
            __builtin_amdgcn_fence(__ATOMIC_ACQUIRE, "agent");
            asm volatile("s_waitcnt vmcnt(0)" ::: "memory");
        }
    }
    __syncthreads();
}


struct Frame {
    LAS unsigned char* lds;
    int tid, lane, wave, vcu, G;
    unsigned char* ws; float* out;
    const float *x_prompt, *state_k, *state_v;
};
template <class T> __device__ __forceinline__ T* opq(T* p) { GAS T* g = (GAS T*)p; asm volatile("" : "+s"(g)); return (T*)g; }
__device__ __forceinline__ int opqv(int x) { asm volatile("" : "+v"(x)); return x; }
__device__ __forceinline__ int fresh_tid(int wave) { int l = (int)__builtin_amdgcn_mbcnt_hi(~0u, __builtin_amdgcn_mbcnt_lo(~0u, 0u)); asm volatile("" : "+v"(l)); return 64 * wave + l; }
#define W_WIN(w) ((bf16*)((w) + WS_WIN))
#define W_WOUT(w) ((bf16*)((w) + WS_WOUT))
#define W_WUP(w) ((bf16*)((w) + WS_WUP))
#define W_WDN(w) ((bf16*)((w) + WS_WDN))
#define W_XB(w) ((bf16*)((w) + WS_XB))
#define W_Q(w) ((bf16*)((w) + WS_Q))
#define W_K(w) ((bf16*)((w) + WS_K))
#define W_V(w) ((bf16*)((w) + WS_V))
#define W_PC(w) ((bf16*)((w) + WS_PC))
#define W_MIX(w) ((bf16*)((w) + WS_MIX))
#define W_HB(w) ((bf16*)((w) + WS_HB))
#define W_OPB(w) ((bf16*)((w) + WS_OP))
#define W_ML(w) ((float*)((w) + WS_ML))
#define W_SSQA(w) ((float*)((w) + WS_SSQA))
#define W_SSQB(w) ((float*)((w) + WS_SSQB))
#define W_XS(w) ((float*)((w) + WS_XS))
#define W_PS(w) ((float*)((w) + WS_PS))
#define W_OS(w) ((float*)((w) + WS_OS))
#define W_MIXS(w) ((float*)((w) + WS_MIXS))
#define W_AS(w) ((float*)((w) + WS_AS))
#define W_BT(w) ((float*)((w) + WS_BT))
#define W_GN(w) ((float*)((w) + WS_GN))
#define W_CW(w) ((float*)((w) + WS_CW))
#define W_SC(w) ((float*)((w) + WS_SC))

__device__ __forceinline__ float wave_sum(float v) {
#pragma unroll
    for (int o = 1; o < 64; o <<= 1) v += __shfl_xor(v, o);
    return v;
}
__device__ __forceinline__ float wave_max(float v) {
#pragma unroll
    for (int o = 1; o < 64; o <<= 1) v = fmaxf(v, __shfl_xor(v, o));
    return v;
}
__device__ __forceinline__ float max3f(float a, float b, float c) { float r; asm("v_max3_f32 %0, %1, %2, %3" : "=v"(r) : "v"(a), "v"(b), "v"(c)); return r; }
#define LDS_WAIT() asm volatile("s_waitcnt lgkmcnt(0)" ::: "memory")
#define WG_BAR() do { asm volatile("s_waitcnt vmcnt(0) lgkmcnt(0)" ::: "memory"); __builtin_amdgcn_s_barrier(); asm volatile("" ::: "memory"); } while (0)

struct Args { const float* in[17]; float* out; unsigned char* ws; int ph_lo, ph_hi; };
struct P0Item { const float* W; const float* g; bf16* WT; int K, N, k0, n0, perm; };
__device__ __forceinline__ int win_row(int col) {
    if (col < 3072) return col;
    if (col < 4096) { const int c = col - 3072; return 3072 + 256 * (c >> 7) + 64 * ((c >> 5) & 3) + (c & 31); }
    if (col < 5120) return 5120 + (col - 4096);
    const int c = col - 5120; return 3072 + 256 * (c >> 7) + 64 * ((c >> 5) & 3) + 32 + (c & 31);
}
__device__ __forceinline__ void p0_item_load(const P0Item& d, int lane, f32x4 (&v)[8], float& gk) {
#pragma unroll
    for (int i = 0; i < 8; ++i) v[i] = __builtin_nontemporal_load((const f32x4*)(d.W + (size_t)(d.k0 + 8 * i + (lane >> 3)) * d.N + d.n0 + (lane & 7) * 4));
    gk = d.g ? d.g[d.k0 + lane] : 1.f;
}
__device__ __forceinline__ void p0_item_store(const P0Item& d, int lane, const f32x4 (&v)[8], float gk, LAS float* scr) {
#pragma unroll
    for (int i = 0; i < 8; ++i) { const int kk = 8 * i + (lane >> 3); const float gg = __shfl(gk, kk);
        LAS float* s = scr + kk * 33 + (lane & 7) * 4; s[0] = v[i][0] * gg; s[1] = v[i][1] * gg; s[2] = v[i][2] * gg; s[3] = v[i][3] * gg; }
    LDS_WAIT(); asm volatile("" ::: "memory");
    const int c = lane & 7;
#pragma unroll
    for (int j = 0; j < 4; ++j) { const int n = (lane >> 3) + 8 * j; const LAS float* s = scr + (8 * c) * 33 + n;
        v4u o; o.x = cvt_pk_bf16(s[0 * 33], s[1 * 33]); o.y = cvt_pk_bf16(s[2 * 33], s[3 * 33]); o.z = cvt_pk_bf16(s[4 * 33], s[5 * 33]); o.w = cvt_pk_bf16(s[6 * 33], s[7 * 33]);
        *(GAS v4u*)(d.WT + (size_t)(d.perm ? win_row(d.n0 + n) : d.n0 + n) * d.K + d.k0 + 8 * c) = o; }
    LDS_WAIT(); asm volatile("" ::: "memory");
}
__device__ __forceinline__ int t5_bucket(int dist) {
    if (dist < 16) return dist;
    int b = 16;
    b += dist >= 22; b += dist >= 30; b += dist >= 40; b += dist >= 54; b += dist >= 73; b += dist >= 99; b += dist >= 134; b += dist >= 182;
    b += dist >= 246; b += dist >= 332; b += dist >= 450; b += dist >= 609; b += dist >= 825; b += dist >= 1117; b += dist >= 1513;
    return b;
}
constexpr int I_IN = (D / 64) * (DIN / 32), I_OUT = (D / 64) * (D / 32), I_UP = (D / 64) * (DFF / 32), I_DN = (DFF / 64) * (D / 32);
__device__ __forceinline__ int conv_count(int stage) { return stage == 0 ? I_IN : I_OUT + I_UP + I_DN + (stage < DEPTH ? I_IN : 0); }
__device__ __forceinline__ void p0_item_desc(const Args& A, unsigned char* w, int stage, int it, P0Item& d) {
    int l = stage == 0 ? 0 : stage - 1, r = it, mat = 0;
    if (stage != 0) { if (r < I_OUT) mat = 1; else if ((r -= I_OUT) < I_UP) mat = 2; else if ((r -= I_UP) < I_DN) mat = 3; else { r -= I_DN; mat = 0; l += 1; } }
    d.perm = mat == 0;
    if (mat == 0) { d.W = A.in[7] + (size_t)l * D * DIN; d.K = D; d.N = DIN; d.g = A.in[6] + l * D; d.WT = W_WIN(w) + (size_t)l * DIN * D; }
    else if (mat == 1) { d.W = A.in[13] + (size_t)l * D * D; d.K = D; d.N = D; d.g = nullptr; d.WT = W_WOUT(w) + (size_t)l * D * D; }
    else if (mat == 2) { d.W = A.in[15] + (size_t)l * D * DFF; d.K = D; d.N = DFF; d.g = A.in[14] + l * D; d.WT = W_WUP(w) + (size_t)l * DFF * D; }
    else { d.W = A.in[16] + (size_t)l * DFF * D; d.K = DFF; d.N = D; d.g = nullptr; d.WT = W_WDN(w) + (size_t)l * D * DFF; }
    const int nblk = d.N / 32, kb = r / nblk; d.k0 = 64 * kb; d.n0 = 32 * (r - kb * nblk);
    if (mat == 1) d.g = (d.k0 < DA ? A.in[11] + l * DA : A.in[12] + l * DC - DA);
}
__device__ __forceinline__ void conv_run(const Args& A, unsigned char* w, int stage, int it0, int stride, int lane, LAS float* scr) {
    const int n = conv_count(stage);
    P0Item dc, dn; f32x4 vc[8], vn[8]; float gc = 1.f, gn = 1.f;
    int it = it0;
    if (it < n) { p0_item_desc(A, w, stage, it, dc); p0_item_load(dc, lane, vc, gc); }
    for (; it < n; it += stride) {
        const bool more = it + stride < n;
        if (more) { p0_item_desc(A, w, stage, it + stride, dn); p0_item_load(dn, lane, vn, gn); }
        p0_item_store(dc, lane, vc, gc, scr);
        if (more) { dc = dn; gc = gn;
#pragma unroll
            for (int i = 0; i < 8; ++i) vc[i] = vn[i]; }
    }
}
struct CDesc { const float* W; bf16* WT; int N, K, goff; };
__device__ __forceinline__ void cdesc(const Args& A, unsigned char* w, int stage, int it, int sinkoff, CDesc& d) {
    if (it < 0) { d.W = A.in[7]; d.N = 0; d.WT = (bf16*)(w + WS_SINK) + sinkoff; d.K = 64; d.goff = 3 * 2048; return; }
    int l = stage == 0 ? 0 : stage - 1, r = it, mat = 0;
    if (stage != 0) { if (r < I_OUT) mat = 1; else if ((r -= I_OUT) < I_UP) mat = 2; else if ((r -= I_UP) < I_DN) mat = 3; else { r -= I_DN; mat = 0; l += 1; } }
    const float* Wb; bf16* WTb; int K, N;
    if (mat == 0) { Wb = A.in[7] + (size_t)l * D * DIN; K = D; N = DIN; WTb = W_WIN(w) + (size_t)l * DIN * D; }
    else if (mat == 1) { Wb = A.in[13] + (size_t)l * D * D; K = D; N = D; WTb = W_WOUT(w) + (size_t)l * D * D; }
    else if (mat == 2) { Wb = A.in[15] + (size_t)l * D * DFF; K = D; N = DFF; WTb = W_WUP(w) + (size_t)l * DFF * D; }
    else { Wb = A.in[16] + (size_t)l * DFF * D; K = DFF; N = D; WTb = W_WDN(w) + (size_t)l * D * DFF; }
    const int nblk = N / 32, kb = r / nblk, k0 = 64 * kb, n0 = 32 * (r - kb * nblk);
    d.W = Wb + (size_t)k0 * N + n0; d.N = N; d.K = K;
    d.WT = WTb + (size_t)(mat == 0 ? win_row(n0) : n0) * K + k0;
    d.goff = mat == 3 ? 3 * 2048 : mat * 2048 + k0;
}
__device__ __forceinline__ void conv_fill_gains(const Args& A, int stage, LAS float* gtab, int tid) {
    const int l = stage == 0 ? 0 : stage - 1, lin = stage == 0 ? 0 : (stage < DEPTH ? stage : DEPTH - 1);
    for (int e = tid; e < 4 * 2048; e += NWAVES * 64) { const int t = e >> 11, k = e & 2047;
        gtab[e] = t == 0 ? A.in[6][lin * D + k] : t == 1 ? (k < DA ? A.in[11][l * DA + k] : A.in[12][l * DC + k - DA]) : t == 2 ? A.in[14][l * D + k] : 1.f; }
}
__device__ __forceinline__ int conv_ticket(LAS unsigned* q, int lane);
template <int DP>
__device__ __forceinline__ void conv_ring(const Args& A, unsigned char* w, int stage, int vcu, int G, int lane, const LAS float* gtab, LAS unsigned* q, int gwave) {
    const int nk = conv_count(stage) / G;
    const int lq = lane & 7, lc = lane >> 3, bp = 4 * ((lane >> 3) + 8 * (lane & 7)), sinkoff = gwave * 2048;
    f32x4 v[DP][8]; int kt[DP];
#define CR_LOAD(s_) do { CDesc d_; cdesc(A, w, stage, kt[s_] < nk ? vcu * nk + kt[s_] : -1, sinkoff, d_); const float* wp_ = d_.W + (size_t)(8 * lc) * d_.N + 4 * lq; \
        _Pragma("unroll") for (int i = 0; i < 8; ++i) v[s_][i] = __builtin_nontemporal_load((const f32x4*)(wp_ + (size_t)i * d_.N)); } while (0)
#define CR_STORE(s_) do { CDesc d_; cdesc(A, w, stage, kt[s_] < nk ? vcu * nk + kt[s_] : -1, sinkoff, d_); \
        const LAS f32x4* gp_ = (const LAS f32x4*)(gtab + d_.goff + 8 * lc); const f32x4 g0_ = gp_[0], g1_ = gp_[1]; \
        bf16* op_ = d_.WT + (size_t)(4 * lc) * d_.K + 8 * lq;              \
        _Pragma("unroll") for (int e = 0; e < 4; ++e) { v4u o_; \
            o_.x = (unsigned)__builtin_amdgcn_ds_bpermute(bp, (int)cvt_pk_bf16(v[s_][0][e] * g0_[0], v[s_][1][e] * g0_[1])); \
            o_.y = (unsigned)__builtin_amdgcn_ds_bpermute(bp, (int)cvt_pk_bf16(v[s_][2][e] * g0_[2], v[s_][3][e] * g0_[3])); \
            o_.z = (unsigned)__builtin_amdgcn_ds_bpermute(bp, (int)cvt_pk_bf16(v[s_][4][e] * g1_[0], v[s_][5][e] * g1_[1])); \
            o_.w = (unsigned)__builtin_amdgcn_ds_bpermute(bp, (int)cvt_pk_bf16(v[s_][6][e] * g1_[2], v[s_][7][e] * g1_[3])); \
            *(GAS v4u*)(op_ + (size_t)e * d_.K) = o_; } } while (0)
#pragma unroll
    for (int s = 0; s < DP; ++s) {
        kt[s] = conv_ticket(q, lane);
        { bf16* sk = (bf16*)(w + WS_SINK) + sinkoff + (4 * lc) * 64 + 8 * lq;
#pragma unroll
          for (int e = 0; e < 4; ++e) *(GAS v4u*)(sk + e * 64) = (v4u){0u, 0u, 0u, 0u}; }
        CR_LOAD(s);
    }
    while (kt[0] < nk) {
#pragma unroll
        for (int s = 0; s < DP; ++s) { CR_STORE(s); kt[s] = conv_ticket(q, lane); CR_LOAD(s); }
    }
#undef CR_LOAD
#undef CR_STORE
}
__device__ __forceinline__ void p0_prologue(Frame& F, const Args& A) {
    unsigned char* w = F.ws;
    const int gw = F.vcu * NWAVES + F.wave, NGW = F.G * NWAVES;
#if CONV_RING
    { LAS float* gtab = (LAS float*)(F.lds + 1024); LAS unsigned* tq = (LAS unsigned*)F.lds;
      conv_fill_gains(A, 0, gtab, F.tid); if (F.tid == 0) tq[0] = 0u;
      WG_BAR();
      conv_ring<CONV_DP>(A, w, 0, F.vcu, F.G, F.lane, gtab, tq, gw); }
#else
    conv_run(A, w, 0, gw, NGW, F.lane, (LAS float*)(F.lds + F.wave * 8448));
#endif
    for (int m = gw; m < M; m += NGW) {
        const GAS f32x4* xr = (const GAS f32x4*)(A.in[0] + (size_t)m * D) + F.lane; GAS v2u* o8 = (GAS v2u*)(W_XB(w) + (size_t)m * D) + F.lane;
        float s = 0.f;
#pragma unroll
        for (int j = 0; j < 8; ++j) { const f32x4 v = xr[64 * j]; s += (v[0] * v[0] + v[1] * v[1]) + (v[2] * v[2] + v[3] * v[3]); v2u pw; pw.x = cvt_pk_bf16(v[0], v[1]); pw.y = cvt_pk_bf16(v[2], v[3]); o8[64 * j] = pw; }
        s = wave_sum(s);
        if (F.lane < 8) W_SSQA(w)[(size_t)m * 8 + F.lane] = F.lane == 0 ? s : 0.f;
    }
    const int gt = F.vcu * (NWAVES * 64) + F.tid, NGT = F.G * NWAVES * 64;
    for (int i = gt; i < SB * D; i += NGT) W_XS(w)[i] = A.in[1][i];
    for (int i = gt; i < DEPTH * 128; i += NGT) { const int l = i >> 7, r = i & 127; W_GN(w)[i] = r < 64 ? A.in[8][l * 64 + r] : A.in[9][l * 64 + r - 64]; }
    for (int i = gt; i < DEPTH * 3 * DC; i += NGT) W_CW(w)[i] = A.in[10][i];
    for (int i = gt; i < DEPTH * SB * 2 * DC; i += NGT) W_SC(w)[i] = A.in[4][i];
    for (int i = gt; i < 3 * 16 * 129; i += NGT) { const int c = i / (16 * 129), r = i - c * (16 * 129), h = r / 129, j = r - h * 129; W_BT(w)[i] = A.in[5][t5_bucket(j << (2 * c)) * 16 + h] * LOG2E; }
#if COPY_IN_P0
    { constexpr int ROWV = 1024 / 4, PER = (WBUF - 1) * ROWV, TOT = DEPTH * SB * PER;
      for (int i0 = gt; i0 < 2 * TOT; i0 += 8 * NGT) { f32x4 v[8];
#pragma unroll
          for (int u = 0; u < 8; ++u) { const int i = i0 + u * NGT; if (i < 2 * TOT) { const int kv = i >= TOT, r = i - kv * TOT, lb = r / PER, e = r - lb * PER;
              v[u] = __builtin_nontemporal_load((const f32x4*)(kv ? A.in[3] : A.in[2]) + (size_t)lb * (WBUF * ROWV) + ROWV + e); } }
#pragma unroll
          for (int u = 0; u < 8; ++u) { const int i = i0 + u * NGT; if (i < 2 * TOT) { const int kv = i >= TOT, r = i - kv * TOT, lb = r / PER, e = r - lb * PER;
              __builtin_nontemporal_store(v[u], (f32x4*)(F.out + (kv ? O_VS : O_KS)) + (size_t)lb * (WBUF * ROWV) + e); } } } }
#endif
}

template <int MODE, int K, int N>
__device__ __forceinline__ void sgemv(Frame& F, const float* A, const bf16* Wt, float* out, float* yout) {
    constexpr int NPW = N / 256, NG = (NPW + 15) / 16, KW = K / 8, STEPS = KW / 32;
    LAS float* red = (LAS float*)F.lds;
    LAS float* sq = (LAS float*)(F.lds + 8 * NG * 1024);
    const int lane = F.lane, wv = F.wave, fr = lane & 15, fq = lane >> 4;
    const int n0 = (F.vcu & 255) * NPW;
    {
        f32x4 acc[NG];
#pragma unroll
        for (int g = 0; g < NG; ++g) acc[g] = (f32x4){0.f, 0.f, 0.f, 0.f};
        float ssq = 0.f;
        const float* ap = A + (size_t)(fr & 7) * K + wv * KW + fq * 8;
        const bf16* wp[NG];
#pragma unroll
        for (int g = 0; g < NG; ++g) { const int nl = 16 * g + fr; wp[g] = Wt + (size_t)(n0 + (nl < NPW ? nl : NPW - 1)) * K + wv * KW + fq * 8; }
#pragma unroll 16
        for (int s = 0; s < STEPS; ++s) {
            v4u yw = {0u, 0u, 0u, 0u};
            if (fr < 8) { const f32x4 a0 = *(const f32x4*)(ap + 32 * s), a1 = *(const f32x4*)(ap + 32 * s + 4); yw = pack8(a0, a1);
                ssq += ((a0[0] * a0[0] + a0[1] * a0[1]) + (a0[2] * a0[2] + a0[3] * a0[3])) + ((a1[0] * a1[0] + a1[1] * a1[1]) + (a1[2] * a1[2] + a1[3] * a1[3])); }
#pragma unroll
            for (int g = 0; g < NG; ++g) { const bf16x8 X = *(const bf16x8*)(wp[g] + 32 * s); acc[g] = __builtin_amdgcn_mfma_f32_16x16x32_bf16(X, __builtin_bit_cast(bf16x8, yw), acc[g], 0, 0, 0); }
        }
#pragma unroll
        for (int g = 0; g < NG; ++g) *(LAS f32x4*)(red + (wv * NG + g) * 256 + lane * 4) = acc[g];
        if (MODE == 0 || MODE == 2) { ssq += __shfl_xor(ssq, 16); ssq += __shfl_xor(ssq, 32); if (lane < 8) sq[wv * 8 + lane] = ssq; }
    }
    float prev = 0.f;
    if ((MODE == 1 || MODE == 3) && F.tid < 8 * NPW) prev = out[(size_t)(F.tid & 7) * N + n0 + (F.tid >> 3)];
    WG_BAR();
    if (F.tid < 8 * NPW) {
        const int nl = F.tid >> 3, tok = F.tid & 7, g = nl >> 4, lp = ((nl & 15) >> 2) * 16 + tok, i = nl & 3;
        float v = 0.f;
#pragma unroll
        for (int ww = 0; ww < 8; ++ww) v += red[(ww * NG + g) * 256 + lp * 4 + i];
        float rs = 1.f;
        if (MODE == 0 || MODE == 2) { float q = 0.f;
#pragma unroll
            for (int ww = 0; ww < 8; ++ww) q += sq[ww * 8 + tok];
            rs = __builtin_amdgcn_rsqf(q * (1.0f / (float)K) + EPS); }
        float* op = out + (size_t)tok * N + n0 + nl;
        if (MODE == 0) *op = v * rs;
        else if (MODE == 2) { const float z = fmaxf(v * rs, 0.f); *op = z * z; }
        else { const float z = prev + v; *op = z; if (yout) yout[(size_t)tok * N + n0 + nl] = z; }
    }
}

constexpr int ATT_BT_BYTES = 48 * 192 * 4, ATT_V_BYTES = 32 * 192;
constexpr int NCP = 32;
__device__ __forceinline__ void attn_phase_prompt(Frame& F, unsigned char* w, float* out, int l, int mode = 3) {
    const int lane = F.lane, r = lane & 31, hh = lane >> 5;
    LAS float* btall = (LAS float*)F.lds;
    for (int e = F.tid; e < 48 * 192; e += NWAVES * 64) { const int t = e / 192, j = 160 - (e - t * 192); btall[e] = (j >= 0 && j <= 128) ? W_BT(w)[t * 129 + (j < 0 ? 0 : (j > 128 ? 128 : j))] : -1.0e30f; }
    WG_BAR();
    LAS unsigned char* vl = F.lds + ATT_BT_BYTES + F.wave * ATT_V_BYTES;
    const int trq = (lane & 15) >> 2, trp = lane & 3, g16 = (lane >> 4) & 1;
    LAS unsigned char* vtr0 = vl + (4 * hh + trq) * 192 + g16 * 32 + trp * 8;
    constexpr int NMOVE = ATT_NMOVE, NWORK = NWAVES - NMOVE;
    if (NMOVE > 0 && F.wave >= NWORK) {
        if (!(mode & 2)) return;
        const int mv = F.wave - NWORK;
        constexpr int CP_PER = (WBUF - 1) * 256, CP_HALF = SB * CP_PER, CP_TOT = 2 * CP_HALF, CP_ROWS = (CP_TOT + 63) / 64;
        for (int k0 = mv * NCP; k0 * F.G < CP_ROWS; k0 += (NMOVE > 0 ? NMOVE : 1) * NCP) {
            f32x4 cpv[NCP];
#pragma unroll
            for (int u = 0; u < NCP; ++u) { int ci = ((k0 + u) * F.G + F.vcu) * 64 + lane; ci = ci < CP_TOT ? ci : CP_TOT - 1;
                const int kv = ci >= CP_HALF, rr = ci - kv * CP_HALF, bb = rr / CP_PER, ee = rr - bb * CP_PER;
                cpv[u] = __builtin_nontemporal_load((const f32x4*)(kv ? F.state_v : F.state_k) + ((size_t)(l * SB + bb) * WBUF + 1) * 256 + ee); }
#pragma unroll
            for (int u = 0; u < NCP; ++u) { const int ci = ((k0 + u) * F.G + F.vcu) * 64 + lane;
                if (ci < CP_TOT) { const int kv = ci >= CP_HALF, rr = ci - kv * CP_HALF, bb = rr / CP_PER, ee = rr - bb * CP_PER;
                    __builtin_nontemporal_store(cpv[u], (f32x4*)(out + (kv ? O_VS : O_KS)) + ((size_t)(l * SB + bb) * WBUF) * 256 + ee); } }
        }
        return;
    }
    if (!(mode & 1)) return;
    const int ntile = (3 * (NB * H * 8) / F.G * 8 - F.wave + NWORK - 1) / NWORK;
#define TILE_SETUP(j_, C_, DSH_, RHO_, I0_, KB0_, HB_, BH_) do { const int t_ = F.wave + NWORK * (j_), i_ = t_ >> 3, c_ = i_ % 3, idx_ = (i_ / 3) * F.G + F.vcu; C_ = c_; DSH_ = 2 * c_; BH_ = idx_ >> 3; \
        const int f0_ = 256 * (idx_ & 7) + 32 * (t_ & 7); RHO_ = f0_ >> (11 - DSH_); I0_ = f0_ & ((2048 >> DSH_) - 1); KB0_ = I0_ >= 128 ? 0 : ((128 - I0_) >> 5); HB_ = (size_t)BH_ * 2048 * 64; } while (0)
#define LOAD_Q(QF, HB_, DSH_, RHO_, I0_) do { const char* qt_ = (const char*)(W_Q(w) + HB_ + (RHO_) * 64) + ((size_t)((I0_) << (DSH_))) * 128; const unsigned ql_ = ((unsigned)(r << (DSH_))) * 128u + 64u * hh; \
        _Pragma("unroll") for (int s = 0; s < 4; ++s) QF[s] = *(const bf16x8*)(qt_ + ql_ + 16 * s); } while (0)
#define LOAD_KV(KF, VV, kb_, HB_, DSH_, RHO_, I0_, KB0_) do { const int kbe_ = (kb_) < (KB0_) ? (KB0_) : (kb_); const size_t bo_ = ((size_t)(((I0_) - 128 + 32 * kbe_) << (DSH_))) * 128; \
        const char* kt_ = (const char*)(W_K(w) + HB_ + (RHO_) * 64) + bo_; const char* vt_ = (const char*)(W_V(w) + HB_ + (RHO_) * 64) + bo_; \
        const unsigned kl_ = ((unsigned)(r << (DSH_))) * 128u + 64u * hh, vl_ = ((unsigned)((lane >> 3) << (DSH_))) * 128u + 16u * (lane & 7), vs_ = (8u << (DSH_)) * 128u; \
        _Pragma("unroll") for (int s = 0; s < 4; ++s) KF[s] = *(const bf16x8*)(kt_ + kl_ + 16 * s); \
        _Pragma("unroll") for (int c4 = 0; c4 < 4; ++c4) VV[c4] = *(const v4u*)(vt_ + vl_ + c4 * vs_); } while (0)
#define VTR(p) __builtin_bit_cast(s16x4, __builtin_amdgcn_ds_read_tr16_b64_v4i16((LAS s16x4*)(p)))
#define VFRAG(db, s) ({ const s16x4 lo_ = VTR(vtr0 + (16 * (s)) * 192 + (db) * 64), hi_ = VTR(vtr0 + (16 * (s) + 8) * 192 + (db) * 64); (bf16x8){lo_[0], lo_[1], lo_[2], lo_[3], hi_[0], hi_[1], hi_[2], hi_[3]}; })
#define ATT_COMPUTE(KF, VV, kb_) do { \
        _Pragma("unroll") for (int c4 = 0; c4 < 4; ++c4) *(LAS v4u*)(vl + ((lane >> 3) + 8 * c4) * 192 + (lane & 7) * 16) = VV[c4]; \
        const int bidx = 32 - r + 4 * hh + 32 * (kb_);            \
        f32x16 sT; _Pragma("unroll") for (int k = 0; k < 16; ++k) sT[k] = bt[bidx + (k & 3) + 8 * (k >> 2)];        \
        _Pragma("unroll") for (int s = 0; s < 4; ++s) sT = __builtin_amdgcn_mfma_f32_32x32x16_bf16(KF[s], qf[s], sT, 0, 0, 0); \
        asm volatile("s_nop 15\n\ts_nop 7" : "+v"(sT));            \
        float mx = max3f(max3f(sT[0], sT[1], sT[2]), max3f(sT[3], sT[4], sT[5]), max3f(sT[6], sT[7], sT[8])); \
        mx = max3f(mx, max3f(sT[9], sT[10], sT[11]), max3f(sT[12], sT[13], max3f(sT[14], sT[15], sT[15]))); \
        mx = max3f(mx, __shfl_xor(mx, 32), mx); \
        if (__any(mx > m_run + 8.0f)) {                            \
            const float m_new = max3f(m_run, mx, mx), alpha = __builtin_amdgcn_exp2f(m_run - m_new); m_run = m_new; l_run *= alpha; \
            _Pragma("unroll") for (int k = 0; k < 16; ++k) { o0[k] *= alpha; o1[k] *= alpha; } } \
        _Pragma("unroll") for (int k = 0; k < 16; ++k) sT[k] = __builtin_amdgcn_exp2f(sT[k] - m_run); \
        l_run += (((sT[0] + sT[1]) + (sT[2] + sT[3])) + ((sT[4] + sT[5]) + (sT[6] + sT[7]))) + (((sT[8] + sT[9]) + (sT[10] + sT[11])) + ((sT[12] + sT[13]) + (sT[14] + sT[15]))); \
        v4u pw0, pw1; \
        pw0.x = cvt_pk_bf16(sT[0], sT[1]); pw0.y = cvt_pk_bf16(sT[2], sT[3]); pw0.z = cvt_pk_bf16(sT[4], sT[5]); pw0.w = cvt_pk_bf16(sT[6], sT[7]); \
        pw1.x = cvt_pk_bf16(sT[8], sT[9]); pw1.y = cvt_pk_bf16(sT[10], sT[11]); pw1.z = cvt_pk_bf16(sT[12], sT[13]); pw1.w = cvt_pk_bf16(sT[14], sT[15]); \
        const bf16x8 pk0 = __builtin_bit_cast(bf16x8, pw0), pk1 = __builtin_bit_cast(bf16x8, pw1); \
        const bf16x8 v00 = VFRAG(0, 0), v01 = VFRAG(0, 1), v10 = VFRAG(1, 0), v11 = VFRAG(1, 1); \
        o0 = __builtin_amdgcn_mfma_f32_32x32x16_bf16(v00, pk0, o0, 0, 0, 0); o0 = __builtin_amdgcn_mfma_f32_32x32x16_bf16(v01, pk1, o0, 0, 0, 0); \
        o1 = __builtin_amdgcn_mfma_f32_32x32x16_bf16(v10, pk0, o1, 0, 0, 0); o1 = __builtin_amdgcn_mfma_f32_32x32x16_bf16(v11, pk1, o1, 0, 0, 0); } while (0)
    int c, dsh, rho, i0, kb0, bh; size_t hb;
    TILE_SETUP(0, c, dsh, rho, i0, kb0, hb, bh);
    bf16x8 qf[4], kA[4], kB[4]; v4u vA[4];
    LOAD_Q(qf, hb, dsh, rho, i0);
    { v4u vdummy[4]; LOAD_KV(kA, vA, 0, hb, dsh, rho, i0, kb0); LOAD_KV(kB, vdummy, 1, hb, dsh, rho, i0, kb0); (void)vdummy; }
    for (int i = 0; i < ntile; ++i) {
        int c2 = 0, dsh2 = 0, rho2 = 0, i02 = 0, kb02 = 0, bh2 = 0; size_t hb2 = 0; const bool has_next = i + 1 < ntile;
        if (has_next) TILE_SETUP(i + 1, c2, dsh2, rho2, i02, kb02, hb2, bh2);
        const LAS float* bt = btall + (c * 16 + (bh & 15)) * 192;
        float m_run = -1.0e30f, l_run = 0.f;
        f32x16 o0, o1;
#pragma unroll
        for (int k = 0; k < 16; ++k) { o0[k] = 0.f; o1[k] = 0.f; }
        bf16x8 kC[4], kD[4], kE[4]; v4u vB[4], vC[4], vD[4], vE[4];
#define SB0() __builtin_amdgcn_sched_barrier(0)
#define LOAD_K(KF, kb_, HB_, DSH_, RHO_, I0_, KB0_) do { const int kbe_ = (kb_) < (KB0_) ? (KB0_) : (kb_); const char* kt_ = (const char*)(W_K(w) + HB_ + (RHO_) * 64) + ((size_t)(((I0_) - 128 + 32 * kbe_) << (DSH_))) * 128; \
        const unsigned kl_ = ((unsigned)(r << (DSH_))) * 128u + 64u * hh; if (!(mode & 8)) { _Pragma("unroll") for (int s = 0; s < 4; ++s) KF[s] = *(const bf16x8*)(kt_ + kl_ + 16 * s); } } while (0)
#define LOAD_V(VV, kb_, HB_, DSH_, RHO_, I0_, KB0_) do { const int kbe_ = (kb_) < (KB0_) ? (KB0_) : (kb_); const char* vt_ = (const char*)(W_V(w) + HB_ + (RHO_) * 64) + ((size_t)(((I0_) - 128 + 32 * kbe_) << (DSH_))) * 128; \
        const unsigned vl_ = ((unsigned)((lane >> 3) << (DSH_))) * 128u + 16u * (lane & 7), vs_ = (8u << (DSH_)) * 128u; if (!(mode & 8)) { _Pragma("unroll") for (int c4 = 0; c4 < 4; ++c4) VV[c4] = *(const v4u*)(vt_ + vl_ + c4 * vs_); } } while (0)
        SB0(); LOAD_K(kC, 2, hb, dsh, rho, i0, kb0); LOAD_V(vB, 1, hb, dsh, rho, i0, kb0); SB0();
        if (kb0 <= 0) ATT_COMPUTE(kA, vA, 0);
        SB0(); LOAD_K(kD, 3, hb, dsh, rho, i0, kb0); LOAD_V(vC, 2, hb, dsh, rho, i0, kb0); SB0();
        if (kb0 <= 1) ATT_COMPUTE(kB, vB, 1);
        SB0(); LOAD_K(kE, 4, hb, dsh, rho, i0, kb0); LOAD_V(vD, 3, hb, dsh, rho, i0, kb0); SB0();
        if (kb0 <= 2) ATT_COMPUTE(kC, vC, 2);
        SB0(); if (has_next) LOAD_K(kA, 0, hb2, dsh2, rho2, i02, kb02); LOAD_V(vE, 4, hb, dsh, rho, i0, kb0); SB0();
        if (kb0 <= 3) ATT_COMPUTE(kD, vD, 3);
        SB0(); if (has_next) { LOAD_K(kB, 1, hb2, dsh2, rho2, i02, kb02); LOAD_V(vA, 0, hb2, dsh2, rho2, i02, kb02); } SB0();
        ATT_COMPUTE(kE, vE, 4);
        SB0(); if (has_next) LOAD_Q(qf, hb2, dsh2, rho2, i02); SB0();
#undef SB0
#undef LOAD_K
#undef LOAD_V
        const float l_tot = l_run + __shfl_xor(l_run, 32);
        const int grow = (bh >> 4) * 2048 + (((i0 + r) << dsh) + rho);
#pragma unroll
        for (int g4 = 0; g4 < 4; ++g4) {
            v2u a, b2; a.x = cvt_pk_bf16(o0[4 * g4], o0[4 * g4 + 1]); a.y = cvt_pk_bf16(o0[4 * g4 + 2], o0[4 * g4 + 3]); b2.x = cvt_pk_bf16(o1[4 * g4], o1[4 * g4 + 1]); b2.y = cvt_pk_bf16(o1[4 * g4 + 2], o1[4 * g4 + 3]);
            *(LAS v2u*)(vl + r * 144 + (8 * g4 + 4 * hh) * 2) = a; *(LAS v2u*)(vl + r * 144 + (32 + 8 * g4 + 4 * hh) * 2) = b2;
        }
#pragma unroll
        for (int q4 = 0; q4 < 4; ++q4) { const int rq = q4 * 8 + (lane >> 3), ch = lane & 7;
            const v4u v = *(const LAS v4u*)(vl + rq * 144 + ch * 16);
            const int grow_q = (bh >> 4) * 2048 + (((i0 + rq) << dsh) + rho);
            if (!(mode & 16)) *(v4u*)(W_OPB(w) + ((size_t)c * M + grow_q) * 1024 + (bh & 15) * 64 + ch * 8) = v; }
        if (hh == 0 && !(mode & 16)) *(f32x2*)(W_ML(w) + (((size_t)c * M + grow) * 16 + (bh & 15)) * 2) = (f32x2){m_run, l_tot};
        c = c2; dsh = dsh2; rho = rho2; i0 = i02; kb0 = kb02; hb = hb2; bh = bh2;
    }
#undef ATT_COMPUTE
#undef VFRAG
#undef VTR
#undef TILE_SETUP
#undef LOAD_Q
#undef LOAD_KV
}

__device__ __forceinline__ int conv_ticket(LAS unsigned* q, int lane) {
    unsigned v = 0u;
    if (lane == 0) v = __hip_atomic_fetch_add(q, 1u, __ATOMIC_RELAXED, __HIP_MEMORY_SCOPE_WORKGROUP);
    return (int)__builtin_amdgcn_readfirstlane(v);
}
__device__ __forceinline__ void conv_run_dyn(const Args& A, unsigned char* w, int stage, int vcu, int G, int lane, LAS float* scr, LAS unsigned* q) {
    const int nk0 = conv_count(stage) / G, hasS = (2 * SB * H == G) ? (vcu < SB * H) : -1;
    const int nk = hasS < 0 ? nk0 : (hasS ? nk0 - CONV_SKEW : nk0 + CONV_SKEW), base = hasS < 0 ? vcu * nk0 : (hasS ? vcu * (nk0 - CONV_SKEW) : SB * H * (nk0 - CONV_SKEW) + (vcu - SB * H) * (nk0 + CONV_SKEW));
    P0Item dc, dn; f32x4 vc[8], vn[8]; float gc = 1.f, gn = 1.f;
    int k = conv_ticket(q, lane);
    if (k < nk) { p0_item_desc(A, w, stage, base + k, dc); p0_item_load(dc, lane, vc, gc); }
    while (k < nk) {
        const int k2 = conv_ticket(q, lane);
        if (k2 < nk) { p0_item_desc(A, w, stage, base + k2, dn); p0_item_load(dn, lane, vn, gn); }
        p0_item_store(dc, lane, vc, gc, scr);
        if (k2 < nk) { dc = dn; gc = gn;
#pragma unroll
            for (int i = 0; i < 8; ++i) vc[i] = vn[i]; }
        k = k2;
    }
}

__device__ __forceinline__ void att4_wait(volatile LAS unsigned* p, unsigned target);
__device__ __forceinline__ void team_bar(LAS unsigned* cnt, unsigned& epoch, int lane) {
    asm volatile("s_waitcnt vmcnt(0) lgkmcnt(0)" ::: "memory");
    if (lane == 0) (void)__hip_atomic_fetch_add(cnt, 1u, __ATOMIC_RELAXED, __HIP_MEMORY_SCOPE_WORKGROUP);
    ++epoch;
    att4_wait((volatile LAS unsigned*)cnt, 4u * epoch);
}
__device__ __forceinline__ void attn_sample_team(Frame& F, unsigned char* w, float* out, int l, int b, int h, int wv, LAS unsigned* tcnt) {
    LAS float* sm = (LAS float*)F.lds;
    const int lane = F.lane, t = wv * 64 + lane;
    unsigned epoch = 0u;
    const float* ps = W_PS(w) + (size_t)b * DIN;
    const size_t sbase = ((size_t)(l * SB + b) * WBUF) * 1024 + h * 64;
    const int e0 = t, c0 = e0 / 129, j0 = e0 - c0 * 129;
    f32x4 kreg[16];
    { const f32x4* kr = (const f32x4*)(F.state_k + sbase + (size_t)(j0 == 0 ? WBUF - 1 : WBUF - (j0 << (2 * c0))) * 1024);
#pragma unroll
      for (int d4 = 0; d4 < 16; ++d4) kreg[d4] = kr[d4]; }
    if (wv == 0) {
        const float qr = ps[h * 64 + lane], kr = ps[1024 + h * 64 + lane], vr = ps[2048 + h * 64 + lane];
        const float sq = wave_sum(qr * qr), sk = wave_sum(kr * kr);
        const float* gn = W_GN(w) + l * 128;
        const float qn = qr * __builtin_amdgcn_rsqf(sq * (1.0f / 64.0f) + EPS) * gn[lane] * QSCALE;
        const float kn = kr * __builtin_amdgcn_rsqf(sk * (1.0f / 64.0f) + EPS) * gn[64 + lane];
        sm[lane] = qn; sm[64 + lane] = kn; sm[128 + lane] = vr;
        out[O_KS + sbase + (size_t)(WBUF - 1) * 1024 + lane] = kn;
        out[O_VS + sbase + (size_t)(WBUF - 1) * 1024 + lane] = vr;
    }
    team_bar(tcnt, epoch, lane);
    {   float a = 0.f;
#pragma unroll
        for (int d4 = 0; d4 < 16; ++d4) { const f32x4 q4 = *(const LAS f32x4*)(sm + 4 * d4); f32x4 kv = kreg[d4]; if (j0 == 0) kv = *(const LAS f32x4*)(sm + 64 + 4 * d4);
            a += (kv[0] * q4[0] + kv[1] * q4[1]) + (kv[2] * q4[2] + kv[3] * q4[3]); }
        sm[192 + e0] = a + W_BT(w)[(c0 * 16 + h) * 129 + j0];
    }
    if (t + 256 < 387) {
        const int e1 = t + 256, c1 = e1 / 129, j1 = e1 - c1 * 129;
        const f32x4* kr = (const f32x4*)(F.state_k + sbase + (size_t)(j1 == 0 ? WBUF - 1 : WBUF - (j1 << (2 * c1))) * 1024);
        float a = 0.f;
#pragma unroll
        for (int d4 = 0; d4 < 16; ++d4) { const f32x4 q4 = *(const LAS f32x4*)(sm + 4 * d4); f32x4 kv = kr[d4]; if (j1 == 0) kv = *(const LAS f32x4*)(sm + 64 + 4 * d4);
            a += (kv[0] * q4[0] + kv[1] * q4[1]) + (kv[2] * q4[2] + kv[3] * q4[3]); }
        sm[192 + e1] = a + W_BT(w)[(c1 * 16 + h) * 129 + j1];
    }
    const int kg = t >> 4, dq = t & 15;
    f32x4 vreg[13];
#pragma unroll
    for (int i = 0; i < 13; ++i) { int ee = kg + 16 * i; const int cc = ee / 129, jj = ee - cc * 129;
        vreg[i] = *(const f32x4*)(F.state_v + sbase + (size_t)(jj == 0 ? WBUF - 1 : WBUF - (jj << (2 * cc))) * 1024 + dq * 4); }
    team_bar(tcnt, epoch, lane);
    float mx = -1.0e30f;
    for (int x = lane; x < 387; x += 64) mx = fmaxf(mx, sm[192 + x]);
    mx = wave_max(mx);
    float sum = 0.f;
    for (int x = lane; x < 387; x += 64) sum += __builtin_amdgcn_exp2f(sm[192 + x] - mx);
    sum = wave_sum(sum);
    f32x4 o = {0.f, 0.f, 0.f, 0.f};
#pragma unroll
    for (int i = 0; i < 13; ++i) { const int ee = kg + 16 * i;
        const float p = __builtin_amdgcn_exp2f(sm[192 + ee] - mx); f32x4 vv = vreg[i]; if (ee == 0 || ee == 129 || ee == 258) vv = *(const LAS f32x4*)(sm + 128 + dq * 4); o += vv * p; }
#pragma unroll
    for (int i = 13; i < 25; ++i) { int ee = kg + 16 * i; if (ee < 387) { const int cc = ee / 129, jj = ee - cc * 129;
        f32x4 vv = *(const f32x4*)(F.state_v + sbase + (size_t)(jj == 0 ? WBUF - 1 : WBUF - (jj << (2 * cc))) * 1024 + dq * 4);
        if (jj == 0) vv = *(const LAS f32x4*)(sm + 128 + dq * 4);
        o += vv * __builtin_amdgcn_exp2f(sm[192 + ee] - mx); } }
    *(LAS f32x4*)(sm + 1024 + kg * 64 + dq * 4) = o;
    team_bar(tcnt, epoch, lane);
    if (t < 64) {
        float tt = 0.f;
#pragma unroll
        for (int g = 0; g < 16; ++g) tt += sm[1024 + g * 64 + t];
        W_OS(w)[(size_t)b * 1024 + h * 64 + t] = tt / sum;
    }
}

constexpr int ATT4_BT = 6 * 192 * 4, ATT4_IMG = ATT4_BT, ATT4_STG = ATT4_IMG + 8 * 8192, ATT4_SYNC = ATT4_STG + 4 * 4608, ATT4_CONV = ATT4_SYNC + 256;
static_assert(ATT4_CONV + 4 * 8448 <= LDSCTL_OFF, "LDS map (attention v4)");
__device__ __forceinline__ void att4_wait(volatile LAS unsigned* p, unsigned target) {
    for (unsigned sp = 0; *p < target && sp < (1u << 22); ++sp) __builtin_amdgcn_s_sleep(1);
    asm volatile("" ::: "memory");
}
__device__ __forceinline__ void att4_signal(LAS unsigned* p, int lane) {
    asm volatile("s_waitcnt lgkmcnt(0)" ::: "memory");
    if (lane == 0) (void)__hip_atomic_fetch_add(p, 1u, __ATOMIC_RELAXED, __HIP_MEMORY_SCOPE_WORKGROUP);
    asm volatile("" ::: "memory");
}
__device__ __forceinline__ void attn_phase_prompt4(Frame& F, const Args& A, unsigned char* w, float* out, int l) {
    const int lane = F.lane, r = lane & 31, hh = lane >> 5;
    LAS float* btall = (LAS float*)F.lds;
    for (int e = F.tid; e < 6 * 192; e += NWAVES * 64) { const int t = e / 192, j = 160 - (e - t * 192), hh_ = ((((t / 3) * F.G + F.vcu) >> 3) & 15);
        btall[e] = (j >= 0 && j <= 128) ? W_BT(w)[((t % 3) * 16 + hh_) * 129 + (j < 0 ? 0 : (j > 128 ? 128 : j))] : -1.0e30f; }
    LAS unsigned* sync = (LAS unsigned*)(F.lds + ATT4_SYNC);
    if (F.tid == 0) { sync[0] = 0u; sync[16] = 0u; sync[32] = 0u; sync[48] = 0u; }
#if CONV_RING
    conv_fill_gains(A, 1 + l, (LAS float*)(F.lds + ATT4_CONV), F.tid);
#endif
    WG_BAR();
    constexpr int NWORK = 4, NMOVE = ATT4_MOVERS;
    if (F.wave >= NWORK) {
        const int mv = F.wave - NWORK;
        constexpr int CP_PER = (WBUF - 1) * 256, CP_HALF = SB * CP_PER, CP_TOT = 2 * CP_HALF, CP_ROWS = (CP_TOT + 63) / 64;
        for (int bt_ = F.vcu * NMOVE + mv; (!COPY_IN_G4 || COPY_BOTH) && bt_ * NCP < CP_ROWS; bt_ += F.G * NMOVE) {
            const int k0 = bt_ * NCP;
            f32x4 cpv[NCP];
#pragma unroll
            for (int u = 0; u < NCP; ++u) { int ci = (k0 + u) * 64 + lane; ci = ci < CP_TOT ? ci : CP_TOT - 1;
                const int kv = ci >= CP_HALF, rr = ci - kv * CP_HALF, bb = rr / CP_PER, ee = rr - bb * CP_PER;
                cpv[u] = __builtin_nontemporal_load((const f32x4*)(kv ? F.state_v : F.state_k) + ((size_t)(l * SB + bb) * WBUF + 1) * 256 + ee); }
#pragma unroll
            for (int u = 0; u < NCP; ++u) { const int ci = (k0 + u) * 64 + lane;
                if (ci < CP_TOT) { const int kv = ci >= CP_HALF, rr = ci - kv * CP_HALF, bb = rr / CP_PER, ee = rr - bb * CP_PER;
                    __builtin_nontemporal_store(cpv[u], (f32x4*)(out + (kv ? O_VS : O_KS)) + ((size_t)(l * SB + bb) * WBUF) * 256 + ee); } }
        }
#if CONV_RING
        conv_ring<CONV_DP>(A, w, 1 + l, F.vcu, F.G, lane, (const LAS float*)(F.lds + ATT4_CONV), sync + 48, F.vcu * NWAVES + F.wave);
#else
        conv_run_dyn(A, w, 1 + l, F.vcu, F.G, lane, (LAS float*)(F.lds + ATT4_CONV + mv * 8448), sync + 48);
#endif
        return;
    }
    const int wv = F.wave;
    LAS unsigned char* img = F.lds + ATT4_IMG;
    LAS unsigned char* stg = F.lds + ATT4_STG + wv * 4608;
    const int trq = (lane & 15) >> 2, trp = lane & 3, g16 = (lane >> 4) & 1, rsw = 4 * hh + trq;
    const int vt0 = rsw * 128 + (((2 * g16 + (trp >> 1)) ^ rsw) * 16) + 8 * (trp & 1), vt1 = rsw * 128 + (((4 + 2 * g16 + (trp >> 1)) ^ rsw) * 16) + 8 * (trp & 1);
    int koff[4];
#pragma unroll
    for (int s = 0; s < 4; ++s) koff[s] = r * 128 + (((4 * hh + s) ^ (r & 7)) * 16);
    const int rib = 8 * wv + (lane >> 3), woff = rib * 128 + (((lane & 7) ^ (rib & 7)) * 16);
#define UNIT_SETUP(mu_, C_, DSH_, RHO_, RB_, JV_, HB_, BH_, PAIR_) do { const int u_ = (mu_) < 5 ? (mu_) : (mu_) + 1; PAIR_ = ((mu_) == 4 || (mu_) == 9); \
        const int i_ = u_ >> 1, c_ = i_ % 3, idx_ = (i_ / 3) * F.G + F.vcu; C_ = c_; DSH_ = 2 * c_; BH_ = idx_ >> 3; \
        const int f0_ = 256 * (idx_ & 7) + 128 * (u_ & 1); RHO_ = f0_ >> (11 - DSH_); RB_ = f0_ & ((2048 >> DSH_) - 1); JV_ = RB_ == 0 ? 4 : 0; HB_ = (size_t)BH_ * 2048 * 64; } while (0)
#define UNIT_LOAD(KP, VP, QF, QFB, DSH_, RHO_, RB_, JV_, HB_, PAIR_) do { \
        _Pragma("unroll") for (int n = 0; n < 8; ++n) { \
            if (n >= (JV_)) { const size_t eo_ = HB_ + (size_t)((((RB_) - 128 + 32 * n + rib) << (DSH_)) + (RHO_)) * 64 + (lane & 7) * 8; KP[n] = *(const v4u*)(W_K(w) + eo_); VP[n] = *(const v4u*)(W_V(w) + eo_); } \
            else if (PAIR_) { const size_t eo_ = HB_ + (size_t)(((32 * n + rib) << (DSH_)) + (RHO_) + 1) * 64 + (lane & 7) * 8; KP[n] = *(const v4u*)(W_K(w) + eo_); VP[n] = *(const v4u*)(W_V(w) + eo_); } } \
        { const bf16* qp_ = W_Q(w) + HB_ + (size_t)((((RB_) + 32 * wv + r) << (DSH_)) + (RHO_)) * 64 + 32 * hh; _Pragma("unroll") for (int s = 0; s < 4; ++s) QF[s] = *(const bf16x8*)(qp_ + 8 * s); } \
        if (PAIR_) { const bf16* qp_ = W_Q(w) + HB_ + (size_t)(((32 * (3 - wv) + r) << (DSH_)) + (RHO_) + 1) * 64 + 32 * hh; _Pragma("unroll") for (int s = 0; s < 4; ++s) QFB[s] = *(const bf16x8*)(qp_ + 8 * s); } } while (0)
    int c, dsh, rho, rb, jv, bh, pair; size_t hb;
    UNIT_SETUP(0, c, dsh, rho, rb, jv, hb, bh, pair);
    int lo = jv, so = 0;
    v4u kp[8], vp[8]; bf16x8 qf[4], qfb[4];
#pragma unroll
    for (int n = 0; n < 8; ++n) { kp[n] = (v4u){0u, 0u, 0u, 0u}; vp[n] = (v4u){0u, 0u, 0u, 0u}; }
#pragma unroll
    for (int s = 0; s < 4; ++s) qfb[s] = (bf16x8){0, 0, 0, 0, 0, 0, 0, 0};
    UNIT_LOAD(kp, vp, qf, qfb, dsh, rho, rb, lo, hb, pair);
    constexpr unsigned NUNIT = 10;
    int pc = 0, pdsh = 0, prho = 0, pbh = 0, pi0 = 0; float pm = 0.f, pl = 0.f;
#define UNIT_FLUSH() do { \
        _Pragma("unroll") for (int q4 = 0; q4 < 4; ++q4) { const int rq = q4 * 8 + (lane >> 3), ch = lane & 7; \
            const v4u v = *(const LAS v4u*)(stg + rq * 144 + ch * 16); \
            const int grow_q = (pbh >> 4) * 2048 + (((pi0 + rq) << pdsh) + prho); \
            *(v4u*)(W_OPB(w) + ((size_t)pc * M + grow_q) * 1024 + (pbh & 15) * 64 + ch * 8) = v; } \
        if (hh == 0) *(f32x2*)(W_ML(w) + (((size_t)pc * M + (pbh >> 4) * 2048 + (((pi0 + r) << pdsh) + prho)) * 16 + (pbh & 15)) * 2) = (f32x2){pm, pl}; } while (0)
#define VTR(p) __builtin_bit_cast(s16x4, __builtin_amdgcn_ds_read_tr16_b64_v4i16((LAS s16x4*)(p)))
#define VFRAG4(VT_, s) ({ const s16x4 lo_ = VTR(vb_ + (16 * (s)) * 128 + (VT_)), hi_ = VTR(vb_ + (16 * (s) + 8) * 128 + (VT_)); (bf16x8){lo_[0], lo_[1], lo_[2], lo_[3], hi_[0], hi_[1], hi_[2], hi_[3]}; })
#define TILE_RUN(WQ_, SOFF_, JVV_, QC_, RHO_T_) do { \
        float m_run = -1.0e30f, l_run = 0.f; \
        f32x16 o0, o1; \
        _Pragma("unroll") for (int k = 0; k < 16; ++k) { o0[k] = 0.f; o1[k] = 0.f; } \
        _Pragma("unroll") for (int jj = 0; jj < 5; ++jj) { \
            const int j = (WQ_) + jj; \
            if (j >= (JVV_)) { \
                const LAS unsigned char* kb_ = img + ((j + (SOFF_) + so) & 7) * 8192; const LAS unsigned char* vb_ = kb_ + 4096; \
                bf16x8 kf[4]; \
                _Pragma("unroll") for (int s = 0; s < 4; ++s) kf[s] = *(const LAS bf16x8*)(kb_ + koff[s]); \
                const int bidx = 32 - r + 4 * hh + 32 * jj; \
                f32x16 sT; \
                _Pragma("unroll") for (int k = 0; k < 16; ++k) sT[k] = bt[bidx + (k & 3) + 8 * (k >> 2)]; \
                _Pragma("unroll") for (int s = 0; s < 4; ++s) sT = __builtin_amdgcn_mfma_f32_32x32x16_bf16(kf[s], QC_[s], sT, 0, 0, 0); \
                asm volatile("s_nop 15\n\ts_nop 7" : "+v"(sT)); \
                float mx = max3f(max3f(sT[0], sT[1], sT[2]), max3f(sT[3], sT[4], sT[5]), max3f(sT[6], sT[7], sT[8])); \
                mx = max3f(mx, max3f(sT[9], sT[10], sT[11]), max3f(sT[12], sT[13], max3f(sT[14], sT[15], sT[15]))); \
                asm volatile("s_nop 1" : "+v"(mx));        \
                { const unsigned mb_ = __builtin_bit_cast(unsigned, mx); const auto sw_ = __builtin_amdgcn_permlane32_swap(mb_, mb_, false, false);        \
                  const unsigned s0_ = sw_[0], s1_ = sw_[1];        \
                  mx = max3f(__builtin_bit_cast(float, s0_), __builtin_bit_cast(float, s1_), __builtin_bit_cast(float, s1_)); } \
                if (__any(mx > m_run + 8.0f)) { \
                    const float m_new = max3f(m_run, mx, mx), alpha = __builtin_amdgcn_exp2f(m_run - m_new); m_run = m_new; l_run *= alpha; \
                    _Pragma("unroll") for (int k = 0; k < 16; ++k) { o0[k] *= alpha; o1[k] *= alpha; } } \
                _Pragma("unroll") for (int k = 0; k < 16; ++k) sT[k] = __builtin_amdgcn_exp2f(sT[k] - m_run); \
                l_run += (((sT[0] + sT[1]) + (sT[2] + sT[3])) + ((sT[4] + sT[5]) + (sT[6] + sT[7]))) + (((sT[8] + sT[9]) + (sT[10] + sT[11])) + ((sT[12] + sT[13]) + (sT[14] + sT[15]))); \
                v4u pw0, pw1; \
                pw0.x = cvt_pk_bf16(sT[0], sT[1]); pw0.y = cvt_pk_bf16(sT[2], sT[3]); pw0.z = cvt_pk_bf16(sT[4], sT[5]); pw0.w = cvt_pk_bf16(sT[6], sT[7]); \
                pw1.x = cvt_pk_bf16(sT[8], sT[9]); pw1.y = cvt_pk_bf16(sT[10], sT[11]); pw1.z = cvt_pk_bf16(sT[12], sT[13]); pw1.w = cvt_pk_bf16(sT[14], sT[15]); \
                const bf16x8 pk0 = __builtin_bit_cast(bf16x8, pw0), pk1 = __builtin_bit_cast(bf16x8, pw1); \
                  \
                const bf16x8 v00 = VFRAG4(vt0, 0), v01 = VFRAG4(vt0, 1), v10 = VFRAG4(vt1, 0), v11 = VFRAG4(vt1, 1); \
                o0 = __builtin_amdgcn_mfma_f32_32x32x16_bf16(v00, pk0, o0, 0, 0, 0); o0 = __builtin_amdgcn_mfma_f32_32x32x16_bf16(v01, pk1, o0, 0, 0, 0); \
                o1 = __builtin_amdgcn_mfma_f32_32x32x16_bf16(v10, pk0, o1, 0, 0, 0); o1 = __builtin_amdgcn_mfma_f32_32x32x16_bf16(v11, pk1, o1, 0, 0, 0); \
            } \
        } \
          \
        _Pragma("unroll") for (int g4 = 0; g4 < 4; ++g4) { \
            v2u a, b2; a.x = cvt_pk_bf16(o0[4 * g4], o0[4 * g4 + 1]); a.y = cvt_pk_bf16(o0[4 * g4 + 2], o0[4 * g4 + 3]); b2.x = cvt_pk_bf16(o1[4 * g4], o1[4 * g4 + 1]); b2.y = cvt_pk_bf16(o1[4 * g4 + 2], o1[4 * g4 + 3]); \
            *(LAS v2u*)(stg + r * 144 + (8 * g4 + 4 * hh) * 2) = a; *(LAS v2u*)(stg + r * 144 + (32 + 8 * g4 + 4 * hh) * 2) = b2; } \
        pc = c; pdsh = dsh; prho = (RHO_T_); pbh = bh; pi0 = rb + 32 * (WQ_); pm = m_run; \
        { const unsigned lb_ = __builtin_bit_cast(unsigned, l_run); const auto sw_ = __builtin_amdgcn_permlane32_swap(lb_, lb_, false, false); const unsigned s0_ = sw_[0], s1_ = sw_[1]; \
          pl = __builtin_bit_cast(float, s0_) + __builtin_bit_cast(float, s1_); } } while (0)
    for (int u = 0; u < (int)NUNIT; ++u) {
        att4_wait((volatile LAS unsigned*)(sync + 16), 4u * (unsigned)u);
#pragma unroll
        for (int n = 0; n < 8; ++n) if (n >= lo || pair) { LAS unsigned char* sl_ = img + ((n + so) & 7) * 8192 + woff; *(LAS v4u*)sl_ = kp[n]; *(LAS v4u*)(sl_ + 4096) = vp[n]; }
        bf16x8 qc[4];
#pragma unroll
        for (int s = 0; s < 4; ++s) qc[s] = qf[s];
        att4_signal(sync, lane);
        if (u > 0) UNIT_FLUSH();
        att4_wait((volatile LAS unsigned*)sync, 4u * (unsigned)(u + 1));
        int c2 = 0, dsh2 = 0, rho2 = 0, rb2 = 0, jv2 = 0, bh2 = 0, pair2 = 0, lo2 = 0, so2 = 0; size_t hb2 = 0;
        if (u + 1 < (int)NUNIT) { UNIT_SETUP(u + 1, c2, dsh2, rho2, rb2, jv2, hb2, bh2, pair2);
            const int reuse2 = (u + 1 == 1 || u + 1 == 3 || u + 1 == 6 || u + 1 == 8); lo2 = reuse2 ? 4 : jv2; so2 = reuse2 ? 4 : 0;
            UNIT_LOAD(kp, vp, qf, qfb, dsh2, rho2, rb2, lo2, hb2, pair2); }
        const LAS float* bt = btall + ((u < 5 ? u : u + 1) >> 1) * 192;
        TILE_RUN(wv, 0, jv, qc, rho);
        if (pair) { UNIT_FLUSH(); TILE_RUN(3 - wv, -4, 4, qfb, rho + 1); }
        att4_signal(sync + 16, lane);
        c = c2; dsh = dsh2; rho = rho2; rb = rb2; jv = jv2; hb = hb2; bh = bh2; pair = pair2; lo = lo2; so = so2;
    }
#undef TILE_RUN
#undef VFRAG4
#undef VTR
#undef UNIT_SETUP
#undef UNIT_LOAD
    UNIT_FLUSH();
#undef UNIT_FLUSH
    att4_wait((volatile LAS unsigned*)(sync + 16), 4u * NUNIT);
    if (F.vcu < SB * H) attn_sample_team(F, w, out, l, F.vcu >> 4, F.vcu & 15, wv, sync + 32);
#if CONV_RING
    conv_ring<CONV_DP>(A, w, 1 + l, F.vcu, F.G, lane, (const LAS float*)(F.lds + ATT4_CONV), sync + 48, F.vcu * NWAVES + F.wave);
#else
    conv_run_dyn(A, w, 1 + l, F.vcu, F.G, lane, (LAS float*)(img + 16384 + wv * 8448), sync + 48);
#endif
}

__device__ __forceinline__ void attn_sample_unit(Frame& F, unsigned char* w, float* out, int l, int b, int h) {
    LAS float* sm = (LAS float*)F.lds;
    const int lane = F.lane, wave = F.wave, tid = F.tid;
    const float* ps = W_PS(w) + (size_t)b * DIN;
    const size_t sbase = ((size_t)(l * SB + b) * WBUF) * 1024 + h * 64;
    const int e = tid < 387 ? tid : 386, ec = e / 129, ej = e - ec * 129;
    f32x4 kreg[16];
    { const f32x4* kr = (const f32x4*)(F.state_k + sbase + (size_t)(ej == 0 ? WBUF - 1 : WBUF - (ej << (2 * ec))) * 1024);
#pragma unroll
      for (int d4 = 0; d4 < 16; ++d4) kreg[d4] = kr[d4]; }
    const int kg = tid >> 4, dq = tid & 15;
    f32x4 vreg[13];
#pragma unroll
    for (int i = 0; i < 13; ++i) { int ee = kg + 32 * i; ee = ee < 387 ? ee : 386; const int cc = ee / 129, jj = ee - cc * 129;
        vreg[i] = *(const f32x4*)(F.state_v + sbase + (size_t)(jj == 0 ? WBUF - 1 : WBUF - (jj << (2 * cc))) * 1024 + dq * 4); }
    if (wave == 0) {
        const float qr = ps[h * 64 + lane], kr = ps[1024 + h * 64 + lane], vr = ps[2048 + h * 64 + lane];
        const float sq = wave_sum(qr * qr), sk = wave_sum(kr * kr);
        const float* gn = W_GN(w) + l * 128;
        const float qn = qr * __builtin_amdgcn_rsqf(sq * (1.0f / 64.0f) + EPS) * gn[lane] * QSCALE;
        const float kn = kr * __builtin_amdgcn_rsqf(sk * (1.0f / 64.0f) + EPS) * gn[64 + lane];
        sm[lane] = qn; sm[64 + lane] = kn; sm[128 + lane] = vr;
        out[O_KS + sbase + (size_t)(WBUF - 1) * 1024 + lane] = kn;
        out[O_VS + sbase + (size_t)(WBUF - 1) * 1024 + lane] = vr;
    }
    WG_BAR();
    if (tid < 387) {
        float a = 0.f;
#pragma unroll
        for (int d4 = 0; d4 < 16; ++d4) { const f32x4 q4 = *(const LAS f32x4*)(sm + 4 * d4); f32x4 kv = kreg[d4]; if (ej == 0) kv = *(const LAS f32x4*)(sm + 64 + 4 * d4);
            a += (kv[0] * q4[0] + kv[1] * q4[1]) + (kv[2] * q4[2] + kv[3] * q4[3]); }
        sm[192 + tid] = a + W_BT(w)[(ec * 16 + h) * 129 + ej];
    }
    WG_BAR();
    float mx = -1.0e30f;
    for (int t = lane; t < 387; t += 64) mx = fmaxf(mx, sm[192 + t]);
    mx = wave_max(mx);
    float sum = 0.f;
    for (int t = lane; t < 387; t += 64) sum += __builtin_amdgcn_exp2f(sm[192 + t] - mx);
    sum = wave_sum(sum);
    f32x4 o = {0.f, 0.f, 0.f, 0.f};
#pragma unroll
    for (int i = 0; i < 13; ++i) { const int ee = kg + 32 * i;
        if (ee < 387) { const float p = __builtin_amdgcn_exp2f(sm[192 + ee] - mx); f32x4 vv = vreg[i]; if (ee == 0 || ee == 129 || ee == 258) vv = *(const LAS f32x4*)(sm + 128 + dq * 4); o += vv * p; } }
    *(LAS f32x4*)(sm + 1024 + kg * 64 + dq * 4) = o;
    WG_BAR();
    if (tid < 64) {
        float t = 0.f;
#pragma unroll
        for (int g = 0; g < 32; ++g) t += sm[1024 + g * 64 + tid];
        W_OS(w)[(size_t)b * 1024 + h * 64 + tid] = t / sum;
    }
    WG_BAR();
}

__device__ __forceinline__ void mix_row_prompt(unsigned char* w, float* out, int lane, int l, int row) {
    const int b = row >> 11, t = row & 2047;
    { const int head = lane >> 2, dq = (lane & 3) * 16;
      float mm[3], ll[3];
#pragma unroll
      for (int c = 0; c < 3; ++c) { const f32x2 v = *(const f32x2*)(W_ML(w) + (((size_t)c * M + row) * 16 + head) * 2); mm[c] = v[0]; ll[c] = v[1]; }
      const float mx = fmaxf(fmaxf(mm[0], mm[1]), mm[2]);
      float wgt[3], den = 0.f;
#pragma unroll
      for (int c = 0; c < 3; ++c) { wgt[c] = __builtin_amdgcn_exp2f(mm[c] - mx); den += wgt[c] * ll[c]; }
      const float inv = 1.0f / den;
      f32x4 o[4];
#pragma unroll
      for (int k = 0; k < 4; ++k) o[k] = (f32x4){0.f, 0.f, 0.f, 0.f};
#pragma unroll
      for (int c = 0; c < 3; ++c) { const v4u* p = (const v4u*)(W_OPB(w) + ((size_t)c * M + row) * 1024 + head * 64 + dq); const float wc_ = wgt[c] * inv; const v4u p0 = p[0], p1 = p[1];
#pragma unroll
          for (int e = 0; e < 4; ++e) { const int k = e >> 1, x = (e & 1) * 2;
              o[k][x] += __uint_as_float(p0[e] << 16) * wc_; o[k][x + 1] += __uint_as_float(p0[e] & 0xffff0000u) * wc_;
              o[2 + k][x] += __uint_as_float(p1[e] << 16) * wc_; o[2 + k][x + 1] += __uint_as_float(p1[e] & 0xffff0000u) * wc_; } }
      float q = 0.f;
#pragma unroll
      for (int k = 0; k < 4; ++k) q += (o[k][0] * o[k][0] + o[k][1] * o[k][1]) + (o[k][2] * o[k][2] + o[k][3] * o[k][3]);
      q = wave_sum(q);
      const float rs = __builtin_amdgcn_rsqf(q * (1.0f / 1024.0f) + EPS);
      bf16* dst = W_MIX(w) + (size_t)row * 2048 + head * 64 + dq;
      *(v4u*)dst = pack8(o[0] * rs, o[1] * rs); *(v4u*)(dst + 8) = pack8(o[2] * rs, o[3] * rs); }
    { const int c0 = lane * 16;
      float u[3][16];
#pragma unroll
      for (int k = 0; k < 3; ++k) { const int tt = t - 2 + k;
          if (tt >= 0) { const bf16* pr = W_PC(w) + (size_t)(row - 2 + k) * 2048;
              const v4u a0 = *(const v4u*)(pr + c0), a1 = *(const v4u*)(pr + c0 + 8);
#pragma unroll
              for (int e = 0; e < 4; ++e) { const unsigned va = a0[e], vb = a1[e];
                  u[k][2 * e] = __uint_as_float(va << 16); u[k][2 * e + 1] = __uint_as_float(va & 0xffff0000u);
                  u[k][8 + 2 * e] = __uint_as_float(vb << 16); u[k][8 + 2 * e + 1] = __uint_as_float(vb & 0xffff0000u); }
          } else {
#pragma unroll
              for (int e = 0; e < 16; ++e) u[k][e] = 0.f; } }
      const bf16* pr = W_PC(w) + (size_t)row * 2048 + 1024 + c0;
      const v4u b0 = *(const v4u*)pr, b1 = *(const v4u*)(pr + 8);
      float gb[16];
#pragma unroll
      for (int e = 0; e < 4; ++e) { gb[2 * e] = __uint_as_float(b0[e] << 16); gb[2 * e + 1] = __uint_as_float(b0[e] & 0xffff0000u); gb[8 + 2 * e] = __uint_as_float(b1[e] << 16); gb[8 + 2 * e + 1] = __uint_as_float(b1[e] & 0xffff0000u); }
      const float* cw = W_CW(w) + (size_t)l * 3 * DC + c0;
      float z[16]; float q = 0.f;
#pragma unroll
      for (int e4 = 0; e4 < 4; ++e4) { const f32x4 w0 = *(const f32x4*)(cw + 4 * e4), w1 = *(const f32x4*)(cw + DC + 4 * e4), w2 = *(const f32x4*)(cw + 2 * DC + 4 * e4);
#pragma unroll
          for (int e = 0; e < 4; ++e) { const int i = 4 * e4 + e; const float y = w0[e] * u[0][i] + w1[e] * u[1][i] + w2[e] * u[2][i]; z[i] = gb[i] * y; q += z[i] * z[i]; } }
      q = wave_sum(q);
      const float rs = __builtin_amdgcn_rsqf(q * (1.0f / 1024.0f) + EPS);
      bf16* dst = W_MIX(w) + (size_t)row * 2048 + 1024 + c0;
      v4u w0, w1;
#pragma unroll
      for (int e = 0; e < 4; ++e) { w0[e] = cvt_pk_bf16(z[2 * e] * rs, z[2 * e + 1] * rs); w1[e] = cvt_pk_bf16(z[8 + 2 * e] * rs, z[8 + 2 * e + 1] * rs); }
      *(v4u*)dst = w0; *(v4u*)(dst + 8) = w1;
      if (t >= S - 2) { float* cp = out + O_CP + ((size_t)(l * NB + b) * 2 + (t - (S - 2))) * DC + c0;
#pragma unroll
          for (int e4 = 0; e4 < 4; ++e4) *(f32x4*)(cp + 4 * e4) = (f32x4){u[2][4 * e4], u[2][4 * e4 + 1], u[2][4 * e4 + 2], u[2][4 * e4 + 3]}; } }
}
__device__ __forceinline__ void mix_row_sample(unsigned char* w, float* out, int lane, int l, int b) {
    { const f32x4* p = (const f32x4*)(W_OS(w) + (size_t)b * 1024 + lane * 16); f32x4 o[4]; float q = 0.f;
#pragma unroll
      for (int k = 0; k < 4; ++k) { o[k] = p[k]; q += (o[k][0] * o[k][0] + o[k][1] * o[k][1]) + (o[k][2] * o[k][2] + o[k][3] * o[k][3]); }
      q = wave_sum(q); const float rs = __builtin_amdgcn_rsqf(q * (1.0f / 1024.0f) + EPS);
      f32x4* dst = (f32x4*)(W_MIXS(w) + (size_t)b * 2048 + lane * 16);
#pragma unroll
      for (int k = 0; k < 4; ++k) dst[k] = o[k] * rs; }
    { const int c0 = lane * 16; const float* ps = W_PS(w) + (size_t)b * DIN;
      const float* st = W_SC(w) + (size_t)(l * SB + b) * 2 * DC; const float* cw = W_CW(w) + (size_t)l * 3 * DC;
      float* co = out + O_CS + (size_t)(l * SB + b) * 2 * DC;
      f32x4 z[4]; float q = 0.f;
#pragma unroll
      for (int k = 0; k < 4; ++k) { const int c = c0 + 4 * k;
          const int cv = 3072 + 256 * (c >> 7) + 64 * ((c >> 5) & 3) + (c & 31);
          const f32x4 vc = *(const f32x4*)(ps + cv), gb = *(const f32x4*)(ps + 5120 + c), gc = *(const f32x4*)(ps + cv + 32);
          const f32x4 s0 = *(const f32x4*)(st + c), s1 = *(const f32x4*)(st + DC + c);
          const f32x4 w0 = *(const f32x4*)(cw + c), w1 = *(const f32x4*)(cw + DC + c), w2 = *(const f32x4*)(cw + 2 * DC + c);
          const f32x4 un = gc * vc; const f32x4 y = w0 * s0 + w1 * s1 + w2 * un; z[k] = gb * y;
          q += (z[k][0] * z[k][0] + z[k][1] * z[k][1]) + (z[k][2] * z[k][2] + z[k][3] * z[k][3]);
          *(f32x4*)(co + c) = s1; *(f32x4*)(co + DC + c) = un; }
      q = wave_sum(q); const float rs = __builtin_amdgcn_rsqf(q * (1.0f / 1024.0f) + EPS);
      f32x4* dst = (f32x4*)(W_MIXS(w) + (size_t)b * 2048 + 1024 + c0);
#pragma unroll
      for (int k = 0; k < 4; ++k) dst[k] = z[k] * rs; }
}

#ifndef PHASE_MASK
#define PHASE_MASK 127
#endif
struct SideKV {
    static constexpr bool ON = true;
    const bf16* kb; const bf16* vb; float* ko; float* vo; int gw, ngw, lane;
    LAS unsigned char* slot; f32x2 d; f32x2* dst;
    __device__ __forceinline__ void issue(int j) {
        int o = j * ngw + gw; o = o < 131072 ? o : 131071;
        const int kv = o >> 16, rem = o & 65535, row = rem >> 3, part = rem & 7, head = 2 * part + (lane >> 5), dd = 2 * (lane & 31);
        const bf16* src = (kv ? vb : kb) + ((size_t)((row >> 11) * 16 + head) * 2048 + (row & 2047)) * 64 + dd;
        __builtin_amdgcn_global_load_lds((const unsigned*)src, (LAS unsigned*)slot, 4, 0, 2);
        dst = (f32x2*)((kv ? vo : ko) + (size_t)row * 1024 + part * 128 + 2 * lane);
    }
    __device__ __forceinline__ void prime() { issue(0); }
    __device__ __forceinline__ void fetch() { const unsigned x = *(const LAS unsigned*)(slot + lane * 4); d[0] = __uint_as_float(x << 16); d[1] = __uint_as_float(x & 0xffff0000u); }
    __device__ __forceinline__ void step(int j) { __builtin_nontemporal_store(d, dst); issue(j + 1); }
};
struct SideCopy {
    static constexpr bool ON = true;
    const float* sk; const float* sv; float* ok; float* ov; int gw, ngw, lane;
    LAS unsigned char* slot;
    f32x4 d; f32x4* dst;
    __device__ __forceinline__ void issue(int j) {
        constexpr int CP_PER = (WBUF - 1) * 256, CP_HALF = SB * CP_PER, CP_TOT = 2 * CP_HALF;
        int ci = (j * ngw + gw) * 64 + lane; ci = ci < CP_TOT ? ci : CP_TOT - 1;
        const int kv = ci >= CP_HALF, rr = ci - kv * CP_HALF, bb = rr / CP_PER, ee = rr - bb * CP_PER;
        __builtin_amdgcn_global_load_lds((const unsigned*)((const f32x4*)(kv ? sv : sk) + ((size_t)bb * WBUF + 1) * 256 + ee), (LAS unsigned*)slot, 16, 0, 0);
        dst = (f32x4*)(kv ? ov : ok) + (size_t)bb * WBUF * 256 + ee;
    }
    __device__ __forceinline__ void prime() { issue(0); }
    __device__ __forceinline__ void fetch() { d = *(const LAS f32x4*)(slot + lane * 16); }
    __device__ __forceinline__ void step(int j) { __builtin_nontemporal_store(d, dst); issue(j + 1); }
};
#define PH_ON(k) ((PHASE_MASK >> (k)) & 1)
#ifndef REPEAT_MASK
#define REPEAT_MASK 0
#endif
#define NREP(k) (((REPEAT_MASK >> (k)) & 1) ? 2 : 1)
__global__ void __launch_bounds__(NWAVES * 64, 2) mk_fwd(Args args) {
    extern __shared__ __attribute__((aligned(16))) unsigned char lds[];
    Frame F;
    F.lds = (LAS unsigned char*)lds;
    F.tid = threadIdx.x; F.lane = F.tid & 63; F.wave = __builtin_amdgcn_readfirstlane(F.tid >> 6);
    F.G = gridDim.x; { const int bx = blockIdx.x; F.vcu = (F.G % 8 == 0) ? (bx % 8) * (F.G / 8) + bx / 8 : bx; }
    F.ws = args.ws; F.out = args.out; F.x_prompt = args.in[0]; F.state_k = args.in[2]; F.state_v = args.in[3];
    for (int u = F.tid; u < (LDS_BYTES - LDSCTL_OFF) / 4; u += NWAVES * 64) ((LAS unsigned*)(F.lds + LDSCTL_OFF))[u] = 0u;
    __syncthreads();
    XcdBarrier bar; bar.wave = F.wave; bar.bar = (unsigned*)(F.ws + WS_CTL) + CW_BAR; bar.x = 0; bar.st = nullptr;
    if (MK_ONE_LAUNCH) bar = xcd_barrier_post((unsigned*)(F.ws + WS_CTL) + CW_BAR, (volatile LAS unsigned*)(F.lds + MISC_OFF) + 8, F.wave);
    const int lo = args.ph_lo, hi = args.ph_hi;
#define IN(k) (lo <= (k) && (k) < hi)
#define SEAM(k) do { if (IN(k) && IN((k) + 1)) xcd_barrier(bar); } while (0)

    if (PH_ON(0) && IN(0)) { for (int rep = 0; rep < NREP(0); ++rep) p0_prologue(F, args); SEAM(0); }

    for (int l = 0; l < DEPTH; ++l) {
        const int p0 = 1 + 6 * l;
        if (PH_ON(1) && IN(p0)) {
            unsigned char* w = opq(F.ws); float* out = opq(F.out); Frame P = F; P.tid = fresh_tid(F.wave); P.lane = P.tid & 63;
            const bool sfirst = STAGGER && (F.vcu & 1);
            if (sfirst) { sgemv<0, D, DIN>(P, W_XS(w), W_WIN(w) + (size_t)l * DIN * D, W_PS(w), nullptr); WG_BAR(); }
            for (int rep = 0; rep < NREP(1); ++rep) { pg8::Gemm g{W_XB(w), W_WIN(w) + (size_t)l * DIN * D, M, DIN, D, F.wave}; pg8::MixedOrderG1 So; So.init(M, DIN, F.G, (int)blockIdx.x);
              pg8::fill_rstd_table((LAS float*)(F.lds + RS_TAB_OFF), So, W_SSQA(w), EPS, P.tid);
              pg8::EpiG1 E{(const LAS float*)(F.lds + RS_TAB_OFF), W_GN(w) + l * 128, 64, W_Q(w), (size_t)(WS_K - WS_Q) / 2, W_PC(w), out + O_KP + (size_t)l * M * 1024, (size_t)(O_VP - O_KP), QSCALE, EPS};
              pg8::gemm_phase<pg8::EpiG1, pg8::MixedOrderG1, GEMM_ALIGN, GEMM_SP2>(F.lds, g, So, E); }
            if (!sfirst && F.wave == 0) EARLY_WB(); if (!sfirst) sgemv<0, D, DIN>(P, W_XS(w), W_WIN(w) + (size_t)l * DIN * D, W_PS(w), nullptr);
            SEAM(p0);
        }
        if (PH_ON(2) && IN(p0 + 1)) {
            unsigned char* w = opq(F.ws); float* out = opq(F.out); Frame P = F; P.tid = fresh_tid(F.wave); P.lane = P.tid & 63;
#ifdef ATT_PROBE_MODE
            attn_phase_prompt(P, w, out, l, ATT_PROBE_MODE); WG_BAR();
#endif
#if ATT_V4
            attn_phase_prompt4(P, args, w, out, l);
#else
            for (int rep = 0; rep < NREP(2); ++rep) attn_phase_prompt(P, w, out, l);
#endif
            WG_BAR();
#if !ATT_V4
            for (int rep = 0; rep < NREP(7); ++rep) if (F.vcu < SB * H) attn_sample_unit(P, w, out, l, F.vcu >> 4, F.vcu & 15);
#endif
            SEAM(p0 + 1);
        }
        if (PH_ON(3) && IN(p0 + 2)) {
            unsigned char* w = opq(F.ws); float* out = opq(F.out); Frame P = F; P.tid = fresh_tid(F.wave); P.lane = P.tid & 63;
            const int gw = F.vcu * NWAVES + F.wave, NGW = F.G * NWAVES;
            for (int rep = 0; rep < NREP(3); ++rep) for (int row = gw; row < M; row += NGW) mix_row_prompt(w, out, P.lane, l, row);
            if (F.vcu == F.G - 1) mix_row_sample(w, out, P.lane, l, P.wave);
            SEAM(p0 + 2);
        }
        if (PH_ON(4) && IN(p0 + 3)) {
            unsigned char* w = opq(F.ws); float* out = opq(F.out); Frame P = F; P.tid = fresh_tid(F.wave); P.lane = P.tid & 63;
            const bool sfirst = STAGGER && (F.vcu & 1);
            if (sfirst) { sgemv<1, D, D>(P, W_MIXS(w), W_WOUT(w) + (size_t)l * D * D, W_XS(w), nullptr); WG_BAR(); }
            if (NREP(4) > 1) { pg8::Gemm g{W_MIX(w), W_WOUT(w) + (size_t)l * D * D, M, D, D, F.wave}; pg8::StaticOrder So; So.init(M, D, F.G, (int)blockIdx.x); pg8::EpiNull E{}; pg8::gemm_phase<pg8::EpiNull, pg8::StaticOrder, false, true>(F.lds, g, So, E); }
            { pg8::Gemm g{W_MIX(w), W_WOUT(w) + (size_t)l * D * D, M, D, D, F.wave}; pg8::StaticOrder So; So.init(M, D, F.G, (int)blockIdx.x);
              pg8::EpiRes E{W_XB(w), W_SSQB(w), nullptr};
              pg8::gemm_phase<pg8::EpiRes, pg8::StaticOrder, false, GEMM_SP2>(F.lds, g, So, E); }
            if (!sfirst && F.wave == 0) EARLY_WB(); if (!sfirst) sgemv<1, D, D>(P, W_MIXS(w), W_WOUT(w) + (size_t)l * D * D, W_XS(w), nullptr);
            SEAM(p0 + 3);
        }
        if (PH_ON(5) && IN(p0 + 4)) {
            unsigned char* w = opq(F.ws); Frame P = F; P.tid = fresh_tid(F.wave); P.lane = P.tid & 63;
            const bool sfirst = STAGGER && (F.vcu & 1);
            if (sfirst) { sgemv<2, D, DFF>(P, W_XS(w), W_WUP(w) + (size_t)l * DFF * D, W_AS(w), nullptr); WG_BAR(); }
            for (int rep = 0; rep < NREP(5); ++rep) { pg8::Gemm g{W_XB(w), W_WUP(w) + (size_t)l * DFF * D, M, DFF, D, F.wave}; pg8::StaticOrder So; So.init(M, DFF, F.G, (int)blockIdx.x);
              pg8::fill_rstd_table((LAS float*)(F.lds + RS_TAB_OFF), So, W_SSQB(w), EPS, P.tid);
              pg8::EpiG3 E{(const LAS float*)(F.lds + RS_TAB_OFF), W_HB(w), DFF};
              pg8::gemm_phase<pg8::EpiG3, pg8::StaticOrder, GEMM_ALIGN, GEMM_SP2>(F.lds, g, So, E); }
            if (!sfirst && F.wave == 0) EARLY_WB(); if (!sfirst) sgemv<2, D, DFF>(P, W_XS(w), W_WUP(w) + (size_t)l * DFF * D, W_AS(w), nullptr);
            SEAM(p0 + 4);
        }
        if (PH_ON(6) && IN(p0 + 5)) {
            unsigned char* w = opq(F.ws); float* out = opq(F.out); Frame P = F; P.tid = fresh_tid(F.wave); P.lane = P.tid & 63;
            const bool sfirst = STAGGER && (F.vcu & 1);
            if (sfirst) { sgemv<3, DFF, D>(P, W_AS(w), W_WDN(w) + (size_t)l * D * DFF, W_XS(w), l == DEPTH - 1 ? out + O_YS : nullptr); WG_BAR(); }
            if (NREP(6) > 1) { pg8::Gemm g{W_HB(w), W_WDN(w) + (size_t)l * D * DFF, M, D, DFF, F.wave}; pg8::StaticOrder So; So.init(M, D, F.G, (int)blockIdx.x); pg8::EpiNull E{}; pg8::gemm_phase<pg8::EpiNull, pg8::StaticOrder, false, true>(F.lds, g, So, E); }
            { pg8::Gemm g{W_HB(w), W_WDN(w) + (size_t)l * D * DFF, M, D, DFF, F.wave}; pg8::StaticOrder So; So.init(M, D, F.G, (int)blockIdx.x);
              pg8::EpiRes E{W_XB(w), W_SSQA(w), l == DEPTH - 1 ? out + O_Y : nullptr};
#if KV_SIDE
              SideKV sc{W_K(w), W_V(w), out + O_KP + (size_t)l * M * 1024, out + O_VP + (size_t)l * M * 1024, F.vcu * NWAVES + F.wave, F.G * NWAVES, P.lane, F.lds + RS_TAB_OFF + F.wave * 1024, (f32x2){0.f, 0.f}, nullptr};
              pg8::gemm_phase<pg8::EpiRes, pg8::StaticOrder, false, true, SideKV>(F.lds, g, So, E, sc); }
#elif COPY_IN_G4
              const size_t lo_ = (size_t)l * SB * WBUF * 1024;
              SideCopy sc{F.state_k + lo_, F.state_v + lo_, out + O_KS + lo_, out + O_VS + lo_, F.vcu * NWAVES + F.wave, F.G * NWAVES, P.lane, F.lds + RS_TAB_OFF + F.wave * 1024, (f32x4){0.f, 0.f, 0.f, 0.f}, nullptr};
              pg8::gemm_phase<pg8::EpiRes, pg8::StaticOrder, false, true, SideCopy>(F.lds, g, So, E, sc); }
#else
              pg8::gemm_phase<pg8::EpiRes, pg8::StaticOrder, false, GEMM_SP2>(F.lds, g, So, E); }
#endif
            if (!sfirst && F.wave == 0) EARLY_WB(); if (!sfirst) sgemv<3, DFF, D>(P, W_AS(w), W_WDN(w) + (size_t)l * D * DFF, W_XS(w), l == DEPTH - 1 ? out + O_YS : nullptr);
            SEAM(p0 + 5);
        }
    }
#undef IN
#undef SEAM
}

extern "C" void kernel_launch(void* const* d_in, const int* in_sizes, int n_in, void* d_out, int out_size, void* d_ws, size_t ws_size, hipStream_t stream) {
    static int grid = 0;
    if (grid == 0) {
        if (n_in != 17 || (size_t)out_size != O_END || ws_size < WS_END) { fprintf(stderr, "kernel_launch: unexpected sizes (n_in %d out %d ws %zu)\n", n_in, out_size, ws_size); grid = -1; return; }
        int dev = 0, cus = 0, per_cu = 0;
        if (hipGetDevice(&dev) != hipSuccess || hipDeviceGetAttribute(&cus, hipDeviceAttributeMultiprocessorCount, dev) != hipSuccess) { grid = -1; return; }
        if (hipFuncSetAttribute((const void*)mk_fwd, hipFuncAttributeMaxDynamicSharedMemorySize, LDS_BYTES) != hipSuccess) { fprintf(stderr, "kernel_launch: hipFuncSetAttribute failed\n"); grid = -1; return; }
        if (hipOccupancyMaxActiveBlocksPerMultiprocessor(&per_cu, (const void*)mk_fwd, NWAVES * 64, LDS_BYTES) != hipSuccess || per_cu < 1) { fprintf(stderr, "kernel_launch: occupancy query says %d\n", per_cu); (void)hipGetLastError(); per_cu = 1; }
        grid = cus;
        if (grid != 256) fprintf(stderr, "kernel_launch: %d CUs (built for 256)\n", grid);
    }
    if (grid < 0) return;
    if (hipMemsetAsync((char*)d_ws + WS_CTL, 0, CTL_ZERO_BYTES, stream) != hipSuccess) return;
    Args a{};
    for (int i = 0; i < 17; ++i) a.in[i] = (const float*)d_in[i];
    a.out = (float*)d_out; a.ws = (unsigned char*)d_ws;
#if MK_ONE_LAUNCH
    a.ph_lo = 0; a.ph_hi = NPH;
    hipLaunchKernelGGL(mk_fwd, dim3(grid), dim3(NWAVES * 64), LDS_BYTES, stream, a);
#else
    for (int p = 0; p < NPH; ++p) { a.ph_lo = p; a.ph_hi = p + 1; hipLaunchKernelGGL(mk_fwd, dim3(grid), dim3(NWAVES * 64), LDS_BYTES, stream, a); }
#endif
}
```
